# Optimizing an MI355X kernel written in HIP

```python
import math
import jax, jax.numpy as jnp
from jax import lax
import numpy as np

D_MODEL = 1024
BATCH = 8
SEQ = 2048
DEPTH = 4

MIX_WIDTH = D_MODEL
GROUP_WIDTH = MIX_WIDTH // 4
ATTN_HEADS = 4
ATTN_QK_DIM = GROUP_WIDTH // ATTN_HEADS // 2
ATTN_V_DIM = 2 * ATTN_QK_DIM
Q_BLOCK = 128
CONF_KERNEL = 31
SHORT_KERNEL = 3
POOL_WINDOWS = (2, 4, 8, 16)
POOL_GROUPS = len(POOL_WINDOWS)
POOL_GROUP_DIM = GROUP_WIDTH // POOL_GROUPS
D_FF = 4 * D_MODEL
EPS = 1e-6
N_MOD = 6

A_QK = ATTN_HEADS * 2 * ATTN_QK_DIM
A_V = ATTN_HEADS * ATTN_V_DIM
B_IN = 2 * GROUP_WIDTH
C_IN = 3 * GROUP_WIDTH
D_IN = GROUP_WIDTH
IN_WIDTH = 2 * A_QK + A_V + B_IN + C_IN + D_IN
IN_SPLITS = (A_QK, 2 * A_QK, 2 * A_QK + A_V, 2 * A_QK + A_V + B_IN, 2 * A_QK + A_V + B_IN + C_IN)

kernel_name = 'hybrid_parallel_headgroup_adaln_trunk'


def rms_norm(x, g):
    xf = x.astype(jnp.float32)
    y = xf * lax.rsqrt(jnp.mean(xf * xf, axis=-1, keepdims=True) + EPS)
    return (y * g.astype(jnp.float32)).astype(x.dtype)


def layer_norm(x, g, b):
    xf = x.astype(jnp.float32)
    mu = jnp.mean(xf, axis=-1, keepdims=True)
    var = jnp.mean(jnp.square(xf - mu), axis=-1, keepdims=True)
    y = (xf - mu) * lax.rsqrt(var + EPS)
    return (y * g.astype(jnp.float32) + b.astype(jnp.float32)).astype(x.dtype)


def causal_dwconv(x, w):
    k = w.shape[0]
    ch = x.shape[-1]
    return lax.conv_general_dilated(
        x, w[:, None, :].astype(x.dtype), window_strides=(1,), padding=[(k - 1, 0)],
        dimension_numbers=('NWC', 'WIO', 'NWC'), feature_group_count=ch)


def diff_attention(q, k, v, lam_p, q_g, k_g, sub_g, lam_init):
    b, s, _ = q.shape
    q = rms_norm(q.reshape(b, s, ATTN_HEADS, 2, ATTN_QK_DIM), q_g).transpose(0, 2, 3, 1, 4)
    k = rms_norm(k.reshape(b, s, ATTN_HEADS, 2, ATTN_QK_DIM), k_g).transpose(0, 2, 3, 1, 4)
    v = v.reshape(b, s, ATTN_HEADS, ATTN_V_DIM).transpose(0, 2, 1, 3)
    lp = lam_p.astype(jnp.float32)
    lam = jnp.exp(jnp.sum(lp[0] * lp[1])) - jnp.exp(jnp.sum(lp[2] * lp[3])) + lam_init
    scale = ATTN_QK_DIM ** -0.5
    nb = s // Q_BLOCK
    qb = jnp.moveaxis(q.reshape(b, ATTN_HEADS, 2, nb, Q_BLOCK, ATTN_QK_DIM), 3, 0)
    starts = jnp.arange(nb) * Q_BLOCK
    kpos = jnp.arange(s)

    def block(args):
        qi, st = args
        sc = jnp.einsum('bhmqd,bhmkd->bhmqk', qi, k).astype(jnp.float32) * scale
        mask = kpos[None, :] <= (st + jnp.arange(Q_BLOCK))[:, None]
        p = jax.nn.softmax(jnp.where(mask, sc, -jnp.inf), axis=-1)
        a = p[:, :, 0] - lam * p[:, :, 1]
        return jnp.einsum('bhqk,bhkd->bhqd', a.astype(v.dtype), v)

    out = lax.map(block, (qb, starts))
    out = jnp.moveaxis(out, 0, 2).reshape(b, ATTN_HEADS, s, ATTN_V_DIM)
    out = rms_norm(out, sub_g) * (1.0 - lam_init)
    return out.transpose(0, 2, 1, 3).reshape(b, s, ATTN_HEADS * ATTN_V_DIM)


def conformer_conv(u, dw_w, dw_b, ln_g, ln_b):
    val, gate = jnp.split(u, 2, axis=-1)
    h = val * jax.nn.sigmoid(gate)
    h = causal_dwconv(h, dw_w) + dw_b
    return jax.nn.silu(layer_norm(h, ln_g, ln_b))


def short_gated_conv(u, w):
    bg, cg, xc = jnp.split(u, 3, axis=-1)
    return bg * causal_dwconv(cg * xc, w)


def multiscale_pool(u, w_pool, scale):
    b, s, _ = u.shape
    xf = u.reshape(b, s, POOL_GROUPS, POOL_GROUP_DIM).astype(jnp.float32)
    cs = jnp.concatenate([jnp.zeros((b, 1, POOL_GROUPS, POOL_GROUP_DIM), jnp.float32),
                          jnp.cumsum(xf, axis=1)], axis=1)
    t = np.arange(s)
    pooled = []
    for g, w in enumerate(POOL_WINDOWS):
        lo = np.maximum(t + 1 - w, 0)
        cnt = jnp.asarray(np.minimum(t + 1, w).astype(np.float32))
        pooled.append((cs[:, 1:, g] - cs[:, lo, g]) / cnt[None, :, None])
    y = (jnp.stack(pooled, axis=2) - xf).astype(u.dtype)
    y = jnp.einsum('bsgc,gcd->bsgd', y, w_pool)
    return y.reshape(b, s, GROUP_WIDTH) * scale


def setup_inputs(seed: int = 0) -> dict:
    key = jax.random.key(seed)
    ks = jax.random.split(key, 24)
    f32 = jnp.float32
    nrm = lambda k, shape, sd: jax.random.normal(k, shape, f32) * sd
    L = DEPTH
    return {
        'x': nrm(ks[0], (BATCH, SEQ, D_MODEL), 1.0),
        'c': nrm(ks[1], (BATCH, D_MODEL), 1.0),
        'w_ada': nrm(ks[2], (L, D_MODEL, N_MOD * D_MODEL), D_MODEL ** -0.5),
        'b_ada': nrm(ks[3], (L, N_MOD * D_MODEL), 0.02),
        'norm1_g': 1.0 + nrm(ks[4], (L, D_MODEL), 0.02),
        'norm2_g': 1.0 + nrm(ks[5], (L, D_MODEL), 0.02),
        'w_in': nrm(ks[6], (L, D_MODEL, IN_WIDTH), D_MODEL ** -0.5),
        'w_out': nrm(ks[7], (L, MIX_WIDTH, D_MODEL), MIX_WIDTH ** -0.5),
        'q_norm_g': 1.0 + nrm(ks[8], (L, ATTN_QK_DIM), 0.02),
        'k_norm_g': 1.0 + nrm(ks[9], (L, ATTN_QK_DIM), 0.02),
        'lam_params': nrm(ks[10], (L, 4, ATTN_QK_DIM), 0.1),
        'attn_sub_g': 1.0 + nrm(ks[11], (L, ATTN_V_DIM), 0.02),
        'conf_dw_w': nrm(ks[12], (L, CONF_KERNEL, GROUP_WIDTH), CONF_KERNEL ** -0.5),
        'conf_dw_b': nrm(ks[13], (L, GROUP_WIDTH), 0.02),
        'conf_ln_g': 1.0 + nrm(ks[14], (L, GROUP_WIDTH), 0.02),
        'conf_ln_b': nrm(ks[15], (L, GROUP_WIDTH), 0.02),
        'short_conv_w': nrm(ks[16], (L, SHORT_KERNEL, GROUP_WIDTH), SHORT_KERNEL ** -0.5),
        'pool_w': nrm(ks[17], (L, POOL_GROUPS, POOL_GROUP_DIM, POOL_GROUP_DIM), POOL_GROUP_DIM ** -0.5),
        'pool_scale': 1.0 + nrm(ks[18], (L, GROUP_WIDTH), 0.1),
        'w_ff1': nrm(ks[19], (L, D_MODEL, D_FF), D_MODEL ** -0.5),
        'w_ff2': nrm(ks[20], (L, D_FF, D_MODEL), D_FF ** -0.5),
    }


def reference(x, c, w_ada, b_ada, norm1_g, norm2_g, w_in, w_out, q_norm_g, k_norm_g, lam_params,
              attn_sub_g, conf_dw_w, conf_dw_b, conf_ln_g, conf_ln_b, short_conv_w, pool_w, pool_scale,
              w_ff1, w_ff2):
    c_act = jax.nn.silu(c)
    for l in range(DEPTH):
        lam_init = 0.8 - 0.6 * math.exp(-0.3 * l)
        mod = (c_act @ w_ada[l] + b_ada[l])[:, None, :]
        sh1, sc1, g1, sh2, sc2, g2 = jnp.split(mod, N_MOD, axis=-1)
        h = rms_norm(x, norm1_g[l]) * (1.0 + sc1) + sh1
        proj = h @ w_in[l]
        qa, ka, va, ub, uc, ud = jnp.split(proj, IN_SPLITS, axis=-1)
        ya = diff_attention(qa, ka, va, lam_params[l], q_norm_g[l], k_norm_g[l], attn_sub_g[l], lam_init)
        yb = conformer_conv(ub, conf_dw_w[l], conf_dw_b[l], conf_ln_g[l], conf_ln_b[l])
        yc = short_gated_conv(uc, short_conv_w[l])
        yd = multiscale_pool(ud, pool_w[l], pool_scale[l])
        mix = jnp.concatenate([ya, yb, yc, yd], axis=-1) @ w_out[l]
        x = x + g1 * mix
        h = rms_norm(x, norm2_g[l]) * (1.0 + sc2) + sh2
        x = x + g2 * (jnp.square(jax.nn.relu(h @ w_ff1[l])) @ w_ff2[l])
    return x
```

```cpp
#include <hip/hip_runtime.h>
#include <cstdio>
#include <cstdint>
#include <cmath>
namespace pg8 {
#define PG8_LAS __attribute__((address_space(3)))
typedef unsigned short bf16_t;
typedef short bf16x8 __attribute__((ext_vector_type(8)));
typedef float f32x4 __attribute__((ext_vector_type(4)));
typedef unsigned u32x4 __attribute__((ext_vector_type(4)));
constexpr int BM = 256, BK = 64, HALF = 128, HTB = HALF * BK * 2  , STAGE_BYTES = 8 * HTB, NXCD = 8, WGM = 8;

__host__ __device__ __forceinline__ int lds_byte(int r, int c) { const int st = (r >> 4) * 2 + (c >> 5), rr = r & 15, cc = c & 31, ob = rr * 64 + cc * 2; return st * 1024 + (ob ^ (((ob >> 9) & 1) << 5)); }
__host__ __device__ __forceinline__ void stage_rc(int b, int& R, int& C) { const int st = b / 1024, sb = b % 1024, swz = sb ^ (((sb >> 9) & 1) << 5); R = (st >> 1) * 16 + swz / 64; C = (st & 1) * 32 + (swz % 64) / 2; }
__host__ __device__ __forceinline__ int perm32(int rho) { const int n = rho >> 4, i = rho & 15; return 8 * (i >> 2) + 4 * n + (i & 3); }

struct Unit { int pm, pn; };
struct Gemm { const bf16_t* A; const bf16_t* Bt; int M, N, K; };

struct StaticOrder {
    int nM, nN, nwg, G, c;
    __host__ __device__ void init(int M, int N, int G_, int c_) { nM = M / BM; nN = N / BM; nwg = nM * nN; G = G_; c = c_; }
    __host__ __device__ bool next(int i, Unit& u) const {
        const long L = (long)i * G + c; if (L >= nwg) return false;
        int wgid = (int)L; { const int q = nwg / NXCD, r = nwg % NXCD, xcd = wgid % NXCD, off = wgid / NXCD; wgid = (xcd < r ? xcd * (q + 1) : r * (q + 1) + (xcd - r) * q) + off; }
        const int nig = WGM * nN, gid = wgid / nig, fm = gid * WGM, gsz = (nM - fm) < WGM ? (nM - fm) : WGM;
        u.pm = fm + ((wgid % nig) % gsz); u.pn = (wgid % nig) / gsz; return true;
    }
    __device__ __forceinline__ void a_ready(const Unit&) const {}
    __device__ __forceinline__ void done(const Unit&) const {}
};


__device__ __forceinline__ unsigned cvt_pk_bf16(float lo, float hi) { unsigned r; asm volatile("v_cvt_pk_bf16_f32 %0, %1, %2" : "=v"(r) : "v"(lo), "v"(hi)); return r; }
typedef unsigned u32x2 __attribute__((ext_vector_type(2)));
__device__ __forceinline__ float dot4(f32x4 a) { return (a[0] * a[0] + a[1] * a[1]) + (a[2] * a[2] + a[3] * a[3]); }

struct EpiProj {
    static constexpr bool PERM = true, AFTER_DRAIN = false;
    bf16_t* O; const float* bias; const PG8_LAS float* rtab; const float* qg; const float* kg; float qscale;
    __device__ __forceinline__ void operator()(const f32x4 (&acc)[2][2][4][2], const Unit& u, int ui, int wr, int wc, int fr, int fq) const {
        const int b = u.pm >> 3;
        const int row0 = u.pm * BM + wr * 64 + fr, col0 = u.pn * BM + wc * 32 + 8 * fq;
        const float* bp = bias + b * 2304 + col0;
        f32x4 bv[2][2];
#pragma unroll
        for (int bj = 0; bj < 2; ++bj)
#pragma unroll
            for (int n = 0; n < 2; ++n) bv[bj][n] = *(const f32x4*)(bp + bj * HALF + 4 * n);
        const bool isqk = u.pn < 2;
        f32x4 g0 = (f32x4){1.f, 1.f, 1.f, 1.f}, g1 = g0;
        if (isqk) { const float* gp = (u.pn == 0 ? qg : kg) + 8 * fq; g0 = *(const f32x4*)gp; g1 = *(const f32x4*)(gp + 4); if (u.pn == 0) { g0 = g0 * qscale; g1 = g1 * qscale; } }
        const PG8_LAS float* rt = rtab + ui * 256 + wr * 64 + fr;
#pragma unroll
        for (int ai = 0; ai < 2; ++ai)
#pragma unroll
            for (int m = 0; m < 4; ++m) { const float rs = rt[ai * HALF + m * 16]; bf16_t* rowp = O + (size_t)(row0 + ai * HALF + m * 16) * 2304 + col0;
#pragma unroll
                for (int bj = 0; bj < 2; ++bj) { f32x4 v0 = acc[ai][bj][m][0] * rs + bv[bj][0], v1 = acc[ai][bj][m][1] * rs + bv[bj][1];
                    if (isqk) { float ss = dot4(v0) + dot4(v1); ss += __shfl_xor(ss, 16); ss += __shfl_xor(ss, 32);
                        const float r = __builtin_amdgcn_rsqf(ss * (1.0f / 32.0f) + 1e-6f); v0 = v0 * r * g0; v1 = v1 * r * g1; }
                    u32x4 w; w.x = cvt_pk_bf16(v0[0], v0[1]); w.y = cvt_pk_bf16(v0[2], v0[3]); w.z = cvt_pk_bf16(v1[0], v1[1]); w.w = cvt_pk_bf16(v1[2], v1[3]);
                    *(u32x4*)(rowp + bj * HALF) = w; } }
    }
};
struct EpiFF1 {
    static constexpr bool PERM = true, AFTER_DRAIN = false;
    bf16_t* O; const float* bias; const PG8_LAS float* rtab;
    __device__ __forceinline__ void operator()(const f32x4 (&acc)[2][2][4][2], const Unit& u, int ui, int wr, int wc, int fr, int fq) const {
        const int b = u.pm >> 3;
        const int row0 = u.pm * BM + wr * 64 + fr, col0 = u.pn * BM + wc * 32 + 8 * fq;
        const float* bp = bias + b * 4096 + col0;
        f32x4 bv[2][2];
#pragma unroll
        for (int bj = 0; bj < 2; ++bj)
#pragma unroll
            for (int n = 0; n < 2; ++n) bv[bj][n] = *(const f32x4*)(bp + bj * HALF + 4 * n);
        const PG8_LAS float* rt = rtab + ui * 256 + wr * 64 + fr;
        const f32x4 z = (f32x4){0.f, 0.f, 0.f, 0.f};
#pragma unroll
        for (int ai = 0; ai < 2; ++ai)
#pragma unroll
            for (int m = 0; m < 4; ++m) {
#ifdef EXP_A
 const float rs = 1.0f;
#else
 const float rs = rt[ai * HALF + m * 16];
#endif
 bf16_t* rowp = O + (size_t)(row0 + ai * HALF + m * 16) * 4096 + col0;
#pragma unroll
                for (int bj = 0; bj < 2; ++bj) { f32x4 v0 = acc[ai][bj][m][0] * rs + bv[bj][0], v1 = acc[ai][bj][m][1] * rs + bv[bj][1];
                    v0 = __builtin_elementwise_max(v0, z); v1 = __builtin_elementwise_max(v1, z); v0 = v0 * v0; v1 = v1 * v1;
                    u32x4 w; w.x = cvt_pk_bf16(v0[0], v0[1]); w.y = cvt_pk_bf16(v0[2], v0[3]); w.z = cvt_pk_bf16(v1[0], v1[1]); w.w = cvt_pk_bf16(v1[2], v1[3]);
                    *(u32x4*)(rowp + bj * HALF) = w; } }
    }
};
struct EpiRes {
    static constexpr bool PERM = false, AFTER_DRAIN = false;
    const float* xin_f; const bf16_t* xin_h; float* xout_f; bf16_t* xout_h; const float* gate; const float* nsc; const float* ng; bf16_t* hA; float* ssq; int write_next;
    __device__ __forceinline__ void operator()(const f32x4 (&acc)[2][2][4][2], const Unit& u, int ui, int wr, int wc, int fr, int fq) const {
        const int b = u.pm >> 3;
        const int col0 = u.pn * BM + wc * 32 + 4 * fq;
        f32x4 gv[2][2], gm[2][2];
#pragma unroll
        for (int bj = 0; bj < 2; ++bj)
#pragma unroll
            for (int n = 0; n < 2; ++n) { const int c = col0 + bj * HALF + n * 16; gv[bj][n] = *(const f32x4*)(gate + b * 6144 + c);
                if (write_next) gm[bj][n] = *(const f32x4*)(ng + c) * (*(const f32x4*)(nsc + b * 6144 + c) + 1.0f); else gm[bj][n] = (f32x4){0.f, 0.f, 0.f, 0.f}; }
#pragma unroll
        for (int ai = 0; ai < 2; ++ai)
#pragma unroll
            for (int m = 0; m < 4; ++m) { const int row = u.pm * BM + ai * HALF + wr * 64 + m * 16 + fr; float ss = 0.f;
#pragma unroll
                for (int bj = 0; bj < 2; ++bj)
#pragma unroll
                    for (int n = 0; n < 2; ++n) { const size_t off = (size_t)row * 1024 + col0 + bj * HALF + n * 16;
                        f32x4 xi;
                        if (xin_f) xi = *(const f32x4*)(xin_f + off);
                        else { const u32x2 t = *(const u32x2*)(xin_h + off); xi = (f32x4){__builtin_bit_cast(float, t.x << 16), __builtin_bit_cast(float, t.x & 0xffff0000u), __builtin_bit_cast(float, t.y << 16), __builtin_bit_cast(float, t.y & 0xffff0000u)}; }
                        const f32x4 xo = xi + gv[bj][n] * acc[ai][bj][m][n]; ss += dot4(xo);
                        if (xout_f) *(f32x4*)(xout_f + off) = xo;
                        else { u32x2 w; w.x = cvt_pk_bf16(xo[0], xo[1]); w.y = cvt_pk_bf16(xo[2], xo[3]); *(u32x2*)(xout_h + off) = w; }
                        if (write_next) { const f32x4 h = xo * gm[bj][n]; u32x2 w; w.x = cvt_pk_bf16(h[0], h[1]); w.y = cvt_pk_bf16(h[2], h[3]); *(u32x2*)(hA + off) = w; } }
                ss += __shfl_xor(ss, 16); ss += __shfl_xor(ss, 32);
                if (write_next && fq == 0) ssq[(size_t)(u.pn * 4 + wc) * 16384 + row] = ss;
                if (m & 1) asm volatile("" ::: "memory"); }
    }
};

template <class Epi, class Sched, bool ALIGN_EPI = false, bool SP2 = false>
__device__ __forceinline__ void gemm_phase(PG8_LAS unsigned char* lds, const Gemm g, const Sched& S, const Epi& E, const int tid_in) {
    const int tid = tid_in, wid = __builtin_amdgcn_readfirstlane(tid >> 6), lane = tid & 63, wr = wid >> 2, wc = wid & 3, fr = lane & 15, fq = lane >> 4;
    const int K = g.K, nt = K / BK;
    unsigned voffA[2], voffB[2];
#pragma unroll
    for (int i = 0; i < 2; ++i) { int R, C; stage_rc(tid * 16 + i * 8192, R, C); const int Rb = Epi::PERM ? ((R & ~31) + perm32(R & 31)) : R;
        voffA[i] = (unsigned)(R * K + C) * 2u; voffB[i] = (unsigned)(Rb * K + C) * 2u; }
    const size_t kstep = (size_t)(BK * 2);
    const size_t hstep = (size_t)HALF * K * 2;
    const size_t tstep = 2 * hstep;
    const unsigned ldsw = (unsigned)wid * 1024u;
    const int aoff = lds_byte(wr * 64 + fr, fq * 8), boff = lds_byte(wc * 32 + fr, fq * 8);
#define PG8_SA(b, h) (((b) * 2 + (h)) * HTB)
#define PG8_SB(b, h) ((4 + (b) * 2 + (h)) * HTB)
#define PG8_STAGE(bufoff, gbase, voff) do { _Pragma("unroll") for (int _i = 0; _i < 2; ++_i) \
        __builtin_amdgcn_global_load_lds((const unsigned*)((const char*)(gbase) + (voff)[_i]), (PG8_LAS unsigned*)(lds + (bufoff) + ldsw + _i * 8192), 16, 0, 0); } while (0)
#define PG8_LDA(dst, b, h) do { _Pragma("unroll") for (int m = 0; m < 4; ++m) _Pragma("unroll") for (int k = 0; k < 2; ++k) dst[m][k] = *(const PG8_LAS bf16x8*)(lds + PG8_SA(b, h) + aoff + m * 2048 + k * 1024); } while (0)
#define PG8_LDB(dst, b, h) do { _Pragma("unroll") for (int n = 0; n < 2; ++n) _Pragma("unroll") for (int k = 0; k < 2; ++k) dst[n][k] = *(const PG8_LAS bf16x8*)(lds + PG8_SB(b, h) + boff + n * 2048 + k * 1024); } while (0)
#define PG8_MMA(ai, bj, At, Bt) do { __builtin_amdgcn_s_setprio(1); _Pragma("unroll") for (int m = 0; m < 4; ++m) _Pragma("unroll") for (int n = 0; n < 2; ++n) _Pragma("unroll") for (int k = 0; k < 2; ++k) \
        acc[ai][bj][m][n] = __builtin_amdgcn_mfma_f32_16x16x32_bf16(Bt[n][k], At[m][k], acc[ai][bj][m][n], 0, 0, 0); __builtin_amdgcn_s_setprio(0); } while (0)
#define PG8_WAIT_V(n) asm volatile("s_waitcnt vmcnt(" #n ")" ::: "memory")
#define PG8_WAIT_L(n) asm volatile("s_waitcnt lgkmcnt(" #n ")" ::: "memory")
#define PG8_BAR __builtin_amdgcn_s_barrier()
#define PG8_SCHED __builtin_amdgcn_sched_barrier(0)
    Unit cur, nxt; int ui = 0;
    if (!S.next(0, cur)) return;
    f32x4 acc[2][2][4][2];
#pragma unroll
    for (int a = 0; a < 2; ++a)
#pragma unroll
        for (int b = 0; b < 2; ++b)
#pragma unroll
            for (int m = 0; m < 4; ++m)
#pragma unroll
                for (int n = 0; n < 2; ++n) acc[a][b][m][n] = (f32x4){0.f, 0.f, 0.f, 0.f};
    bf16x8 At[4][2], B0[2][2], B1[2][2];
    const char* cA = (const char*)g.A + (size_t)cur.pm * tstep; const char* cB = (const char*)g.Bt + (size_t)cur.pn * tstep;
    S.a_ready(cur);
    if constexpr (SP2) {
        PG8_STAGE(PG8_SB(0, 0), cB, voffB); PG8_STAGE(PG8_SB(0, 1), cB + hstep, voffB); PG8_STAGE(PG8_SA(0, 0), cA, voffA); PG8_STAGE(PG8_SA(0, 1), cA + hstep, voffA);
        if (wr == 1) PG8_BAR;
        PG8_WAIT_V(2); PG8_BAR;
        PG8_STAGE(PG8_SB(1, 0), cB + kstep, voffB); PG8_STAGE(PG8_SA(1, 0), cA + kstep, voffA); PG8_STAGE(PG8_SB(1, 1), cB + hstep + kstep, voffB);
        PG8_WAIT_V(6); PG8_BAR;
    } else {
        PG8_STAGE(PG8_SB(0, 0), cB, voffB); PG8_STAGE(PG8_SA(0, 0), cA, voffA); PG8_STAGE(PG8_SB(0, 1), cB + hstep, voffB); PG8_STAGE(PG8_SA(0, 1), cA + hstep, voffA);
        if (wr == 1) PG8_BAR;
        PG8_WAIT_V(4); PG8_BAR;
        PG8_STAGE(PG8_SB(1, 0), cB + kstep, voffB); PG8_STAGE(PG8_SA(1, 0), cA + kstep, voffA); PG8_STAGE(PG8_SB(1, 1), cB + hstep + kstep, voffB);
        PG8_WAIT_V(6); PG8_BAR;
    }
    for (;;) {
        const bool has_next = S.next(ui + 1, nxt);
        const char* nA = has_next ? (const char*)g.A + (size_t)nxt.pm * tstep : cA; const char* nB = has_next ? (const char*)g.Bt + (size_t)nxt.pn * tstep : cB;
        for (int t = 0; t < nt; t += 2) {
            const bool last = (t == nt - 2);
            const char* a1 = cA + (size_t)(t + 1) * kstep;
            const char* a2 = last ? nA : cA + (size_t)(t + 2) * kstep; const char* b2 = last ? nB : cB + (size_t)(t + 2) * kstep;
            const char* a3 = a2 + kstep; const char* b3 = b2 + kstep;
            if (last && has_next) S.a_ready(nxt);
            if constexpr (SP2) {
            PG8_LDB(B0, 0, 0); PG8_LDB(B1, 0, 1); PG8_SCHED; PG8_LDA(At, 0, 0); PG8_STAGE(PG8_SA(1, 1), a1 + hstep, voffA);
            PG8_WAIT_V(8); PG8_WAIT_L(0); PG8_BAR; PG8_MMA(0, 0, At, B0); PG8_MMA(0, 1, At, B1); PG8_BAR; PG8_SCHED;
            PG8_LDA(At, 0, 1); PG8_STAGE(PG8_SB(0, 0), b2, voffB); PG8_STAGE(PG8_SB(0, 1), b2 + hstep, voffB); PG8_STAGE(PG8_SA(0, 0), a2, voffA);
            PG8_WAIT_V(8); PG8_WAIT_L(0); PG8_BAR; PG8_MMA(1, 0, At, B0); PG8_MMA(1, 1, At, B1); PG8_BAR; PG8_SCHED;
            PG8_LDB(B0, 1, 0); PG8_LDB(B1, 1, 1); PG8_SCHED; PG8_LDA(At, 1, 0); PG8_STAGE(PG8_SA(0, 1), a2 + hstep, voffA);
            PG8_WAIT_V(8); PG8_WAIT_L(0); PG8_BAR; PG8_MMA(0, 0, At, B0); PG8_MMA(0, 1, At, B1); PG8_BAR; PG8_SCHED;
            PG8_LDA(At, 1, 1); PG8_STAGE(PG8_SB(1, 0), b3, voffB); PG8_STAGE(PG8_SB(1, 1), b3 + hstep, voffB); PG8_STAGE(PG8_SA(1, 0), a3, voffA);
            PG8_WAIT_V(8); PG8_WAIT_L(0); PG8_BAR; PG8_MMA(1, 0, At, B0); PG8_MMA(1, 1, At, B1); PG8_BAR; PG8_SCHED;
            } else {
            PG8_LDB(B0, 0, 0); PG8_SCHED; PG8_LDA(At, 0, 0); PG8_STAGE(PG8_SA(1, 1), a1 + hstep, voffA);
            PG8_WAIT_L(8); PG8_BAR; PG8_WAIT_L(0); PG8_MMA(0, 0, At, B0); PG8_BAR; PG8_SCHED;
            PG8_LDB(B1, 0, 1); PG8_STAGE(PG8_SB(0, 0), b2, voffB);
            PG8_BAR; PG8_WAIT_L(0); PG8_MMA(0, 1, At, B1); PG8_BAR;
            PG8_LDA(At, 0, 1); PG8_STAGE(PG8_SA(0, 0), a2, voffA);
            PG8_BAR; PG8_WAIT_L(0); PG8_MMA(1, 0, At, B0); PG8_BAR; PG8_SCHED;
            PG8_STAGE(PG8_SB(0, 1), b2 + hstep, voffB);
            PG8_WAIT_V(6); PG8_BAR; PG8_MMA(1, 1, At, B1); PG8_BAR;
            PG8_LDB(B0, 1, 0); PG8_SCHED; PG8_LDA(At, 1, 0); PG8_STAGE(PG8_SA(0, 1), a2 + hstep, voffA);
            PG8_WAIT_L(8); PG8_BAR; PG8_WAIT_L(0); PG8_MMA(0, 0, At, B0); PG8_BAR; PG8_SCHED;
            PG8_LDB(B1, 1, 1); PG8_STAGE(PG8_SB(1, 0), b3, voffB);
            PG8_BAR; PG8_WAIT_L(0); PG8_MMA(0, 1, At, B1); PG8_BAR;
            PG8_LDA(At, 1, 1); PG8_STAGE(PG8_SA(1, 0), a3, voffA);
            PG8_BAR; PG8_WAIT_L(0); PG8_MMA(1, 0, At, B0); PG8_BAR; PG8_SCHED;
            PG8_STAGE(PG8_SB(1, 1), b3 + hstep, voffB);
            PG8_WAIT_V(6); PG8_BAR; PG8_MMA(1, 1, At, B1); PG8_BAR;
            }
        }
        if constexpr (ALIGN_EPI) { if (wr == 0) PG8_BAR; }
        if constexpr (!Epi::AFTER_DRAIN) { E(acc, cur, ui, wr, wc, fr, fq); S.done(cur); }
        if (!has_next) break;
#pragma unroll
        for (int a = 0; a < 2; ++a)
#pragma unroll
            for (int b = 0; b < 2; ++b)
#pragma unroll
                for (int m = 0; m < 4; ++m)
#pragma unroll
                    for (int n = 0; n < 2; ++n) acc[a][b][m][n] = (f32x4){0.f, 0.f, 0.f, 0.f};
        cur = nxt; cA = nA; cB = nB; ++ui;
        if constexpr (ALIGN_EPI) { if (wr == 1) PG8_BAR; }
    }
    PG8_WAIT_V(0);
    if constexpr (!ALIGN_EPI) { if (wr == 0) PG8_BAR; }
    PG8_BAR;
    if constexpr (Epi::AFTER_DRAIN) { E.fused(acc, cur, wr, wc, fr, fq, lds, wid, lane); S.done(cur); }
#undef PG8_SA
#undef PG8_SB
#undef PG8_STAGE
#undef PG8_LDA
#undef PG8_LDB
#undef PG8_MMA
#undef PG8_WAIT_V
#undef PG8_WAIT_L
#undef PG8_BAR
#undef PG8_SCHED
}
}

constexpr int NWAVES = 8;
constexpr int DM = 1024, BATCH = 8, SEQ = 2048, M = BATCH * SEQ, DEPTH = 4, NIN = 2304, FF = 4096, NMOD = 6144;
constexpr float EPS = 1e-6f;
constexpr float QSCALE = 0.17677669529663687f * 1.4426950408889634f;

#ifndef MK_PER_PHASE
#define MK_PER_PHASE 0
#endif
constexpr int N_PHASES = 2 + 5 * DEPTH;
#ifndef PREP_UPFRONT
#define PREP_UPFRONT 1
#endif

constexpr size_t MiB = 1u << 20;
constexpr size_t WS_CTL = 0, CTL_ZERO_BYTES = 1 * MiB;
constexpr size_t WS_MOD = 1 * MiB;
constexpr size_t WS_BIAS1 = 2 * MiB;
constexpr size_t WS_BIAS2 = 3 * MiB;
constexpr size_t WS_SSQ1 = 4 * MiB, WS_SSQ2 = 5 * MiB;
constexpr size_t WS_WT = 8 * MiB;
constexpr size_t WT_IN = 0, WT_OUT = (size_t)NIN * DM * 2, WT_FF1 = WT_OUT + (size_t)DM * DM * 2, WT_FF2 = WT_FF1 + (size_t)FF * DM * 2, WT_LAYER = WT_FF2 + (size_t)FF * DM * 2;
constexpr size_t WS_HA = WS_WT + DEPTH * WT_LAYER;
constexpr size_t WS_XB = WS_HA + (size_t)M * DM * 2;
constexpr size_t WS_PROJ = WS_XB + (size_t)M * DM * 2;
constexpr size_t WS_MIX = WS_PROJ + (size_t)M * NIN * 2;
constexpr size_t WS_HID = WS_PROJ;
constexpr size_t WS_END = WS_HID + (size_t)M * FF * 2;
static_assert(WT_LAYER == (size_t)(NIN + DM + FF + FF) * DM * 2 && WS_HA % 256 == 0 && WS_PROJ % 256 == 0 && WS_MIX % 256 == 0 && WS_HID % 256 == 0 && WS_MIX + (size_t)M * DM * 2 <= WS_END, "ws map");
constexpr int CW_BAR = 4096;

constexpr int RING_OFF = 0, RING_BYTES = 131072;
constexpr int LDSCTL_OFF = RING_BYTES, MISC_OFF = LDSCTL_OFF + 320;
constexpr int RT_OFF = LDSCTL_OFF + 512;
constexpr int LDS_BYTES = 147456;
static_assert(RT_OFF + 8 * 256 * 4 <= LDS_BYTES, "LDS map");

#define GAS __attribute__((address_space(1)))
#define LAS __attribute__((address_space(3)))
typedef unsigned short bf16;
typedef unsigned v4u __attribute__((ext_vector_type(4)));
typedef unsigned v2u __attribute__((ext_vector_type(2)));
typedef float f32x4 __attribute__((ext_vector_type(4)));
typedef float f32x2 __attribute__((ext_vector_type(2)));
typedef short bf16x8 __attribute__((ext_vector_type(8)));
typedef short s16x4 __attribute__((ext_vector_type(4)));
typedef GAS unsigned gu32;
#define RLX_AGENT __ATOMIC_RELAXED, __HIP_MEMORY_SCOPE_AGENT
#define LDS_WAIT() asm volatile("s_waitcnt lgkmcnt(0)" ::: "memory")
#define VM_WAIT() asm volatile("s_waitcnt vmcnt(0)" ::: "memory")
__device__ __forceinline__ unsigned f2bf(float f) { unsigned u = __builtin_bit_cast(unsigned, f); return (u + 0x7fffu + ((u >> 16) & 1u)) >> 16; }
__device__ __forceinline__ unsigned pk2(float lo, float hi) { return f2bf(lo) | (f2bf(hi) << 16); }
__device__ __forceinline__ float bflo(unsigned v) { return __builtin_bit_cast(float, v << 16); }
__device__ __forceinline__ float bfhi(unsigned v) { return __builtin_bit_cast(float, v & 0xffff0000u); }
__device__ __forceinline__ float wave_sum(float v) {
#pragma unroll
    for (int o = 1; o < 64; o <<= 1) v += __shfl_xor(v, o);
    return v;
}
__device__ __forceinline__ float wave_max(float v) {
#pragma unroll
    for (int o = 1; o < 64; o <<= 1) v = fmaxf(v, __shfl_xor(v, o));
    return v;
}
__device__ __forceinline__ float sigmoidf_(float v) { return 1.0f / (1.0f + __expf(-v)); }

#define XB_TMO      128
#define XB_XCNT(j)  (256  + 64 * (j))
#define XB_XSUB(j)  (1280 + 64 * (j))
#define XB_XGEN(j)  (2304 + 64 * (j))
#define XB_TOP      3328
#define XB_TOPGEN   3392
#define XCD_BAR_WORDS 3456
#define XB_SPIN_CAP (1u << 18)

__device__ __forceinline__ unsigned xb_ld(unsigned* p)              { return __hip_atomic_load(p, __ATOMIC_RELAXED, __HIP_MEMORY_SCOPE_AGENT); }
__device__ __forceinline__ unsigned xb_add(unsigned* p, unsigned v) { return __hip_atomic_fetch_add(p, v, __ATOMIC_RELAXED, __HIP_MEMORY_SCOPE_AGENT); }
__device__ __forceinline__ unsigned xb_xcc_id() { return (unsigned)__builtin_amdgcn_s_getreg((3 << 11) | 20) & 0xFu; }
#define XB_SPIN(cond, bar) do { unsigned _sp = 0; while (cond) { __builtin_amdgcn_s_sleep(1); \
    if ((++_sp & 255u) == 0u) { if (xb_ld(&(bar)[XB_TMO])) break; if (_sp > XB_SPIN_CAP) { atomicAdd(&(bar)[XB_TMO], 1u); break; } } } } while (0)

struct XcdBarrier { unsigned* bar; unsigned x; volatile LAS unsigned* st; };

__device__ __forceinline__ XcdBarrier xcd_barrier_post(unsigned* bar, volatile LAS unsigned* st) {
    XcdBarrier b; b.bar = bar; b.x = xb_xcc_id(); b.st = st;
    if (threadIdx.x == 0) (void)xb_add(&bar[XB_XCNT(b.x)], 1u);
    return b;
}
__device__ __forceinline__ void xcd_barrier_complete(unsigned* bar, unsigned x, unsigned& nloc, unsigned& nx) {
    const unsigned G = gridDim.x * gridDim.y * gridDim.z;
    unsigned sum, cnt, mine, sp = 0u;
    for (;;) {
        sum = 0u; cnt = 0u; mine = 0u;
#pragma unroll
        for (unsigned j = 0; j < 16; ++j) { const unsigned c = xb_ld(&bar[XB_XCNT(j)]); sum += c; cnt += (c > 0u) ? 1u : 0u; mine = (j == x) ? c : mine; }
        if (sum == G) break;
        __builtin_amdgcn_s_sleep(1);
        if ((++sp & 255u) == 0u) { if (xb_ld(&bar[XB_TMO])) break; if (sp > XB_SPIN_CAP) { atomicAdd(&bar[XB_TMO], 1u); break; } }
    }
    nloc = mine > 0u ? mine : 1u; nx = cnt > 0u ? cnt : 1u;
}
__device__ __forceinline__ void xcd_barrier(const XcdBarrier& b) {
    asm volatile("s_waitcnt vmcnt(0)" ::: "memory");
    __syncthreads();
    if (threadIdx.x == 0) {
        unsigned* bar = b.bar;
        __builtin_amdgcn_s_waitcnt(0);
        unsigned nloc = b.st[0], nx = b.st[1];
        if (nloc == 0u) { xcd_barrier_complete(bar, b.x, nloc, nx); b.st[0] = nloc; b.st[1] = nx; }
        const unsigned old = xb_add(&bar[XB_XSUB(b.x)], 1u);
        const unsigned gen = old / nloc;
        if (old + 1u == (gen + 1u) * nloc) {
            __builtin_amdgcn_fence(__ATOMIC_RELEASE, "agent");
            asm volatile("s_waitcnt vmcnt(0)" ::: "memory");
            const unsigned og = xb_add(&bar[XB_TOP], 1u);
            const unsigned tg = og / nx;
            if (og + 1u == (tg + 1u) * nx) xb_add(&bar[XB_TOPGEN], 1u);
            else XB_SPIN(xb_ld(&bar[XB_TOPGEN]) == tg, bar);
            __builtin_amdgcn_fence(__ATOMIC_ACQUIRE, "agent");
            xb_add(&bar[XB_XGEN(b.x)], 1u);
            asm volatile("s_waitcnt vmcnt(0)" ::: "memory");
        } else {
            XB_SPIN(xb_ld(&bar[XB_XGEN(b.x)]) == gen, bar);
            __builtin_amdgcn_fence(__ATOMIC_ACQUIRE, "agent");
            asm volatile("s_waitcnt vmcnt(0)" ::: "memory");
        }
    }
    __syncthreads();
}

struct Frame {
    LAS unsigned char* lds;
    volatile LAS unsigned* MISC;
    gu32* ctl;
    int tid, lane, wave;
    int vcu, G;
    const float *x, *c, *w_ada, *b_ada, *n1g, *n2g, *w_in, *w_out, *qng, *kng, *lamp, *subg, *cdw, *cdb, *clg, *clb, *scw, *poolw, *poolsc, *w_ff1, *w_ff2;
    float* out;
    unsigned char* ws;
    float *MOD, *BIAS1, *BIAS2, *SSQ1, *SSQ2;
    bf16 *HA, *XB, *PROJ, *MIX, *HID;
};
__device__ __forceinline__ bf16* wt_ptr(const Frame& F, int l, size_t off) { return (bf16*)(F.ws + WS_WT + (size_t)l * WT_LAYER + off); }

__device__ __forceinline__ void mod_item(Frame& F, int l, int strip) {
    const int j0 = strip * 32, tid = F.tid;
    LAS float* cact = (LAS float*)(F.lds);
    LAS float* red = (LAS float*)(F.lds + 32768);
    for (int i = tid; i < 8192; i += NWAVES * 64) { const int b = i >> 10, k = i & 1023; const float v = F.c[b * 1024 + k]; cact[k * 8 + b] = v * sigmoidf_(v); }
    __syncthreads();
    {
        const int col4 = tid & 7, kp = tid >> 3;
        const float* wp = F.w_ada + ((size_t)l * 1024 + kp * 16) * NMOD + j0 + col4 * 4;
        f32x4 w[16];
#pragma unroll
        for (int k = 0; k < 16; ++k) w[k] = *(const f32x4*)(wp + (size_t)k * NMOD);
        f32x4 acc[8];
#pragma unroll
        for (int b = 0; b < 8; ++b) acc[b] = (f32x4){0.f, 0.f, 0.f, 0.f};
#pragma unroll
        for (int k = 0; k < 16; ++k) {
            const LAS f32x4* ca = (const LAS f32x4*)(cact + (kp * 16 + k) * 8);
            const f32x4 c0 = ca[0], c1 = ca[1];
            acc[0] += w[k] * c0[0]; acc[1] += w[k] * c0[1]; acc[2] += w[k] * c0[2]; acc[3] += w[k] * c0[3];
            acc[4] += w[k] * c1[0]; acc[5] += w[k] * c1[1]; acc[6] += w[k] * c1[2]; acc[7] += w[k] * c1[3];
        }
#pragma unroll
        for (int b = 0; b < 8; ++b) *(LAS f32x4*)(red + (kp * 8 + b) * 32 + col4 * 4) = acc[b];
    }
    __syncthreads();
    if (tid < 256) { const int b = tid >> 5, cc = tid & 31; float s = F.b_ada[l * NMOD + j0 + cc];
#pragma unroll 16
        for (int kp = 0; kp < 64; ++kp) s += red[(kp * 8 + b) * 32 + cc];
        F.MOD[((size_t)l * 8 + b) * NMOD + j0 + cc] = s; }
    __syncthreads();
}
constexpr int TS = 260;
__device__ __forceinline__ void transpose_item(Frame& F, const float* W, int K, int N, bf16* WT, int kb, int nb, const float* Wp, const float* psc, int mode = 0) {
    const int k0 = 64 * kb, n0 = 256 * nb, lane = F.lane, wv = F.wave;
    LAS float* tile = (LAS float*)(F.lds);
    {
        f32x4 v[8];
#pragma unroll
        for (int i = 0; i < 8; ++i) v[i] = *(const f32x4*)(W + (size_t)(k0 + 8 * wv + i) * N + n0 + 4 * lane);
#pragma unroll
        for (int i = 0; i < 8; ++i) { if (psc) v[i] = v[i] * psc[8 * wv + i]; if (mode < 3) *(LAS f32x4*)(tile + (8 * wv + i) * TS + 4 * lane) = v[i]; else asm volatile("" :: "v"(v[i])); }
    }
    LDS_WAIT(); __syncthreads();
    if (mode >= 2) return;
    if (Wp) {
        typedef float f32x4_t __attribute__((ext_vector_type(4)));
        const int li = lane & 15, lk = lane >> 4;
        f32x4_t acc[4][2];
#pragma unroll
        for (int ct = 0; ct < 4; ++ct) { acc[ct][0] = (f32x4_t){0.f, 0.f, 0.f, 0.f}; acc[ct][1] = acc[ct][0]; }
#pragma unroll 4
        for (int d0 = 0; d0 < 64; d0 += 4) {
            const float b0 = tile[(d0 + lk) * TS + 32 * wv + li], b1 = tile[(d0 + lk) * TS + 32 * wv + 16 + li];
#pragma unroll
            for (int ct = 0; ct < 4; ++ct) { const float a = Wp[(16 * ct + li) * 64 + d0 + lk];
                acc[ct][0] = __builtin_amdgcn_mfma_f32_16x16x4f32(a, b0, acc[ct][0], 0, 0, 0); acc[ct][1] = __builtin_amdgcn_mfma_f32_16x16x4f32(a, b1, acc[ct][1], 0, 0, 0); }
        }
        LDS_WAIT(); __syncthreads();
#pragma unroll
        for (int ct = 0; ct < 4; ++ct)
#pragma unroll
            for (int r = 0; r < 4; ++r) { tile[(16 * ct + 4 * lk + r) * TS + 32 * wv + li] = acc[ct][0][r]; tile[(16 * ct + 4 * lk + r) * TS + 32 * wv + 16 + li] = acc[ct][1][r]; }
        LDS_WAIT(); __syncthreads();
    }
    {
        const int n = 32 * wv + (lane & 31), ch = lane >> 5;
#pragma unroll
        for (int j = 0; j < 4; ++j) { const int c = 4 * ch + j; const LAS float* s = tile + (8 * c) * TS + n;
            v4u o; o.x = pk2(s[0 * TS], s[1 * TS]); o.y = pk2(s[2 * TS], s[3 * TS]); o.z = pk2(s[4 * TS], s[5 * TS]); o.w = pk2(s[6 * TS], s[7 * TS]);
            if (mode == 0) *(GAS v4u*)(WT + (size_t)(n0 + n) * K + k0 + 8 * c) = o; else asm volatile("" :: "v"(o)); }
    }
    LDS_WAIT(); __syncthreads();
}
__device__ __forceinline__ void prep_layer(Frame& F, int L, int rank, int nranks, int what = 3) {
    constexpr int I_MOD = NMOD / 32, I_IN = (DM / 64) * (NIN / 256), I_OUT = (DM / 64) * (DM / 256), I_1 = (DM / 64) * (FF / 256), I_2 = (FF / 64) * (DM / 256), I_ALL = I_MOD + I_IN + I_OUT + I_1 + I_2;
    const int l = L;
#pragma unroll 1
    for (int it = rank; it < I_ALL; it += nranks) {
        int r = it;
        if (r < I_MOD) { if (what & 1) mod_item(F, l, r); continue; } r -= I_MOD;
        if (!(what & 2)) continue;
        if (r < I_IN) { transpose_item(F, F.w_in + (size_t)l * DM * NIN, DM, NIN, wt_ptr(F, l, WT_IN), r / (NIN / 256), r % (NIN / 256), nullptr, nullptr, what >> 2); continue; } r -= I_IN;
        if (r < I_OUT) { const int kb = r / 4, nb = r % 4;
            if (kb < 12) transpose_item(F, F.w_out + (size_t)l * DM * DM, DM, DM, wt_ptr(F, l, WT_OUT), kb, nb, nullptr, nullptr, what >> 2);
            else transpose_item(F, F.w_out + (size_t)l * DM * DM, DM, DM, wt_ptr(F, l, WT_OUT), kb, nb, F.poolw + ((size_t)l * 4 + (kb - 12)) * 4096, F.poolsc + l * 256 + 64 * (kb - 12), what >> 2);
            continue; } r -= I_OUT;
        if (r < I_1) { transpose_item(F, F.w_ff1 + (size_t)l * DM * FF, DM, FF, wt_ptr(F, l, WT_FF1), r / (FF / 256), r % (FF / 256), nullptr, nullptr, what >> 2); continue; } r -= I_1;
        transpose_item(F, F.w_ff2 + (size_t)l * FF * DM, FF, DM, wt_ptr(F, l, WT_FF2), r / 4, r % 4, nullptr, nullptr, what >> 2);
    }
}
__device__ __forceinline__ void bias_layer(Frame& F, int l) {
    const int gw = F.vcu * NWAVES + F.wave, NGW = F.G * NWAVES, lane = F.lane;
#pragma unroll 1
    for (int kind = 0; kind < 2; ++kind) {
        const int N = kind ? FF : NIN;
        const bf16* Wt = wt_ptr(F, l, kind ? WT_FF1 : WT_IN);
        const float* sh = F.MOD + (size_t)l * 8 * NMOD + (kind ? 3072 : 0);
        float* outp = kind ? F.BIAS2 + (size_t)l * 8 * FF : F.BIAS1 + (size_t)l * 8 * NIN;
        f32x4 shr[8][4];
#pragma unroll
        for (int b = 0; b < 8; ++b)
#pragma unroll
            for (int j = 0; j < 4; ++j) shr[b][j] = *(const f32x4*)(sh + (size_t)b * NMOD + 16 * lane + 4 * j);
        for (int n = gw; n < N; n += NGW) {
            const v4u w0 = *(const v4u*)(Wt + (size_t)n * DM + 16 * lane), w1 = *(const v4u*)(Wt + (size_t)n * DM + 16 * lane + 8);
            const f32x4 wv0 = (f32x4){bflo(w0.x), bfhi(w0.x), bflo(w0.y), bfhi(w0.y)}, wv1 = (f32x4){bflo(w0.z), bfhi(w0.z), bflo(w0.w), bfhi(w0.w)};
            const f32x4 wv2 = (f32x4){bflo(w1.x), bfhi(w1.x), bflo(w1.y), bfhi(w1.y)}, wv3 = (f32x4){bflo(w1.z), bfhi(w1.z), bflo(w1.w), bfhi(w1.w)};
            float a[8];
#pragma unroll
            for (int b = 0; b < 8; ++b) { const f32x4 t = shr[b][0] * wv0 + shr[b][1] * wv1 + shr[b][2] * wv2 + shr[b][3] * wv3; a[b] = wave_sum((t[0] + t[1]) + (t[2] + t[3])); }
            if (lane == 0) {
#pragma unroll
                for (int b = 0; b < 8; ++b) outp[(size_t)b * N + n] = a[b]; }
        }
    }
}
__device__ __forceinline__ void p0b(Frame& F) {
#pragma unroll 1
    for (int L = 0; L < (PREP_UPFRONT ? DEPTH : 1); ++L) bias_layer(F, L);
    const int gw = F.vcu * NWAVES + F.wave, NGW = F.G * NWAVES, lane = F.lane;
    for (int m = gw; m < M; m += NGW) {
        const int b = m >> 11; const GAS f32x4* xr = (const GAS f32x4*)(F.x + (size_t)m * DM) + lane;
        const f32x4* gr = (const f32x4*)(F.n1g) + lane; const f32x4* sr = (const f32x4*)(F.MOD + (size_t)b * NMOD + 1024) + lane;
        float ss = 0.f; GAS v2u* o8 = (GAS v2u*)(F.HA + (size_t)m * DM) + lane;
#pragma unroll
        for (int j = 0; j < 4; ++j) { const f32x4 v = xr[64 * j]; ss += (v[0] * v[0] + v[1] * v[1]) + (v[2] * v[2] + v[3] * v[3]);
            const f32x4 h = v * gr[64 * j] * (sr[64 * j] + 1.0f); v2u w; w.x = pk2(h[0], h[1]); w.y = pk2(h[2], h[3]); o8[64 * j] = w; }
        ss = wave_sum(ss);
        if (lane < 16) F.SSQ1[(size_t)lane * M + m] = lane == 0 ? ss : 0.f;
    }
}
__device__ __forceinline__ void rstd_table(Frame& F, const pg8::StaticOrder& S, const float* ssq) {
    LAS float* tab = (LAS float*)(F.lds + RT_OFF);
    pg8::Unit u;
    for (int ui = 0; ui < 8 && S.next(ui, u); ++ui) {
        if (F.tid < 256) { const int row = u.pm * 256 + F.tid; float s = 0.f;
#pragma unroll
            for (int p = 0; p < 16; ++p) s += ssq[(size_t)p * M + row];
            tab[ui * 256 + F.tid] = __builtin_amdgcn_rsqf(s * (1.0f / DM) + EPS); }
    }
    LDS_WAIT(); __syncthreads();
}

__device__ __forceinline__ s16x4 vtr(const LAS unsigned char* p) { typedef short v4i16_t __attribute__((ext_vector_type(4))); return __builtin_bit_cast(s16x4, __builtin_amdgcn_ds_read_tr16_b64_v4i16((LAS v4i16_t*)p)); }
__device__ __forceinline__ void glds16(const void* gsrc, LAS unsigned char* dst) { __builtin_amdgcn_global_load_lds((const unsigned*)gsrc, (LAS unsigned*)dst, 16, 0, 0); }
__device__ __forceinline__ void attn_qk(f32x4 (&s)[2][4], const LAS unsigned char* kb_, bf16x8 q0, bf16x8 q1, f32x4 negM) {
#pragma unroll
    for (int kb = 0; kb < 4; ++kb) { const bf16x8 k0 = *(const LAS bf16x8*)(kb_ + kb * 256), k1 = *(const LAS bf16x8*)(kb_ + 4096 + kb * 256);
        s[0][kb] = __builtin_amdgcn_mfma_f32_16x16x32_bf16(k0, q0, negM, 0, 0, 0); s[1][kb] = __builtin_amdgcn_mfma_f32_16x16x32_bf16(k1, q1, negM, 0, 0, 0); }
}
__device__ __forceinline__ void attn_pv(f32x4 (&s)[2][4], f32x4 (&o)[2][4], f32x4 (&ol)[2], const LAS unsigned char* vb_, int vE, int vO, bool band, int key0, int qrow) {
    if (band) {
#pragma unroll
        for (int kb = 0; kb < 4; ++kb)
#pragma unroll
            for (int r = 0; r < 4; ++r) { const int key = key0 + 16 * kb + r; if (key > qrow) { s[0][kb][r] = -INFINITY; s[1][kb][r] = -INFINITY; } }
    }
#pragma unroll
    for (int kb = 0; kb < 4; ++kb)
#pragma unroll
        for (int r = 0; r < 4; ++r) { s[0][kb][r] = __builtin_amdgcn_exp2f(s[0][kb][r]); s[1][kb][r] = __builtin_amdgcn_exp2f(s[1][kb][r]); }
    bf16x8 pw[2][2];
#pragma unroll
    for (int m = 0; m < 2; ++m)
#pragma unroll
        for (int ks = 0; ks < 2; ++ks) { v4u w; w.x = pg8::cvt_pk_bf16(s[m][2 * ks][0], s[m][2 * ks][1]); w.y = pg8::cvt_pk_bf16(s[m][2 * ks][2], s[m][2 * ks][3]);
            w.z = pg8::cvt_pk_bf16(s[m][2 * ks + 1][0], s[m][2 * ks + 1][1]); w.w = pg8::cvt_pk_bf16(s[m][2 * ks + 1][2], s[m][2 * ks + 1][3]); pw[m][ks] = __builtin_bit_cast(bf16x8, w); }
    const bf16x8 ones = (bf16x8){0x3F80, 0x3F80, 0x3F80, 0x3F80, 0x3F80, 0x3F80, 0x3F80, 0x3F80};
#pragma unroll
    for (int ks = 0; ks < 2; ++ks) {
#pragma unroll
        for (int d0 = 0; d0 < 4; ++d0) { const LAS unsigned char* vp = vb_ + ((d0 & 1) ? vO : vE) + (d0 >> 1) * 4096 + (2 * ks) * 1024;
            const s16x4 lo = vtr(vp), hi = vtr(vp + 1024);
            const bf16x8 vf = (bf16x8){lo[0], lo[1], lo[2], lo[3], hi[0], hi[1], hi[2], hi[3]};
            o[0][d0] = __builtin_amdgcn_mfma_f32_16x16x32_bf16(pw[0][ks], vf, o[0][d0], 0, 0, 0);
            o[1][d0] = __builtin_amdgcn_mfma_f32_16x16x32_bf16(pw[1][ks], vf, o[1][d0], 0, 0, 0); }
        ol[0] = __builtin_amdgcn_mfma_f32_16x16x32_bf16(pw[0][ks], ones, ol[0], 0, 0, 0);
        ol[1] = __builtin_amdgcn_mfma_f32_16x16x32_bf16(pw[1][ks], ones, ol[1], 0, 0, 0); }
}
__device__ __forceinline__ void attn_epilogue(Frame& F, const f32x4 (&o)[2][4], const f32x4 (&ol)[2], const float (&sgv)[4], float lam, bf16* op) {
    const int lane = F.lane;
#pragma unroll
    for (int r = 0; r < 4; ++r) {
        const float a0 = 1.0f / ol[0][r], a1 = lam / ol[1][r];
        float ov[4], ss = 0.f;
#pragma unroll
        for (int d0 = 0; d0 < 4; ++d0) { ov[d0] = o[0][d0][r] * a0 - o[1][d0][r] * a1; ss += ov[d0] * ov[d0]; }
        ss += __shfl_xor(ss, 1); ss += __shfl_xor(ss, 2); ss += __shfl_xor(ss, 4); ss += __shfl_xor(ss, 8);
        const float rn = __builtin_amdgcn_rsqf(ss * (1.0f / 64.0f) + EPS);
#pragma unroll
        for (int d0 = 0; d0 < 4; ++d0) op[(size_t)r * DM + 16 * d0] = (bf16)f2bf(ov[d0] * rn * sgv[d0]);
    }
    (void)lane;
}
__device__ __forceinline__ void attn_pair(Frame& F, int l, int b, int h, int sidx, float lam, float negMv, float outscale) {
    const int lane = F.lane, wid = F.wave, fr = lane & 15, fq = lane >> 4;
    LAS unsigned char* lds = F.lds;
    const size_t rowbase = (size_t)b * SEQ;
    const bf16* proj = F.PROJ;
    const int qbA = 15 - sidx, qbB = sidx, NTa = 2 * (qbA + 1), NTb = 2 * (qbB + 1), S = NTa + NTb;
    const bf16* qpA = proj + (rowbase + qbA * 128 + 16 * wid + fr) * NIN + h * 64 + 8 * fq;
    const bf16* qpB = proj + (rowbase + qbB * 128 + 16 * wid + fr) * NIN + h * 64 + 8 * fq;
    const bf16x8 qa0 = *(const bf16x8*)qpA, qa1 = *(const bf16x8*)(qpA + 32), qb0 = *(const bf16x8*)qpB, qb1 = *(const bf16x8*)(qpB + 32);
    const bf16* ksrc = proj + (rowbase + lane) * NIN + 256 + h * 64 + wid * 8;
    const bf16* vsrc = proj + (rowbase + 16 * (wid & 3) + (lane >> 2)) * NIN + 512 + h * 64 + (wid >> 2) * 32 + 8 * ((lane & 3) ^ (2 * ((lane >> 4) & 1)));
    LAS unsigned char* kdst = lds + wid * 1024;
    LAS unsigned char* vdst = lds + 16384 + wid * 1024;
    f32x4 o[2][4], ol[2];
#pragma unroll
    for (int m = 0; m < 2; ++m) { ol[m] = (f32x4){0.f, 0.f, 0.f, 0.f};
#pragma unroll
        for (int d = 0; d < 4; ++d) o[m][d] = (f32x4){0.f, 0.f, 0.f, 0.f}; }
    const f32x4 negM = (f32x4){negMv, negMv, negMv, negMv};
    const int koff = fq * 1024 + fr * 16;
    const int prow = fr >> 2, pp = fr & 3;
    const int vrow = (4 * fq + prow) * 64 + (pp & 1) * 8 + (pp >> 1) * 16;
    const int vE = vrow + 32 * (fq & 1), vO = vrow + 32 * (1 - (fq & 1));
    float sgv[4];
#pragma unroll
    for (int d0 = 0; d0 < 4; ++d0) sgv[d0] = F.subg[l * 64 + 16 * d0 + fr] * outscale;
#define ATT_TILE(s) ((s) < NTa ? (s) : (s) - NTa)
    glds16(ksrc + (size_t)ATT_TILE(0) * 64 * NIN, kdst); glds16(vsrc + (size_t)ATT_TILE(0) * 64 * NIN, vdst); glds16(ksrc + (size_t)ATT_TILE(1) * 64 * NIN, kdst + 8192);
    VM_WAIT(); __syncthreads();
    f32x4 sA[2][4], sB[2][4];
    attn_qk(sA, lds + koff, qa0, qa1, negM);
#define ATT_STEP(s, CUR, NXT) do { \
        VM_WAIT(); __syncthreads(); \
        if ((s) + 2 < S) glds16(ksrc + (size_t)ATT_TILE((s) + 2) * 64 * NIN, kdst + ((s) & 1) * 8192); \
        if ((s) + 1 < S) glds16(vsrc + (size_t)ATT_TILE((s) + 1) * 64 * NIN, vdst + (((s) + 1) & 1) * 8192); \
        if ((s) + 1 < S) { const bool nb_ = ((s) + 1 >= NTa); attn_qk(NXT, lds + (((s) + 1) & 1) * 8192 + koff, nb_ ? qb0 : qa0, nb_ ? qb1 : qa1, negM); } \
        { const bool inB_ = (s) >= NTa; const int tile_ = ATT_TILE(s), NTu_ = inB_ ? NTb : NTa, q0_ = (inB_ ? qbB : qbA) * 128; \
          attn_pv(CUR, o, ol, lds + 16384 + ((s) & 1) * 8192, vE, vO, tile_ >= NTu_ - 2, 64 * tile_ + 4 * fq, q0_ + 16 * wid + fr); \
          if (tile_ == NTu_ - 1) { attn_epilogue(F, o, ol, sgv, lam, F.MIX + (rowbase + q0_ + 16 * wid + 4 * fq) * DM + h * 64 + fr); \
              _Pragma("unroll") for (int m_ = 0; m_ < 2; ++m_) { ol[m_] = (f32x4){0.f, 0.f, 0.f, 0.f}; _Pragma("unroll") for (int d_ = 0; d_ < 4; ++d_) o[m_][d_] = (f32x4){0.f, 0.f, 0.f, 0.f}; } } } \
    } while (0)
#pragma unroll 1
    for (int s = 0; s < S; s += 2) { ATT_STEP(s, sA, sB); ATT_STEP(s + 1, sB, sA); }
#undef ATT_STEP
#undef ATT_TILE
    __syncthreads();
}
__device__ __forceinline__ void attn_phase(Frame& F, int l) {
    const int lane = F.lane; const float* lp = F.lamp + l * 128;
    float pa = lane < 32 ? lp[lane] * lp[32 + lane] : 0.f, pb = lane < 32 ? lp[64 + lane] * lp[96 + lane] : 0.f;
    pa = wave_sum(pa); pb = wave_sum(pb);
    const float lam_init = 0.8f - 0.6f * __expf(-0.3f * (float)l);
    const float lam = __expf(pa) - __expf(pb) + lam_init;
    const float gq = wave_max(fabsf(F.qng[l * 32 + (lane & 31)])), gk = wave_max(fabsf(F.kng[l * 32 + (lane & 31)]));
    const float negMv = -(QSCALE * 32.0f * gq * gk);
    for (int pi = F.vcu; pi < 256; pi += F.G) {
        const int bh = pi >> 3, s = pi & 7;
        attn_pair(F, l, bh >> 2, bh & 3, s, lam, negMv, 1.0f - lam_init);
    }
}
__device__ __forceinline__ unsigned bld(__amdgpu_buffer_rsrc_t r, int voff, int soff) { return __builtin_amdgcn_raw_buffer_load_b32(r, voff, soff, 0); }
__device__ __forceinline__ f32x2 bld2(__amdgpu_buffer_rsrc_t r, int voff, int soff) { typedef unsigned u2 __attribute__((ext_vector_type(2))); const u2 v = __builtin_amdgcn_raw_buffer_load_b64(r, voff, soff, 0); return __builtin_bit_cast(f32x2, v); }
__device__ __forceinline__ void mixer_tile(Frame& F, int l, int tt) {
    const int tid = F.tid, lane = F.lane; const int b = tt >> 5, s0 = (tt & 31) * 64; const int rowbase = b * SEQ;
    LAS float* cbuf = (LAS float*)F.lds;
    const int c2 = (tid & 127) * 2, tq = F.wave >> 1, sb = s0 + 16 * tq;
    const __amdgpu_buffer_rsrc_t rp = __builtin_amdgcn_make_buffer_rsrc((void*)F.PROJ, 0, (int)((size_t)M * NIN * 2), 0x00020000);
    const __amdgpu_buffer_rsrc_t rm = __builtin_amdgcn_make_buffer_rsrc((void*)F.MIX, 0, (int)((size_t)M * DM * 2), 0x00020000);
    const int vo = c2 * 2;
    {
        unsigned cgr[18], xcr[18], bgr[16], udr[31];
#pragma unroll
        for (int j = 0; j < 18; ++j) { const int s = sb - 2 + j, sc = s < 0 ? 0 : s; const int so = (rowbase + sc) * (NIN * 2) + 1536 * 2; cgr[j] = bld(rp, vo, so); xcr[j] = bld(rp, vo, so + 512); }
#pragma unroll
        for (int j = 0; j < 16; ++j) bgr[j] = bld(rp, vo, (rowbase + sb + j) * (NIN * 2) + 1280 * 2);
#pragma unroll
        for (int j = 0; j < 31; ++j) { const int s = sb - 15 + j, sc = s < 0 ? 0 : s; udr[j] = bld(rp, vo, (rowbase + sc) * (NIN * 2) + 2048 * 2); }
        const __amdgpu_buffer_rsrc_t rw = __builtin_amdgcn_make_buffer_rsrc((void*)(F.scw + (size_t)l * 3 * 256), 0, 3 * 256 * 4, 0x00020000);
        f32x2 w3[3];
#pragma unroll
        for (int k = 0; k < 3; ++k) w3[k] = bld2(rw, c2 * 4, k * 1024);
        f32x2 pr[18];
#pragma unroll
        for (int j = 0; j < 18; ++j) { const float ok = (sb - 2 + j) >= 0 ? 1.f : 0.f; pr[j] = (f32x2){bflo(cgr[j]) * bflo(xcr[j]) * ok, bfhi(cgr[j]) * bfhi(xcr[j]) * ok}; }
#pragma unroll
        for (int i = 0; i < 16; ++i) { const f32x2 cv = w3[0] * pr[i] + w3[1] * pr[i + 1] + w3[2] * pr[i + 2];
            __builtin_amdgcn_raw_buffer_store_b32(pk2(bflo(bgr[i]) * cv[0], bfhi(bgr[i]) * cv[1]), rm, vo, (rowbase + sb + i) * (DM * 2) + 512 * 2, 0); }
        const int win = 2 << (c2 >> 6);
#pragma unroll
        for (int i = 0; i < 16; ++i) { f32x2 sum = (f32x2){0.f, 0.f};
#pragma unroll
            for (int k = 1; k < 16; ++k) { const float ok = (k < win && sb + i - k >= 0) ? 1.f : 0.f; sum += (f32x2){bflo(udr[15 + i - k]), bfhi(udr[15 + i - k])} * ok; }
            const int s = sb + i; const float rc = 1.0f / (float)((s + 1 < win) ? (s + 1) : win); const f32x2 ut = (f32x2){bflo(udr[15 + i]), bfhi(udr[15 + i])}; const f32x2 y = (sum + ut) * rc - ut;
            __builtin_amdgcn_raw_buffer_store_b32(pk2(y[0], y[1]), rm, vo, (rowbase + s) * (DM * 2) + 768 * 2, 0); }
    }
    {
        unsigned rv[46], rg[46];
#pragma unroll
        for (int j = 0; j < 46; ++j) { const int s = sb - 30 + j, sc = s < 0 ? 0 : s; const int so = (rowbase + sc) * (NIN * 2) + 768 * 2; rv[j] = bld(rp, vo, so); rg[j] = bld(rp, vo, so + 512); }
        const __amdgpu_buffer_rsrc_t rw = __builtin_amdgcn_make_buffer_rsrc((void*)(F.cdw + (size_t)l * 31 * 256), 0, 31 * 256 * 4, 0x00020000);
        f32x2 w[31];
#pragma unroll
        for (int k = 0; k < 31; ++k) w[k] = bld2(rw, c2 * 4, k * 1024);
        f32x2 acc[16];
        const f32x2 bias = *(const f32x2*)(F.cdb + l * 256 + c2);
#pragma unroll
        for (int i = 0; i < 16; ++i) acc[i] = bias;
#pragma unroll
        for (int j = 0; j < 46; ++j) { const float ok = (sb - 30 + j) >= 0 ? 1.f : 0.f;
            const f32x2 hv = (f32x2){bflo(rv[j]) * sigmoidf_(bflo(rg[j])) * ok, bfhi(rv[j]) * sigmoidf_(bfhi(rg[j])) * ok};
#pragma unroll
            for (int i = 0; i < 16; ++i) { if (j - i >= 0 && j - i <= 30) acc[i] += w[j - i] * hv; } }
#pragma unroll
        for (int i = 0; i < 16; ++i) *(LAS f32x2*)(cbuf + (16 * tq + i) * 256 + c2) = acc[i];
    }
    LDS_WAIT(); __syncthreads();
    {
        const f32x4 g = *(const f32x4*)(F.clg + l * 256 + 4 * lane), bb = *(const f32x4*)(F.clb + l * 256 + 4 * lane);
#pragma unroll 2
        for (int i = 0; i < 8; ++i) { const int t = 8 * F.wave + i; const f32x4 v = *(const LAS f32x4*)(cbuf + t * 256 + 4 * lane);
            const float mu = wave_sum((v[0] + v[1]) + (v[2] + v[3])) * (1.0f / 256.0f); const f32x4 d = v - mu;
            const float var = wave_sum((d[0] * d[0] + d[1] * d[1]) + (d[2] * d[2] + d[3] * d[3])) * (1.0f / 256.0f);
            const float rs = __builtin_amdgcn_rsqf(var + EPS); f32x4 y = d * rs * g + bb;
            y[0] *= sigmoidf_(y[0]); y[1] *= sigmoidf_(y[1]); y[2] *= sigmoidf_(y[2]); y[3] *= sigmoidf_(y[3]);
            v2u w; w.x = pk2(y[0], y[1]); w.y = pk2(y[2], y[3]);
            *(v2u*)(F.MIX + ((size_t)rowbase + s0 + t) * DM + 256 + 4 * lane) = w; }
    }
    __syncthreads();
}

struct Args { const float* in[21]; float* out; unsigned char* ws; int ph_lo, ph_hi, li, pad; };
__global__ void __launch_bounds__(NWAVES * 64, 2) trunk_fwd(Args args) {
    extern __shared__ __attribute__((aligned(16))) unsigned char lds[];
    Frame F;
    F.lds = (LAS unsigned char*)lds;
    F.MISC = (volatile LAS unsigned*)(F.lds + MISC_OFF);
    F.tid = threadIdx.x; F.lane = F.tid & 63; F.wave = __builtin_amdgcn_readfirstlane(F.tid >> 6);
    F.G = gridDim.x; { const int bx = blockIdx.x; F.vcu = (F.G % 8 == 0) ? (bx % 8) * (F.G / 8) + bx / 8 : bx; }
    unsigned char* ws = args.ws; F.ws = ws;
    F.ctl = (gu32*)(ws + WS_CTL);
    F.x = args.in[0]; F.c = args.in[1]; F.w_ada = args.in[2]; F.b_ada = args.in[3]; F.n1g = args.in[4]; F.n2g = args.in[5]; F.w_in = args.in[6]; F.w_out = args.in[7];
    F.qng = args.in[8]; F.kng = args.in[9]; F.lamp = args.in[10]; F.subg = args.in[11]; F.cdw = args.in[12]; F.cdb = args.in[13]; F.clg = args.in[14]; F.clb = args.in[15];
    F.scw = args.in[16]; F.poolw = args.in[17]; F.poolsc = args.in[18]; F.w_ff1 = args.in[19]; F.w_ff2 = args.in[20]; F.out = args.out;
    F.MOD = (float*)(ws + WS_MOD); F.BIAS1 = (float*)(ws + WS_BIAS1); F.BIAS2 = (float*)(ws + WS_BIAS2); F.SSQ1 = (float*)(ws + WS_SSQ1); F.SSQ2 = (float*)(ws + WS_SSQ2);
    F.HA = (bf16*)(ws + WS_HA); F.XB = (bf16*)(ws + WS_XB); F.PROJ = (bf16*)(ws + WS_PROJ); F.MIX = (bf16*)(ws + WS_MIX); F.HID = (bf16*)(ws + WS_HID);
    for (int u = F.tid; u < (LDS_BYTES - LDSCTL_OFF) / 4; u += NWAVES * 64) ((LAS unsigned*)(F.lds + LDSCTL_OFF))[u] = 0u;
    __syncthreads();
    XcdBarrier bar; bar.bar = (unsigned*)(F.ctl + CW_BAR); bar.x = 0; bar.st = nullptr;
    if (!MK_PER_PHASE) bar = xcd_barrier_post((unsigned*)(F.ctl + CW_BAR), F.MISC + 8);
    const int lo = args.ph_lo, hi = args.ph_hi;
#define IN(k) (lo <= (k) && (k) < hi)
#define SEAM(k) do { if (IN((k) + 1)) xcd_barrier(bar); } while (0)

#ifndef PROBE_DUP
#define PROBE_DUP 0
#endif
#ifndef PROBE_N
#define PROBE_N 2
#endif
#define REPS(k) (((PROBE_DUP >> (k)) & 1) ? PROBE_N : 1)
    if (IN(0)) { for (int rep = 0; rep < REPS(0); ++rep) { if (rep) xcd_barrier(bar);
#pragma unroll 1
        for (int L = 0; L < (PREP_UPFRONT ? DEPTH : 1); ++L) prep_layer(F, L, F.vcu, F.G, rep ? ((PROBE_DUP >> 8) & 15) : 3); } SEAM(0); }
    if (IN(1)) { for (int rep = 0; rep < REPS(1); ++rep) { if (rep) xcd_barrier(bar); p0b(F); } SEAM(1); }
#pragma unroll 1
    for (int l = 0; l < DEPTH; ++l) {
        const int p = 2 + 5 * l;
        { int tl = threadIdx.x; asm volatile("" : "+v"(tl)); F.tid = tl; F.lane = tl & 63; F.wave = __builtin_amdgcn_readfirstlane(tl >> 6); }
        int bxl = blockIdx.x; asm volatile("" : "+s"(bxl));
        const float* modl = F.MOD + (size_t)l * 8 * NMOD;
        if (IN(p)) {
            for (int rep = 0; rep < REPS(2); ++rep) { if (rep) { xcd_barrier(bar); int tl = threadIdx.x; asm volatile("" : "+v"(tl)); F.tid = tl; F.lane = tl & 63; F.wave = __builtin_amdgcn_readfirstlane(tl >> 6); asm volatile("" : "+s"(bxl)); }
            pg8::Gemm g{F.HA, wt_ptr(F, l, WT_IN), M, NIN, DM}; pg8::StaticOrder S; S.init(M, NIN, F.G, bxl);
            rstd_table(F, S, F.SSQ1);
            pg8::EpiProj E{F.PROJ, F.BIAS1 + (size_t)l * 8 * NIN, (const LAS float*)(F.lds + RT_OFF), F.qng + l * 32, F.kng + l * 32, QSCALE};
            pg8::gemm_phase<pg8::EpiProj, pg8::StaticOrder, true, true>(F.lds + RING_OFF, g, S, E, F.tid);
            if (!PREP_UPFRONT && l + 1 < DEPTH && !rep) {
                const int nun = (M / 256) * (NIN / 256), rounds = (nun + F.G - 1) / F.G, first_idle = nun - (rounds - 1) * F.G;
                if (first_idle >= F.G) prep_layer(F, l + 1, F.vcu, F.G); else if (bxl >= first_idle) prep_layer(F, l + 1, bxl - first_idle, F.G - first_idle); } }
            SEAM(p);
        }
        if (IN(p + 1)) {
            for (int rep = 0; rep < REPS(3); ++rep) { if (rep) xcd_barrier(bar); attn_phase(F, l); }
            for (int rep = 0; rep < REPS(4); ++rep) { if (rep) xcd_barrier(bar); for (int tt = F.vcu; tt < 256; tt += F.G) mixer_tile(F, l, tt); }
            if (!PREP_UPFRONT && l + 1 < DEPTH) bias_layer(F, l + 1);
            SEAM(p + 1);
        }
        if (IN(p + 2)) {
            for (int rep = 0; rep < REPS(5); ++rep) { if (rep) { xcd_barrier(bar); int tl = threadIdx.x; asm volatile("" : "+v"(tl)); F.tid = tl; F.lane = tl & 63; F.wave = __builtin_amdgcn_readfirstlane(tl >> 6); asm volatile("" : "+s"(bxl)); }
            pg8::Gemm g{F.MIX, wt_ptr(F, l, WT_OUT), M, DM, DM}; pg8::StaticOrder S; S.init(M, DM, F.G, bxl);
            pg8::EpiRes E{(l == 0 || rep) ? F.x : nullptr, F.XB, nullptr, rep ? F.PROJ : F.XB, modl + 2048, modl + 4096, F.n2g + l * DM, rep ? (bf16*)((unsigned char*)F.PROJ + 32 * MiB) : F.HA, rep ? (float*)((unsigned char*)F.PROJ + 64 * MiB) : F.SSQ2, 1};
            pg8::gemm_phase<pg8::EpiRes, pg8::StaticOrder, true, true>(F.lds + RING_OFF, g, S, E, F.tid); }
            SEAM(p + 2);
        }
        if (IN(p + 3)) {
            for (int rep = 0; rep < REPS(6); ++rep) { if (rep) { xcd_barrier(bar); int tl = threadIdx.x; asm volatile("" : "+v"(tl)); F.tid = tl; F.lane = tl & 63; F.wave = __builtin_amdgcn_readfirstlane(tl >> 6); asm volatile("" : "+s"(bxl)); }
            pg8::Gemm g{F.HA, wt_ptr(F, l, WT_FF1), M, FF, DM}; pg8::StaticOrder S; S.init(M, FF, F.G, bxl);
            rstd_table(F, S, F.SSQ2);
            pg8::EpiFF1 E{F.HID, F.BIAS2 + (size_t)l * 8 * FF, (const LAS float*)(F.lds + RT_OFF)};
            pg8::gemm_phase<pg8::EpiFF1, pg8::StaticOrder, true, true>(F.lds + RING_OFF, g, S, E, F.tid); }
            SEAM(p + 3);
        }
        if (IN(p + 4)) {
            for (int rep = 0; rep < REPS(7); ++rep) { if (rep) { xcd_barrier(bar); int tl = threadIdx.x; asm volatile("" : "+v"(tl)); F.tid = tl; F.lane = tl & 63; F.wave = __builtin_amdgcn_readfirstlane(tl >> 6); asm volatile("" : "+s"(bxl)); }
            pg8::Gemm g{F.HID, wt_ptr(F, l, WT_FF2), M, DM, FF}; pg8::StaticOrder S; S.init(M, DM, F.G, bxl);
            const int nl = l + 1 < DEPTH ? l + 1 : l;
            if (rep && l + 1 == DEPTH) break;
            pg8::EpiRes E{rep ? F.x : nullptr, F.XB, (l + 1 == DEPTH && !rep) ? F.out : nullptr, rep ? (bf16*)F.out : F.XB, modl + 5120, F.MOD + (size_t)nl * 8 * NMOD + 1024, F.n1g + nl * DM, rep ? (bf16*)((unsigned char*)F.out + 32 * MiB) : F.HA, rep ? (float*)(F.ws + WS_SSQ2) : F.SSQ1, (l + 1 < DEPTH || rep) ? 1 : 0};
            pg8::gemm_phase<pg8::EpiRes, pg8::StaticOrder, true, true>(F.lds + RING_OFF, g, S, E, F.tid); }
            if (l + 1 < DEPTH) SEAM(p + 4);
        }
    }
#undef IN
#undef SEAM
}

extern "C" void kernel_launch(void* const* d_in, const int* in_sizes, int n_in, void* d_out, int out_size, void* d_ws, size_t ws_size, hipStream_t stream) {
    static int grid = 0;
    if (grid == 0) {
        if (n_in != 21 || in_sizes[0] != M * DM || out_size != M * DM || ws_size < WS_END) { fprintf(stderr, "kernel_launch: unexpected problem shape (n_in %d, in0 %d, out %d, ws %zu, need %zu); nothing launched\n", n_in, n_in > 0 ? in_sizes[0] : -1, out_size, ws_size, (size_t)WS_END); grid = -1; return; }
        int dev = 0, cus = 0, per_cu = 0;
        if (hipGetDevice(&dev) != hipSuccess || hipDeviceGetAttribute(&cus, hipDeviceAttributeMultiprocessorCount, dev) != hipSuccess) { fprintf(stderr, "kernel_launch: device query failed\n"); grid = -1; return; }
        if (hipFuncSetAttribute((const void*)trunk_fwd, hipFuncAttributeMaxDynamicSharedMemorySize, LDS_BYTES) != hipSuccess) { fprintf(stderr, "kernel_launch: hipFuncSetAttribute failed\n"); grid = -1; return; }
        if (hipOccupancyMaxActiveBlocksPerMultiprocessor(&per_cu, (const void*)trunk_fwd, NWAVES * 64, LDS_BYTES) != hipSuccess || per_cu < 1) { fprintf(stderr, "kernel_launch: occupancy query reports %d workgroups per CU\n", per_cu); }
        (void)hipGetLastError();
        grid = cus;
    }
    if (grid < 0) return;
    if (hipMemsetAsync((char*)d_ws + WS_CTL, 0, CTL_ZERO_BYTES, stream) != hipSuccess) { fprintf(stderr, "kernel_launch: hipMemsetAsync failed\n"); return; }
    Args a{};
    for (int i = 0; i < 21; ++i) a.in[i] = (const float*)d_in[i];
    a.out = (float*)d_out; a.ws = (unsigned char*)d_ws;
#if MK_PER_PHASE
    for (int li = 0; li < N_PHASES; ++li) { a.ph_lo = li; a.ph_hi = li + 1; a.li = li;
        hipLaunchKernelGGL(trunk_fwd, dim3(grid), dim3(NWAVES * 64), LDS_BYTES, stream, a); }
#else
    a.ph_lo = 0; a.ph_hi = N_PHASES; a.li = 0;
    hipLaunchKernelGGL(trunk_fwd, dim3(grid), dim3(NWAVES * 64), LDS_BYTES, stream, a);
#endif
    const hipError_t le = hipPeekAtLastError();
    if (le != hipSuccess) fprintf(stderr, "kernel_launch: launch failed: %s\n", hipGetErrorName(le));
}
```

```cpp
#include <hip/hip_runtime.h>
#include <cstdio>
#include <cstdint>
#include <cmath>
namespace pg8 {
#define PG8_LAS __attribute__((address_space(3)))
typedef unsigned short bf16_t;
typedef short bf16x8 __attribute__((ext_vector_type(8)));
typedef float f32x4 __attribute__((ext_vector_type(4)));
typedef unsigned u32x4 __attribute__((ext_vector_type(4)));
constexpr int BM = 256, BK = 64, HALF = 128, HTB = HALF * BK * 2  , STAGE_BYTES = 8 * HTB, NXCD = 8, WGM = 8;

__host__ __device__ __forceinline__ int lds_byte(int r, int c) { const int st = (r >> 4) * 2 + (c >> 5), rr = r & 15, cc = c & 31, ob = rr * 64 + cc * 2; return st * 1024 + (ob ^ (((ob >> 9) & 1) << 5)); }
__host__ __device__ __forceinline__ void stage_rc(int b, int& R, int& C) { const int st = b / 1024, sb = b % 1024, swz = sb ^ (((sb >> 9) & 1) << 5); R = (st >> 1) * 16 + swz / 64; C = (st & 1) * 32 + (swz % 64) / 2; }
__host__ __device__ __forceinline__ int perm32(int rho) { const int n = rho >> 4, i = rho & 15; return 8 * (i >> 2) + 4 * n + (i & 3); }

struct Unit { int pm, pn; };
struct Gemm { const bf16_t* A; const bf16_t* Bt; int M, N, K; };

struct StaticOrder {
    int nM, nN, nwg, G, c;
    __host__ __device__ void init(int M, int N, int G_, int c_) { nM = M / BM; nN = N / BM; nwg = nM * nN; G = G_; c = c_; }
    __host__ __device__ bool next(int i, Unit& u) const {
        const long L = (long)i * G + c; if (L >= nwg) return false;
        int wgid = (int)L; { const int q = nwg / NXCD, r = nwg % NXCD, xcd = wgid % NXCD, off = wgid / NXCD; wgid = (xcd < r ? xcd * (q + 1) : r * (q + 1) + (xcd - r) * q) + off; }
        const int nig = WGM * nN, gid = wgid / nig, fm = gid * WGM, gsz = (nM - fm) < WGM ? (nM - fm) : WGM;
        u.pm = fm + ((wgid % nig) % gsz); u.pn = (wgid % nig) / gsz; return true;
    }
    __device__ __forceinline__ void a_ready(const Unit&) const {}
    __device__ __forceinline__ void done(const Unit&) const {}
};


__device__ __forceinline__ unsigned cvt_pk_bf16(float lo, float hi) { unsigned r; asm volatile("v_cvt_pk_bf16_f32 %0, %1, %2" : "=v"(r) : "v"(lo), "v"(hi)); return r; }
typedef unsigned u32x2 __attribute__((ext_vector_type(2)));
__device__ __forceinline__ float dot4(f32x4 a) { return (a[0] * a[0] + a[1] * a[1]) + (a[2] * a[2] + a[3] * a[3]); }

struct EpiProj {
    static constexpr bool PERM = true, AFTER_DRAIN = false;
    bf16_t* O; const float* bias; const PG8_LAS float* rtab; const float* qg; const float* kg; float qscale;
    __device__ __forceinline__ void operator()(const f32x4 (&acc)[2][2][4][2], const Unit& u, int ui, int wr, int wc, int fr, int fq) const {
        const int b = u.pm >> 3;
        const int row0 = u.pm * BM + wr * 64 + fr, col0 = u.pn * BM + wc * 32 + 8 * fq;
        const float* bp = bias + b * 2304 + col0;
        f32x4 bv[2][2];
#pragma unroll
        for (int bj = 0; bj < 2; ++bj)
#pragma unroll
            for (int n = 0; n < 2; ++n) bv[bj][n] = *(const f32x4*)(bp + bj * HALF + 4 * n);
        const bool isqk = u.pn < 2;
        f32x4 g0 = (f32x4){1.f, 1.f, 1.f, 1.f}, g1 = g0;
        if (isqk) { const float* gp = (u.pn == 0 ? qg : kg) + 8 * fq; g0 = *(const f32x4*)gp; g1 = *(const f32x4*)(gp + 4); if (u.pn == 0) { g0 = g0 * qscale; g1 = g1 * qscale; } }
        const PG8_LAS float* rt = rtab + ui * 256 + wr * 64 + fr;
#pragma unroll
        for (int ai = 0; ai < 2; ++ai)
#pragma unroll
            for (int m = 0; m < 4; ++m) { const float rs = rt[ai * HALF + m * 16]; bf16_t* rowp = O + (size_t)(row0 + ai * HALF + m * 16) * 2304 + col0;
#pragma unroll
                for (int bj = 0; bj < 2; ++bj) { f32x4 v0 = acc[ai][bj][m][0] * rs + bv[bj][0], v1 = acc[ai][bj][m][1] * rs + bv[bj][1];
                    if (isqk) { float ss = dot4(v0) + dot4(v1); ss += __shfl_xor(ss, 16); ss += __shfl_xor(ss, 32);
                        const float r = __builtin_amdgcn_rsqf(ss * (1.0f / 32.0f) + 1e-6f); v0 = v0 * r * g0; v1 = v1 * r * g1; }
                    u32x4 w; w.x = cvt_pk_bf16(v0[0], v0[1]); w.y = cvt_pk_bf16(v0[2], v0[3]); w.z = cvt_pk_bf16(v1[0], v1[1]); w.w = cvt_pk_bf16(v1[2], v1[3]);
                    *(u32x4*)(rowp + bj * HALF) = w; } }
    }
};
struct EpiFF1 {
    static constexpr bool PERM = true, AFTER_DRAIN = false;
    bf16_t* O; const float* bias; const PG8_LAS float* rtab;
    __device__ __forceinline__ void operator()(const f32x4 (&acc)[2][2][4][2], const Unit& u, int ui, int wr, int wc, int fr, int fq) const {
        const int b = u.pm >> 3;
        const int row0 = u.pm * BM + wr * 64 + fr, col0 = u.pn * BM + wc * 32 + 8 * fq;
        const float* bp = bias + b * 4096 + col0;
        f32x4 bv[2][2];
#pragma unroll
        for (int bj = 0; bj < 2; ++bj)
#pragma unroll
            for (int n = 0; n < 2; ++n) bv[bj][n] = *(const f32x4*)(bp + bj * HALF + 4 * n);
        const PG8_LAS float* rt = rtab + ui * 256 + wr * 64 + fr;
        const f32x4 z = (f32x4){0.f, 0.f, 0.f, 0.f};
#pragma unroll
        for (int ai = 0; ai < 2; ++ai)
#pragma unroll
            for (int m = 0; m < 4; ++m) {
#ifdef EXP_A
 const float rs = 1.0f;
#else
 const float rs = rt[ai * HALF + m * 16];
#endif
 bf16_t* rowp = O + (size_t)(row0 + ai * HALF + m * 16) * 4096 + col0;
#pragma unroll
                for (int bj = 0; bj < 2; ++bj) { f32x4 v0 = acc[ai][bj][m][0] * rs + bv[bj][0], v1 = acc[ai][bj][m][1] * rs + bv[bj][1];
                    v0 = __builtin_elementwise_max(v0, z); v1 = __builtin_elementwise_max(v1, z); v0 = v0 * v0; v1 = v1 * v1;
                    u32x4 w; w.x = cvt_pk_bf16(v0[0], v0[1]); w.y = cvt_pk_bf16(v0[2], v0[3]); w.z = cvt_pk_bf16(v1[0], v1[1]); w.w = cvt_pk_bf16(v1[2], v1[3]);
                    *(u32x4*)(rowp + bj * HALF) = w; } }
    }
};
struct EpiRes {
    static constexpr bool PERM = false, AFTER_DRAIN = false;
    const float* xin_f; const bf16_t* xin_h; float* xout_f; bf16_t* xout_h; const float* gate; const float* nsc; const float* ng; bf16_t* hA; float* ssq; int write_next;
    __device__ __forceinline__ void operator()(const f32x4 (&acc)[2][2][4][2], const Unit& u, int ui, int wr, int wc, int fr, int fq) const {
        const int b = u.pm >> 3;
        const int col0 = u.pn * BM + wc * 32 + 4 * fq;
        f32x4 gv[2][2], gm[2][2];
#pragma unroll
        for (int bj = 0; bj < 2; ++bj)
#pragma unroll
            for (int n = 0; n < 2; ++n) { const int c = col0 + bj * HALF + n * 16; gv[bj][n] = *(const f32x4*)(gate + b * 6144 + c);
                if (write_next) gm[bj][n] = *(const f32x4*)(ng + c) * (*(const f32x4*)(nsc + b * 6144 + c) + 1.0f); else gm[bj][n] = (f32x4){0.f, 0.f, 0.f, 0.f}; }
#pragma unroll
        for (int ai = 0; ai < 2; ++ai)
#pragma unroll
            for (int m = 0; m < 4; ++m) { const int row = u.pm * BM + ai * HALF + wr * 64 + m * 16 + fr; float ss = 0.f;
#pragma unroll
                for (int bj = 0; bj < 2; ++bj)
#pragma unroll
                    for (int n = 0; n < 2; ++n) { const size_t off = (size_t)row * 1024 + col0 + bj * HALF + n * 16;
                        f32x4 xi;
                        if (xin_f) xi = *(const f32x4*)(xin_f + off);
                        else { const u32x2 t = *(const u32x2*)(xin_h + off); xi = (f32x4){__builtin_bit_cast(float, t.x << 16), __builtin_bit_cast(float, t.x & 0xffff0000u), __builtin_bit_cast(float, t.y << 16), __builtin_bit_cast(float, t.y & 0xffff0000u)}; }
                        const f32x4 xo = xi + gv[bj][n] * acc[ai][bj][m][n]; ss += dot4(xo);
                        if (xout_f) *(f32x4*)(xout_f + off) = xo;
                        else { u32x2 w; w.x = cvt_pk_bf16(xo[0], xo[1]); w.y = cvt_pk_bf16(xo[2], xo[3]); *(u32x2*)(xout_h + off) = w; }
                        if (write_next) { const f32x4 h = xo * gm[bj][n]; u32x2 w; w.x = cvt_pk_bf16(h[0], h[1]); w.y = cvt_pk_bf16(h[2], h[3]); *(u32x2*)(hA + off) = w; } }
                ss += __shfl_xor(ss, 16); ss += __shfl_xor(ss, 32);
                if (write_next && fq == 0) ssq[(size_t)(u.pn * 4 + wc) * 16384 + row] = ss;
                if (m & 1) asm volatile("" ::: "memory"); }
    }
};

template <class Epi, class Sched, bool ALIGN_EPI = false, bool SP2 = false>
__device__ __forceinline__ void gemm_phase(PG8_LAS unsigned char* lds, const Gemm g, const Sched& S, const Epi& E, const int tid_in) {
    const int tid = tid_in, wid = __builtin_amdgcn_readfirstlane(tid >> 6), lane = tid & 63, wr = wid >> 2, wc = wid & 3, fr = lane & 15, fq = lane >> 4;
    const int K = g.K, nt = K / BK;
    unsigned voffA[2], voffB[2];
#pragma unroll
    for (int i = 0; i < 2; ++i) { int R, C; stage_rc(tid * 16 + i * 8192, R, C); const int Rb = Epi::PERM ? ((R & ~31) + perm32(R & 31)) : R;
        voffA[i] = (unsigned)(R * K + C) * 2u; voffB[i] = (unsigned)(Rb * K + C) * 2u; }
    const size_t kstep = (size_t)(BK * 2);
    const size_t hstep = (size_t)HALF * K * 2;
    const size_t tstep = 2 * hstep;
    const unsigned ldsw = (unsigned)wid * 1024u;
    const int aoff = lds_byte(wr * 64 + fr, fq * 8), boff = lds_byte(wc * 32 + fr, fq * 8);
#define PG8_SA(b, h) (((b) * 2 + (h)) * HTB)
#define PG8_SB(b, h) ((4 + (b) * 2 + (h)) * HTB)
#define PG8_STAGE(bufoff, gbase, voff) do { _Pragma("unroll") for (int _i = 0; _i < 2; ++_i) \
        __builtin_amdgcn_global_load_lds((const unsigned*)((const char*)(gbase) + (voff)[_i]), (PG8_LAS unsigned*)(lds + (bufoff) + ldsw + _i * 8192), 16, 0, 0); } while (0)
#define PG8_LDA(dst, b, h) do { _Pragma("unroll") for (int m = 0; m < 4; ++m) _Pragma("unroll") for (int k = 0; k < 2; ++k) dst[m][k] = *(const PG8_LAS bf16x8*)(lds + PG8_SA(b, h) + aoff + m * 2048 + k * 1024); } while (0)
#define PG8_LDB(dst, b, h) do { _Pragma("unroll") for (int n = 0; n < 2; ++n) _Pragma("unroll") for (int k = 0; k < 2; ++k) dst[n][k] = *(const PG8_LAS bf16x8*)(lds + PG8_SB(b, h) + boff + n * 2048 + k * 1024); } while (0)
#define PG8_MMA(ai, bj, At, Bt) do { __builtin_amdgcn_s_setprio(1); _Pragma("unroll") for (int m = 0; m < 4; ++m) _Pragma("unroll") for (int n = 0; n < 2; ++n) _Pragma("unroll") for (int k = 0; k < 2; ++k) \
        acc[ai][bj][m][n] = __builtin_amdgcn_mfma_f32_16x16x32_bf16(Bt[n][k], At[m][k], acc[ai][bj][m][n], 0, 0, 0); __builtin_amdgcn_s_setprio(0); } while (0)
#define PG8_WAIT_V(n) asm volatile("s_waitcnt vmcnt(" #n ")" ::: "memory")
#define PG8_WAIT_L(n) asm volatile("s_waitcnt lgkmcnt(" #n ")" ::: "memory")
#define PG8_BAR __builtin_amdgcn_s_barrier()
#define PG8_SCHED __builtin_amdgcn_sched_barrier(0)
    Unit cur, nxt; int ui = 0;
    if (!S.next(0, cur)) return;
    f32x4 acc[2][2][4][2];
#pragma unroll
    for (int a = 0; a < 2; ++a)
#pragma unroll
        for (int b = 0; b < 2; ++b)
#pragma unroll
            for (int m = 0; m < 4; ++m)
#pragma unroll
                for (int n = 0; n < 2; ++n) acc[a][b][m][n] = (f32x4){0.f, 0.f, 0.f, 0.f};
    bf16x8 At[4][2], B0[2][2], B1[2][2];
    const char* cA = (const char*)g.A + (size_t)cur.pm * tstep; const char* cB = (const char*)g.Bt + (size_t)cur.pn * tstep;
    S.a_ready(cur);
    if constexpr (SP2) {
        PG8_STAGE(PG8_SB(0, 0), cB, voffB); PG8_STAGE(PG8_SB(0, 1), cB + hstep, voffB); PG8_STAGE(PG8_SA(0, 0), cA, voffA); PG8_STAGE(PG8_SA(0, 1), cA + hstep, voffA);
        if (wr == 1) PG8_BAR;
        PG8_WAIT_V(2); PG8_BAR;
        PG8_STAGE(PG8_SB(1, 0), cB + kstep, voffB); PG8_STAGE(PG8_SA(1, 0), cA + kstep, voffA); PG8_STAGE(PG8_SB(1, 1), cB + hstep + kstep, voffB);
        PG8_WAIT_V(6); PG8_BAR;
    } else {
        PG8_STAGE(PG8_SB(0, 0), cB, voffB); PG8_STAGE(PG8_SA(0, 0), cA, voffA); PG8_STAGE(PG8_SB(0, 1), cB + hstep, voffB); PG8_STAGE(PG8_SA(0, 1), cA + hstep, voffA);
        if (wr == 1) PG8_BAR;
        PG8_WAIT_V(4); PG8_BAR;
        PG8_STAGE(PG8_SB(1, 0), cB + kstep, voffB); PG8_STAGE(PG8_SA(1, 0), cA + kstep, voffA); PG8_STAGE(PG8_SB(1, 1), cB + hstep + kstep, voffB);
        PG8_WAIT_V(6); PG8_BAR;
    }
    for (;;) {
        const bool has_next = S.next(ui + 1, nxt);
        const char* nA = has_next ? (const char*)g.A + (size_t)nxt.pm * tstep : cA; const char* nB = has_next ? (const char*)g.Bt + (size_t)nxt.pn * tstep : cB;
        for (int t = 0; t < nt; t += 2) {
            const bool last = (t == nt - 2);
            const char* a1 = cA + (size_t)(t + 1) * kstep;
            const char* a2 = last ? nA : cA + (size_t)(t + 2) * kstep; const char* b2 = last ? nB : cB + (size_t)(t + 2) * kstep;
            const char* a3 = a2 + kstep; const char* b3 = b2 + kstep;
            if (last && has_next) S.a_ready(nxt);
            if constexpr (SP2) {
            PG8_LDB(B0, 0, 0); PG8_LDB(B1, 0, 1); PG8_SCHED; PG8_LDA(At, 0, 0); PG8_STAGE(PG8_SA(1, 1), a1 + hstep, voffA);
            PG8_WAIT_V(8); PG8_WAIT_L(0); PG8_BAR; PG8_MMA(0, 0, At, B0); PG8_MMA(0, 1, At, B1); PG8_BAR; PG8_SCHED;
            PG8_LDA(At, 0, 1); PG8_STAGE(PG8_SB(0, 0), b2, voffB); PG8_STAGE(PG8_SB(0, 1), b2 + hstep, voffB); PG8_STAGE(PG8_SA(0, 0), a2, voffA);
            PG8_WAIT_V(8); PG8_WAIT_L(0); PG8_BAR; PG8_MMA(1, 0, At, B0); PG8_MMA(1, 1, At, B1); PG8_BAR; PG8_SCHED;
            PG8_LDB(B0, 1, 0); PG8_LDB(B1, 1, 1); PG8_SCHED; PG8_LDA(At, 1, 0); PG8_STAGE(PG8_SA(0, 1), a2 + hstep, voffA);
            PG8_WAIT_V(8); PG8_WAIT_L(0); PG8_BAR; PG8_MMA(0, 0, At, B0); PG8_MMA(0, 1, At, B1); PG8_BAR; PG8_SCHED;
            PG8_LDA(At, 1, 1); PG8_STAGE(PG8_SB(1, 0), b3, voffB); PG8_STAGE(PG8_SB(1, 1), b3 + hstep, voffB); PG8_STAGE(PG8_SA(1, 0), a3, voffA);
            PG8_WAIT_V(8); PG8_WAIT_L(0); PG8_BAR; PG8_MMA(1, 0, At, B0); PG8_MMA(1, 1, At, B1); PG8_BAR; PG8_SCHED;
            } else {
            PG8_LDB(B0, 0, 0); PG8_SCHED; PG8_LDA(At, 0, 0); PG8_STAGE(PG8_SA(1, 1), a1 + hstep, voffA);
            PG8_WAIT_L(8); PG8_BAR; PG8_WAIT_L(0); PG8_MMA(0, 0, At, B0); PG8_BAR; PG8_SCHED;
            PG8_LDB(B1, 0, 1); PG8_STAGE(PG8_SB(0, 0), b2, voffB);
            PG8_BAR; PG8_WAIT_L(0); PG8_MMA(0, 1, At, B1); PG8_BAR;
            PG8_LDA(At, 0, 1); PG8_STAGE(PG8_SA(0, 0), a2, voffA);
            PG8_BAR; PG8_WAIT_L(0); PG8_MMA(1, 0, At, B0); PG8_BAR; PG8_SCHED;
            PG8_STAGE(PG8_SB(0, 1), b2 + hstep, voffB);
            PG8_WAIT_V(6); PG8_BAR; PG8_MMA(1, 1, At, B1); PG8_BAR;
            PG8_LDB(B0, 1, 0); PG8_SCHED; PG8_LDA(At, 1, 0); PG8_STAGE(PG8_SA(0, 1), a2 + hstep, voffA);
            PG8_WAIT_L(8); PG8_BAR; PG8_WAIT_L(0); PG8_MMA(0, 0, At, B0); PG8_BAR; PG8_SCHED;
            PG8_LDB(B1, 1, 1); PG8_STAGE(PG8_SB(1, 0), b3, voffB);
            PG8_BAR; PG8_WAIT_L(0); PG8_MMA(0, 1, At, B1); PG8_BAR;
            PG8_LDA(At, 1, 1); PG8_STAGE(PG8_SA(1, 0), a3, voffA);
            PG8_BAR; PG8_WAIT_L(0); PG8_MMA(1, 0, At, B0); PG8_BAR; PG8_SCHED;
            PG8_STAGE(PG8_SB(1, 1), b3 + hstep, voffB);
            PG8_WAIT_V(6); PG8_BAR; PG8_MMA(1, 1, At, B1); PG8_BAR;
            }
        }
        if constexpr (ALIGN_EPI) { if (wr == 0) PG8_BAR; }
        if constexpr (!Epi::AFTER_DRAIN) { E(acc, cur, ui, wr, wc, fr, fq); S.done(cur); }
        if (!has_next) break;
#pragma unroll
        for (int a = 0; a < 2; ++a)
#pragma unroll
            for (int b = 0; b < 2; ++b)
#pragma unroll
                for (int m = 0; m < 4; ++m)
#pragma unroll
                    for (int n = 0; n < 2; ++n) acc[a][b][m][n] = (f32x4){0.f, 0.f, 0.f, 0.f};
        cur = nxt; cA = nA; cB = nB; ++ui;
        if constexpr (ALIGN_EPI) { if (wr == 1) PG8_BAR; }
    }
    PG8_WAIT_V(0);
    if constexpr (!ALIGN_EPI) { if (wr == 0) PG8_BAR; }
    PG8_BAR;
    if constexpr (Epi::AFTER_DRAIN) { E.fused(acc, cur, wr, wc, fr, fq, lds, wid, lane); S.done(cur); }
#undef PG8_SA
#undef PG8_SB
#undef PG8_STAGE
#undef PG8_LDA
#undef PG8_LDB
#undef PG8_MMA
#undef PG8_WAIT_V
#undef PG8_WAIT_L
#undef PG8_BAR
#undef PG8_SCHED
}
}

constexpr int NWAVES = 8;
constexpr int DM = 1024, BATCH = 8, SEQ = 2048, M = BATCH * SEQ, DEPTH = 4, NIN = 2304, FF = 4096, NMOD = 6144;
constexpr float EPS = 1e-6f;
constexpr float QSCALE = 0.17677669529663687f * 1.4426950408889634f;

#ifndef MK_PER_PHASE
#define MK_PER_PHASE 0
#endif
constexpr int N_PHASES = 2 + 5 * DEPTH;
#ifndef PREP_UPFRONT
#define PREP_UPFRONT 1
#endif

constexpr size_t MiB = 1u << 20;
constexpr size_t WS_CTL = 0, CTL_ZERO_BYTES = 1 * MiB;
constexpr size_t WS_MOD = 1 * MiB;
constexpr size_t WS_BIAS1 = 2 * MiB;
constexpr size_t WS_BIAS2 = 3 * MiB;
constexpr size_t WS_SSQ1 = 4 * MiB, WS_SSQ2 = 5 * MiB;
constexpr size_t WS_WT = 8 * MiB;
constexpr size_t WT_IN = 0, WT_OUT = (size_t)NIN * DM * 2, WT_FF1 = WT_OUT + (size_t)DM * DM * 2, WT_FF2 = WT_FF1 + (size_t)FF * DM * 2, WT_LAYER = WT_FF2 + (size_t)FF * DM * 2;
constexpr size_t WS_HA = WS_WT + DEPTH * WT_LAYER;
constexpr size_t WS_XB = WS_HA + (size_t)M * DM * 2;
constexpr size_t WS_PROJ = WS_XB + (size_t)M * DM * 2;
constexpr size_t WS_MIX = WS_PROJ + (size_t)M * NIN * 2;
constexpr size_t WS_HID = WS_PROJ;
constexpr size_t WS_END = WS_HID + (size_t)M * FF * 2;
static_assert(WT_LAYER == (size_t)(NIN + DM + FF + FF) * DM * 2 && WS_HA % 256 == 0 && WS_PROJ % 256 == 0 && WS_MIX % 256 == 0 && WS_HID % 256 == 0 && WS_MIX + (size_t)M * DM * 2 <= WS_END, "ws map");
constexpr int CW_BAR = 4096;

constexpr int RING_OFF = 0, RING_BYTES = 131072;
constexpr int LDSCTL_OFF = RING_BYTES, MISC_OFF = LDSCTL_OFF + 320;
constexpr int RT_OFF = LDSCTL_OFF + 512;
constexpr int LDS_BYTES = 147456;
static_assert(RT_OFF + 8 * 256 * 4 <= LDS_BYTES, "LDS map");

#define GAS __attribute__((address_space(1)))
#define LAS __attribute__((address_space(3)))
typedef unsigned short bf16;
typedef unsigned v4u __attribute__((ext_vector_type(4)));
typedef unsigned v2u __attribute__((ext_vector_type(2)));
typedef float f32x4 __attribute__((ext_vector_type(4)));
typedef float f32x2 __attribute__((ext_vector_type(2)));
typedef short bf16x8 __attribute__((ext_vector_type(8)));
typedef short s16x4 __attribute__((ext_vector_type(4)));
typedef GAS unsigned gu32;
#define RLX_AGENT __ATOMIC_RELAXED, __HIP_MEMORY_SCOPE_AGENT
#define LDS_WAIT() asm volatile("s_waitcnt lgkmcnt(0)" ::: "memory")
#define VM_WAIT() asm volatile("s_waitcnt vmcnt(0)" ::: "memory")
__device__ __forceinline__ unsigned f2bf(float f) { unsigned u = __builtin_bit_cast(unsigned, f); return (u + 0x7fffu + ((u >> 16) & 1u)) >> 16; }
__device__ __forceinline__ unsigned pk2(float lo, float hi) { return f2bf(lo) | (f2bf(hi) << 16); }
__device__ __forceinline__ float bflo(unsigned v) { return __builtin_bit_cast(float, v << 16); }
__device__ __forceinline__ float bfhi(unsigned v) { return __builtin_bit_cast(float, v & 0xffff0000u); }
__device__ __forceinline__ float wave_sum(float v) {
#pragma unroll
    for (int o = 1; o < 64; o <<= 1) v += __shfl_xor(v, o);
    return v;
}
__device__ __forceinline__ float wave_max(float v) {
#pragma unroll
    for (int o = 1; o < 64; o <<= 1) v = fmaxf(v, __shfl_xor(v, o));
    return v;
}
__device__ __forceinline__ float sigmoidf_(float v) { return 1.0f / (1.0f + __expf(-v)); }

#define XB_TMO      128
#define XB_XCNT(j)  (256  + 64 * (j))
#define XB_XSUB(j)  (1280 + 64 * (j))
#define XB_XGEN(j)  (2304 + 64 * (j))
#define XB_TOP      3328
#define XB_TOPGEN   3392
#define XCD_BAR_WORDS 3456
#define XB_SPIN_CAP (1u << 18)

__device__ __forceinline__ unsigned xb_ld(unsigned* p)              { return __hip_atomic_load(p, __ATOMIC_RELAXED, __HIP_MEMORY_SCOPE_AGENT); }
__device__ __forceinline__ unsigned xb_add(unsigned* p, unsigned v) { return __hip_atomic_fetch_add(p, v, __ATOMIC_RELAXED, __HIP_MEMORY_SCOPE_AGENT); }
__device__ __forceinline__ unsigned xb_xcc_id() { return (unsigned)__builtin_amdgcn_s_getreg((3 << 11) | 20) & 0xFu; }
#define XB_SPIN(cond, bar) do { unsigned _sp = 0; while (cond) { __builtin_amdgcn_s_sleep(1); \
    if ((++_sp & 255u) == 0u) { if (xb_ld(&(bar)[XB_TMO])) break; if (_sp > XB_SPIN_CAP) { atomicAdd(&(bar)[XB_TMO], 1u); break; } } } } while (0)

struct XcdBarrier { unsigned* bar; unsigned x; volatile LAS unsigned* st; };

__device__ __forceinline__ XcdBarrier xcd_barrier_post(unsigned* bar, volatile LAS unsigned* st) {
    XcdBarrier b; b.bar = bar; b.x = xb_xcc_id(); b.st = st;
    if (threadIdx.x == 0) (void)xb_add(&bar[XB_XCNT(b.x)], 1u);
    return b;
}
__device__ __forceinline__ void xcd_barrier_complete(unsigned* bar, unsigned x, unsigned& nloc, unsigned& nx) {
    const unsigned G = gridDim.x * gridDim.y * gridDim.z;
    unsigned sum, cnt, mine, sp = 0u;
    for (;;) {
        sum = 0u; cnt = 0u; mine = 0u;
#pragma unroll
        for (unsigned j = 0; j < 16; ++j) { const unsigned c = xb_ld(&bar[XB_XCNT(j)]); sum += c; cnt += (c > 0u) ? 1u : 0u; mine = (j == x) ? c : mine; }
        if (sum == G) break;
        __builtin_amdgcn_s_sleep(1);
        if ((++sp & 255u) == 0u) { if (xb_ld(&bar[XB_TMO])) break; if (sp > XB_SPIN_CAP) { atomicAdd(&bar[XB_TMO], 1u); break; } }
    }
    nloc = mine > 0u ? mine : 1u; nx = cnt > 0u ? cnt : 1u;
}
__device__ __forceinline__ void xcd_barrier(const XcdBarrier& b) {
    asm volatile("s_waitcnt vmcnt(0)" ::: "memory");
    __syncthreads();
    if (threadIdx.x == 0) {
        unsigned* bar = b.bar;
        __builtin_amdgcn_s_waitcnt(0);
        unsigned nloc = b.st[0], nx = b.st[1];
        if (nloc == 0u) { xcd_barrier_complete(bar, b.x, nloc, nx); b.st[0] = nloc; b.st[1] = nx; }
        const unsigned old = xb_add(&bar[XB_XSUB(b.x)], 1u);
        const unsigned gen = old / nloc;
        if (old + 1u == (gen + 1u) * nloc) {
            __builtin_amdgcn_fence(__ATOMIC_RELEASE, "agent");
            asm volatile("s_waitcnt vmcnt(0)" ::: "memory");
            const unsigned og = xb_add(&bar[XB_TOP], 1u);
            const unsigned tg = og / nx;
            if (og + 1u == (tg + 1u) * nx) xb_add(&bar[XB_TOPGEN], 1u);
            else XB_SPIN(xb_ld(&bar[XB_TOPGEN]) == tg, bar);
            __builtin_amdgcn_fence(__ATOMIC_ACQUIRE, "agent");
            xb_add(&bar[XB_XGEN(b.x)], 1u);
            asm volatile("s_waitcnt vmcnt(0)" ::: "memory");
        } else {
            XB_SPIN(xb_ld(&bar[XB_XGEN(b.x)]) == gen, bar);
            __builtin_amdgcn_fence(__ATOMIC_ACQUIRE, "agent");
            asm volatile("s_waitcnt vmcnt(0)" ::: "memory");
        }
    }
    __syncthreads();
}

struct Frame {
    LAS unsigned char* lds;
    volatile LAS unsigned* MISC;
    gu32* ctl;
    int tid, lane, wave;
    int vcu, G;
    const float *x, *c, *w_ada, *b_ada, *n1g, *n2g, *w_in, *w_out, *qng, *kng, *lamp, *subg, *cdw, *cdb, *clg, *clb, *scw, *poolw, *poolsc, *w_ff1, *w_ff2;
    float* out;
    unsigned char* ws;
    float *MOD, *BIAS1, *BIAS2, *SSQ1, *SSQ2;
    bf16 *HA, *XB, *PROJ, *MIX, *HID;
};
__device__ __forceinline__ bf16* wt_ptr(const Frame& F, int l, size_t off) { return (bf16*)(F.ws + WS_WT + (size_t)l * WT_LAYER + off); }

__device__ __forceinline__ void mod_item(Frame& F, int l, int strip) {
    const int j0 = strip * 32, tid = F.tid;
    LAS float* cact = (LAS float*)(F.lds);
    LAS float* red = (LAS float*)(F.lds + 32768);
    for (int i = tid; i < 8192; i += NWAVES * 64) { const int b = i >> 10, k = i & 1023; const float v = F.c[b * 1024 + k]; cact[k * 8 + b] = v * sigmoidf_(v); }
    __syncthreads();
    {
        const int col4 = tid & 7, kp = tid >> 3;
        const float* wp = F.w_ada + ((size_t)l * 1024 + kp * 16) * NMOD + j0 + col4 * 4;
        f32x4 w[16];
#pragma unroll
        for (int k = 0; k < 16; ++k) w[k] = *(const f32x4*)(wp + (size_t)k * NMOD);
        f32x4 acc[8];
#pragma unroll
        for (int b = 0; b < 8; ++b) acc[b] = (f32x4){0.f, 0.f, 0.f, 0.f};
#pragma unroll
        for (int k = 0; k < 16; ++k) {
            const LAS f32x4* ca = (const LAS f32x4*)(cact + (kp * 16 + k) * 8);
            const f32x4 c0 = ca[0], c1 = ca[1];
            acc[0] += w[k] * c0[0]; acc[1] += w[k] * c0[1]; acc[2] += w[k] * c0[2]; acc[3] += w[k] * c0[3];
            acc[4] += w[k] * c1[0]; acc[5] += w[k] * c1[1]; acc[6] += w[k] * c1[2]; acc[7] += w[k] * c1[3];
        }
#pragma unroll
        for (int b = 0; b < 8; ++b) *(LAS f32x4*)(red + (kp * 8 + b) * 32 + col4 * 4) = acc[b];
    }
    __syncthreads();
    if (tid < 256) { const int b = tid >> 5, cc = tid & 31; float s = F.b_ada[l * NMOD + j0 + cc];
#pragma unroll 16
        for (int kp = 0; kp < 64; ++kp) s += red[(kp * 8 + b) * 32 + cc];
        F.MOD[((size_t)l * 8 + b) * NMOD + j0 + cc] = s; }
    __syncthreads();
}
constexpr int TS = 260;
__device__ __forceinline__ void transpose_item(Frame& F, const float* W, int K, int N, bf16* WT, int kb, int nb, const float* Wp, const float* psc, int mode = 0) {
    const int k0 = 64 * kb, n0 = 256 * nb, lane = F.lane, wv = F.wave;
    LAS float* tile = (LAS float*)(F.lds);
    {
        f32x4 v[8];
#pragma unroll
        for (int i = 0; i < 8; ++i) v[i] = *(const f32x4*)(W + (size_t)(k0 + 8 * wv + i) * N + n0 + 4 * lane);
#pragma unroll
        for (int i = 0; i < 8; ++i) { if (psc) v[i] = v[i] * psc[8 * wv + i]; if (mode < 3) *(LAS f32x4*)(tile + (8 * wv + i) * TS + 4 * lane) = v[i]; else asm volatile("" :: "v"(v[i])); }
    }
    LDS_WAIT(); __syncthreads();
    if (mode >= 2) return;
    if (Wp) {
        typedef float f32x4_t __attribute__((ext_vector_type(4)));
        const int li = lane & 15, lk = lane >> 4;
        f32x4_t acc[4][2];
#pragma unroll
        for (int ct = 0; ct < 4; ++ct) { acc[ct][0] = (f32x4_t){0.f, 0.f, 0.f, 0.f}; acc[ct][1] = acc[ct][0]; }
#pragma unroll 4
        for (int d0 = 0; d0 < 64; d0 += 4) {
            const float b0 = tile[(d0 + lk) * TS + 32 * wv + li], b1 = tile[(d0 + lk) * TS + 32 * wv + 16 + li];
#pragma unroll
            for (int ct = 0; ct < 4; ++ct) { const float a = Wp[(16 * ct + li) * 64 + d0 + lk];
                acc[ct][0] = __builtin_amdgcn_mfma_f32_16x16x4f32(a, b0, acc[ct][0], 0, 0, 0); acc[ct][1] = __builtin_amdgcn_mfma_f32_16x16x4f32(a, b1, acc[ct][1], 0, 0, 0); }
        }
        LDS_WAIT(); __syncthreads();
#pragma unroll
        for (int ct = 0; ct < 4; ++ct)
#pragma unroll
            for (int r = 0; r < 4; ++r) { tile[(16 * ct + 4 * lk + r) * TS + 32 * wv + li] = acc[ct][0][r]; tile[(16 * ct + 4 * lk + r) * TS + 32 * wv + 16 + li] = acc[ct][1][r]; }
        LDS_WAIT(); __syncthreads();
    }
    {
        const int n = 32 * wv + (lane & 31), ch = lane >> 5;
#pragma unroll
        for (int j = 0; j < 4; ++j) { const int c = 4 * ch + j; const LAS float* s = tile + (8 * c) * TS + n;
            v4u o; o.x = pk2(s[0 * TS], s[1 * TS]); o.y = pk2(s[2 * TS], s[3 * TS]); o.z = pk2(s[4 * TS], s[5 * TS]); o.w = pk2(s[6 * TS], s[7 * TS]);
            if (mode == 0) *(GAS v4u*)(WT + (size_t)(n0 + n) * K + k0 + 8 * c) = o; else asm volatile("" :: "v"(o)); }
    }
    LDS_WAIT(); __syncthreads();
}
__device__ __forceinline__ void prep_layer(Frame& F, int L, int rank, int nranks, int what = 3) {
    constexpr int I_MOD = NMOD / 32, I_IN = (DM / 64) * (NIN / 256), I_OUT = (DM / 64) * (DM / 256), I_1 = (DM / 64) * (FF / 256), I_2 = (FF / 64) * (DM / 256), I_ALL = I_MOD + I_IN + I_OUT + I_1 + I_2;
    const int l = L;
#pragma unroll 1
    for (int it = rank; it < I_ALL; it += nranks) {
        int r = it;
        if (r < I_MOD) { if (what & 1) mod_item(F, l, r); continue; } r -= I_MOD;
        if (!(what & 2)) continue;
        if (r < I_IN) { transpose_item(F, F.w_in + (size_t)l * DM * NIN, DM, NIN, wt_ptr(F, l, WT_IN), r / (NIN / 256), r % (NIN / 256), nullptr, nullptr, what >> 2); continue; } r -= I_IN;
        if (r < I_OUT) { const int kb = r / 4, nb = r % 4;
            if (kb < 12) transpose_item(F, F.w_out + (size_t)l * DM * DM, DM, DM, wt_ptr(F, l, WT_OUT), kb, nb, nullptr, nullptr, what >> 2);
            else transpose_item(F, F.w_out + (size_t)l * DM * DM, DM, DM, wt_ptr(F, l, WT_OUT), kb, nb, F.poolw + ((size_t)l * 4 + (kb - 12)) * 4096, F.poolsc + l * 256 + 64 * (kb - 12), what >> 2);
            continue; } r -= I_OUT;
        if (r < I_1) { transpose_item(F, F.w_ff1 + (size_t)l * DM * FF, DM, FF, wt_ptr(F, l, WT_FF1), r / (FF / 256), r % (FF / 256), nullptr, nullptr, what >> 2); continue; } r -= I_1;
        transpose_item(F, F.w_ff2 + (size_t)l * FF * DM, FF, DM, wt_ptr(F, l, WT_FF2), r / 4, r % 4, nullptr, nullptr, what >> 2);
    }
}
__device__ __forceinline__ void bias_layer(Frame& F, int l) {
    const int gw = F.vcu * NWAVES + F.wave, NGW = F.G * NWAVES, lane = F.lane;
#pragma unroll 1
    for (int kind = 0; kind < 2; ++kind) {
        const int N = kind ? FF : NIN;
        const bf16* Wt = wt_ptr(F, l, kind ? WT_FF1 : WT_IN);
        const float* sh = F.MOD + (size_t)l * 8 * NMOD + (kind ? 3072 : 0);
        float* outp = kind ? F.BIAS2 + (size_t)l * 8 * FF : F.BIAS1 + (size_t)l * 8 * NIN;
        f32x4 shr[8][4];
#pragma unroll
        for (int b = 0; b < 8; ++b)
#pragma unroll
            for (int j = 0; j < 4; ++j) shr[b][j] = *(const f32x4*)(sh + (size_t)b * NMOD + 16 * lane + 4 * j);
        for (int n = gw; n < N; n += NGW) {
            const v4u w0 = *(const v4u*)(Wt + (size_t)n * DM + 16 * lane), w1 = *(const v4u*)(Wt + (size_t)n * DM + 16 * lane + 8);
            const f32x4 wv0 = (f32x4){bflo(w0.x), bfhi(w0.x), bflo(w0.y), bfhi(w0.y)}, wv1 = (f32x4){bflo(w0.z), bfhi(w0.z), bflo(w0.w), bfhi(w0.w)};
            const f32x4 wv2 = (f32x4){bflo(w1.x), bfhi(w1.x), bflo(w1.y), bfhi(w1.y)}, wv3 = (f32x4){bflo(w1.z), bfhi(w1.z), bflo(w1.w), bfhi(w1.w)};
            float a[8];
#pragma unroll
            for (int b = 0; b < 8; ++b) { const f32x4 t = shr[b][0] * wv0 + shr[b][1] * wv1 + shr[b][2] * wv2 + shr[b][3] * wv3; a[b] = wave_sum((t[0] + t[1]) + (t[2] + t[3])); }
            if (lane == 0) {
#pragma unroll
                for (int b = 0; b < 8; ++b) outp[(size_t)b * N + n] = a[b]; }
        }
    }
}
__device__ __forceinline__ void p0b(Frame& F) {
#pragma unroll 1
    for (int L = 0; L < (PREP_UPFRONT ? DEPTH : 1); ++L) bias_layer(F, L);
    const int gw = F.vcu * NWAVES + F.wave, NGW = F.G * NWAVES, lane = F.lane;
    for (int m = gw; m < M; m += NGW) {
        const int b = m >> 11; const GAS f32x4* xr = (const GAS f32x4*)(F.x + (size_t)m * DM) + lane;
        const f32x4* gr = (const f32x4*)(F.n1g) + lane; const f32x4* sr = (const f32x4*)(F.MOD + (size_t)b * NMOD + 1024) + lane;
        float ss = 0.f; GAS v2u* o8 = (GAS v2u*)(F.HA + (size_t)m * DM) + lane;
#pragma unroll
        for (int j = 0; j < 4; ++j) { const f32x4 v = xr[64 * j]; ss += (v[0] * v[0] + v[1] * v[1]) + (v[2] * v[2] + v[3] * v[3]);
            const f32x4 h = v * gr[64 * j] * (sr[64 * j] + 1.0f); v2u w; w.x = pk2(h[0], h[1]); w.y = pk2(h[2], h[3]); o8[64 * j] = w; }
        ss = wave_sum(ss);
        if (lane < 16) F.SSQ1[(size_t)lane * M + m] = lane == 0 ? ss : 0.f;
    }
}
__device__ __forceinline__ void rstd_table(Frame& F, const pg8::StaticOrder& S, const float* ssq) {
    LAS float* tab = (LAS float*)(F.lds + RT_OFF);
    pg8::Unit u;
    for (int ui = 0; ui < 8 && S.next(ui, u); ++ui) {
        if (F.tid < 256) { const int row = u.pm * 256 + F.tid; float s = 0.f;
#pragma unroll
            for (int p = 0; p < 16; ++p) s += ssq[(size_t)p * M + row];
            tab[ui * 256 + F.tid] = __builtin_amdgcn_rsqf(s * (1.0f / DM) + EPS); }
    }
    LDS_WAIT(); __syncthreads();
}

__device__ __forceinline__ s16x4 vtr(const LAS unsigned char* p) { typedef short v4i16_t __attribute__((ext_vector_type(4))); return __builtin_bit_cast(s16x4, __builtin_amdgcn_ds_read_tr16_b64_v4i16((LAS v4i16_t*)p)); }
__device__ __forceinline__ void glds16(const void* gsrc, LAS unsigned char* dst) { __builtin_amdgcn_global_load_lds((const unsigned*)gsrc, (LAS unsigned*)dst, 16, 0, 0); }
__device__ __forceinline__ void attn_qk(f32x4 (&s)[2][4], const LAS unsigned char* kb_, bf16x8 q0, bf16x8 q1, f32x4 negM) {
#pragma unroll
    for (int kb = 0; kb < 4; ++kb) { const bf16x8 k0 = *(const LAS bf16x8*)(kb_ + kb * 256), k1 = *(const LAS bf16x8*)(kb_ + 4096 + kb * 256);
        s[0][kb] = __builtin_amdgcn_mfma_f32_16x16x32_bf16(k0, q0, negM, 0, 0, 0); s[1][kb] = __builtin_amdgcn_mfma_f32_16x16x32_bf16(k1, q1, negM, 0, 0, 0); }
}
__device__ __forceinline__ void attn_pv(f32x4 (&s)[2][4], f32x4 (&o)[2][4], f32x4 (&ol)[2], const LAS unsigned char* vb_, int vE, int vO, bool band, int key0, int qrow) {
    if (band) {
#pragma unroll
        for (int kb = 0; kb < 4; ++kb)
#pragma unroll
            for (int r = 0; r < 4; ++r) { const int key = key0 + 16 * kb + r; if (key > qrow) { s[0][kb][r] = -INFINITY; s[1][kb][r] = -INFINITY; } }
    }
#pragma unroll
    for (int kb = 0; kb < 4; ++kb)
#pragma unroll
        for (int r = 0; r < 4; ++r) { s[0][kb][r] = __builtin_amdgcn_exp2f(s[0][kb][r]); s[1][kb][r] = __builtin_amdgcn_exp2f(s[1][kb][r]); }
    bf16x8 pw[2][2];
#pragma unroll
    for (int m = 0; m < 2; ++m)
#pragma unroll
        for (int ks = 0; ks < 2; ++ks) { v4u w; w.x = pg8::cvt_pk_bf16(s[m][2 * ks][0], s[m][2 * ks][1]); w.y = pg8::cvt_pk_bf16(s[m][2 * ks][2], s[m][2 * ks][3]);
            w.z = pg8::cvt_pk_bf16(s[m][2 * ks + 1][0], s[m][2 * ks + 1][1]); w.w = pg8::cvt_pk_bf16(s[m][2 * ks + 1][2], s[m][2 * ks + 1][3]); pw[m][ks] = __builtin_bit_cast(bf16x8, w); }
    const bf16x8 ones = (bf16x8){0x3F80, 0x3F80, 0x3F80, 0x3F80, 0x3F80, 0x3F80, 0x3F80, 0x3F80};
    const unsigned va0 = (unsigned)(size_t)(vb_ + vE), va1 = (unsigned)(size_t)(vb_ + vO);
#pragma unroll
    for (int ks = 0; ks < 2; ++ks) {
        s16x4 lo[4], hi[4];
#define ATT_TR(dst, addr, off) asm volatile("ds_read_b64_tr_b16 %0, %1 offset:%c2" : "=&v"(dst) : "v"(addr), "i"(off) : "memory")
        if (ks == 0) { ATT_TR(lo[0], va0, 0); ATT_TR(hi[0], va0, 1024); ATT_TR(lo[1], va1, 0); ATT_TR(hi[1], va1, 1024);
                       ATT_TR(lo[2], va0, 4096); ATT_TR(hi[2], va0, 4096 + 1024); ATT_TR(lo[3], va1, 4096); ATT_TR(hi[3], va1, 4096 + 1024); }
        else         { ATT_TR(lo[0], va0, 2048); ATT_TR(hi[0], va0, 2048 + 1024); ATT_TR(lo[1], va1, 2048); ATT_TR(hi[1], va1, 2048 + 1024);
                       ATT_TR(lo[2], va0, 4096 + 2048); ATT_TR(hi[2], va0, 4096 + 2048 + 1024); ATT_TR(lo[3], va1, 4096 + 2048); ATT_TR(hi[3], va1, 4096 + 2048 + 1024); }
#undef ATT_TR
        asm volatile("s_waitcnt lgkmcnt(0)" : "+v"(lo[0]), "+v"(hi[0]), "+v"(lo[1]), "+v"(hi[1]), "+v"(lo[2]), "+v"(hi[2]), "+v"(lo[3]), "+v"(hi[3]) :: "memory");
        __builtin_amdgcn_sched_barrier(0);
#pragma unroll
        for (int d0 = 0; d0 < 4; ++d0) {
            const bf16x8 vf = (bf16x8){lo[d0][0], lo[d0][1], lo[d0][2], lo[d0][3], hi[d0][0], hi[d0][1], hi[d0][2], hi[d0][3]};
            o[0][d0] = __builtin_amdgcn_mfma_f32_16x16x32_bf16(pw[0][ks], vf, o[0][d0], 0, 0, 0);
            o[1][d0] = __builtin_amdgcn_mfma_f32_16x16x32_bf16(pw[1][ks], vf, o[1][d0], 0, 0, 0); }
        ol[0] = __builtin_amdgcn_mfma_f32_16x16x32_bf16(pw[0][ks], ones, ol[0], 0, 0, 0);
        ol[1] = __builtin_amdgcn_mfma_f32_16x16x32_bf16(pw[1][ks], ones, ol[1], 0, 0, 0); }
}
__device__ __forceinline__ void attn_epilogue(Frame& F, const f32x4 (&o)[2][4], const f32x4 (&ol)[2], const float (&sgv)[4], float lam, bf16* op) {
    const int lane = F.lane;
#pragma unroll
    for (int r = 0; r < 4; ++r) {
        const float a0 = 1.0f / ol[0][r], a1 = lam / ol[1][r];
        float ov[4], ss = 0.f;
#pragma unroll
        for (int d0 = 0; d0 < 4; ++d0) { ov[d0] = o[0][d0][r] * a0 - o[1][d0][r] * a1; ss += ov[d0] * ov[d0]; }
        ss += __shfl_xor(ss, 1); ss += __shfl_xor(ss, 2); ss += __shfl_xor(ss, 4); ss += __shfl_xor(ss, 8);
        const float rn = __builtin_amdgcn_rsqf(ss * (1.0f / 64.0f) + EPS);
#pragma unroll
        for (int d0 = 0; d0 < 4; ++d0) op[(size_t)r * DM + 16 * d0] = (bf16)f2bf(ov[d0] * rn * sgv[d0]);
    }
    (void)lane;
}
__device__ __forceinline__ void attn_pair(Frame& F, int l, int b, int h, int sidx, float lam, float negMv, float outscale) {
    const int lane = F.lane, wid = F.wave, fr = lane & 15, fq = lane >> 4;
    LAS unsigned char* lds = F.lds;
    const size_t rowbase = (size_t)b * SEQ;
    const bf16* proj = F.PROJ;
    const int qbA = 15 - sidx, qbB = sidx, NTa = 2 * (qbA + 1), NTb = 2 * (qbB + 1), S = NTa + NTb;
    const bf16* qpA = proj + (rowbase + qbA * 128 + 16 * wid + fr) * NIN + h * 64 + 8 * fq;
    const bf16* qpB = proj + (rowbase + qbB * 128 + 16 * wid + fr) * NIN + h * 64 + 8 * fq;
    const bf16x8 qa0 = *(const bf16x8*)qpA, qa1 = *(const bf16x8*)(qpA + 32), qb0 = *(const bf16x8*)qpB, qb1 = *(const bf16x8*)(qpB + 32);
    const bf16* ksrc = proj + (rowbase + lane) * NIN + 256 + h * 64 + wid * 8;
    const bf16* vsrc = proj + (rowbase + 16 * (wid & 3) + (lane >> 2)) * NIN + 512 + h * 64 + (wid >> 2) * 32 + 8 * ((lane & 3) ^ (2 * ((lane >> 4) & 1)));
    LAS unsigned char* kdst = lds + wid * 1024;
    LAS unsigned char* vdst = lds + 32768 + wid * 1024;
    f32x4 o[2][4], ol[2];
#pragma unroll
    for (int m = 0; m < 2; ++m) { ol[m] = (f32x4){0.f, 0.f, 0.f, 0.f};
#pragma unroll
        for (int d = 0; d < 4; ++d) o[m][d] = (f32x4){0.f, 0.f, 0.f, 0.f}; }
    const f32x4 negM = (f32x4){negMv, negMv, negMv, negMv};
    const int koff = fq * 1024 + fr * 16;
    const int prow = fr >> 2, pp = fr & 3;
    const int vrow = (4 * fq + prow) * 64 + (pp & 1) * 8 + (pp >> 1) * 16;
    const int vE = vrow + 32 * (fq & 1), vO = vrow + 32 * (1 - (fq & 1));
    float sgv[4];
#pragma unroll
    for (int d0 = 0; d0 < 4; ++d0) sgv[d0] = F.subg[l * 64 + 16 * d0 + fr] * outscale;
#define ATT_TILE(s) ((s) < NTa ? (s) : (s) - NTa)
#define ATT_SRC(s) ((size_t)ATT_TILE((s) < S ? (s) : S - 1) * 64 * NIN)
#define ATT_BAR(N) do { asm volatile("s_waitcnt vmcnt(" #N ") lgkmcnt(0)" ::: "memory"); __builtin_amdgcn_s_barrier(); asm volatile("" ::: "memory"); } while (0)
    glds16(ksrc + ATT_SRC(0), kdst);
    glds16(ksrc + ATT_SRC(1), kdst + 8192); glds16(vsrc + ATT_SRC(0), vdst);
    glds16(ksrc + ATT_SRC(2), kdst + 2 * 8192); glds16(vsrc + ATT_SRC(1), vdst + 8192);
    glds16(ksrc + ATT_SRC(3), kdst + 3 * 8192); glds16(vsrc + ATT_SRC(2), vdst + 2 * 8192);
    ATT_BAR(6);
    f32x4 sA[2][4], sB[2][4];
    attn_qk(sA, lds + koff, qa0, qa1, negM);
#define ATT_STEP(s, CUR, NXT) do { \
        ATT_BAR(4); \
        glds16(ksrc + ATT_SRC((s) + 4), kdst + ((s) & 3) * 8192); glds16(vsrc + ATT_SRC((s) + 3), vdst + (((s) + 3) & 3) * 8192); \
        if ((s) + 1 < S) { const bool nb_ = ((s) + 1 >= NTa); attn_qk(NXT, lds + (((s) + 1) & 3) * 8192 + koff, nb_ ? qb0 : qa0, nb_ ? qb1 : qa1, negM); } \
        { const bool inB_ = (s) >= NTa; const int tile_ = ATT_TILE(s), NTu_ = inB_ ? NTb : NTa, q0_ = (inB_ ? qbB : qbA) * 128; \
          attn_pv(CUR, o, ol, lds + 32768 + ((s) & 3) * 8192, vE, vO, tile_ >= NTu_ - 2, 64 * tile_ + 4 * fq, q0_ + 16 * wid + fr); \
          if (tile_ == NTu_ - 1) { attn_epilogue(F, o, ol, sgv, lam, F.MIX + (rowbase + q0_ + 16 * wid + 4 * fq) * DM + h * 64 + fr); \
              asm volatile("s_waitcnt vmcnt(0)" ::: "memory");      \
              _Pragma("unroll") for (int m_ = 0; m_ < 2; ++m_) { ol[m_] = (f32x4){0.f, 0.f, 0.f, 0.f}; _Pragma("unroll") for (int d_ = 0; d_ < 4; ++d_) o[m_][d_] = (f32x4){0.f, 0.f, 0.f, 0.f}; } } } \
    } while (0)
#pragma unroll 1
    for (int s = 0; s < S; s += 2) { ATT_STEP(s, sA, sB); ATT_STEP(s + 1, sB, sA); }
#undef ATT_STEP
#undef ATT_TILE
#undef ATT_SRC
    ATT_BAR(0);
#undef ATT_BAR
}
__device__ __forceinline__ void attn_phase(Frame& F, int l) {
    const int lane = F.lane; const float* lp = F.lamp + l * 128;
    float pa = lane < 32 ? lp[lane] * lp[32 + lane] : 0.f, pb = lane < 32 ? lp[64 + lane] * lp[96 + lane] : 0.f;
    pa = wave_sum(pa); pb = wave_sum(pb);
    const float lam_init = 0.8f - 0.6f * __expf(-0.3f * (float)l);
    const float lam = __expf(pa) - __expf(pb) + lam_init;
    const float gq = wave_max(fabsf(F.qng[l * 32 + (lane & 31)])), gk = wave_max(fabsf(F.kng[l * 32 + (lane & 31)]));
    const float negMv = -(QSCALE * 32.0f * gq * gk);
    for (int pi = F.vcu; pi < 256; pi += F.G) {
        const int bh = pi >> 3, s = pi & 7;
        attn_pair(F, l, bh >> 2, bh & 3, s, lam, negMv, 1.0f - lam_init);
    }
}
__device__ __forceinline__ unsigned bld(__amdgpu_buffer_rsrc_t r, int voff, int soff) { return __builtin_amdgcn_raw_buffer_load_b32(r, voff, soff, 0); }
__device__ __forceinline__ f32x2 bld2(__amdgpu_buffer_rsrc_t r, int voff, int soff) { typedef unsigned u2 __attribute__((ext_vector_type(2))); const u2 v = __builtin_amdgcn_raw_buffer_load_b64(r, voff, soff, 0); return __builtin_bit_cast(f32x2, v); }
__device__ __forceinline__ void mixer_tile(Frame& F, int l, int tt) {
    const int tid = F.tid, lane = F.lane; const int b = tt >> 5, s0 = (tt & 31) * 64; const int rowbase = b * SEQ;
    LAS float* cbuf = (LAS float*)F.lds;
    const int c2 = (tid & 127) * 2, tq = F.wave >> 1, sb = s0 + 16 * tq;
    const __amdgpu_buffer_rsrc_t rp = __builtin_amdgcn_make_buffer_rsrc((void*)F.PROJ, 0, (int)((size_t)M * NIN * 2), 0x00020000);
    const __amdgpu_buffer_rsrc_t rm = __builtin_amdgcn_make_buffer_rsrc((void*)F.MIX, 0, (int)((size_t)M * DM * 2), 0x00020000);
    const int vo = c2 * 2;
    {
        unsigned cgr[18], xcr[18], bgr[16], udr[31];
#pragma unroll
        for (int j = 0; j < 18; ++j) { const int s = sb - 2 + j, sc = s < 0 ? 0 : s; const int so = (rowbase + sc) * (NIN * 2) + 1536 * 2; cgr[j] = bld(rp, vo, so); xcr[j] = bld(rp, vo, so + 512); }
#pragma unroll
        for (int j = 0; j < 16; ++j) bgr[j] = bld(rp, vo, (rowbase + sb + j) * (NIN * 2) + 1280 * 2);
#pragma unroll
        for (int j = 0; j < 31; ++j) { const int s = sb - 15 + j, sc = s < 0 ? 0 : s; udr[j] = bld(rp, vo, (rowbase + sc) * (NIN * 2) + 2048 * 2); }
        const __amdgpu_buffer_rsrc_t rw = __builtin_amdgcn_make_buffer_rsrc((void*)(F.scw + (size_t)l * 3 * 256), 0, 3 * 256 * 4, 0x00020000);
        f32x2 w3[3];
#pragma unroll
        for (int k = 0; k < 3; ++k) w3[k] = bld2(rw, c2 * 4, k * 1024);
        f32x2 pr[18];
#pragma unroll
        for (int j = 0; j < 18; ++j) { const float ok = (sb - 2 + j) >= 0 ? 1.f : 0.f; pr[j] = (f32x2){bflo(cgr[j]) * bflo(xcr[j]) * ok, bfhi(cgr[j]) * bfhi(xcr[j]) * ok}; }
#pragma unroll
        for (int i = 0; i < 16; ++i) { const f32x2 cv = w3[0] * pr[i] + w3[1] * pr[i + 1] + w3[2] * pr[i + 2];
            __builtin_amdgcn_raw_buffer_store_b32(pk2(bflo(bgr[i]) * cv[0], bfhi(bgr[i]) * cv[1]), rm, vo, (rowbase + sb + i) * (DM * 2) + 512 * 2, 0); }
        const int win = 2 << (c2 >> 6);
#pragma unroll
        for (int i = 0; i < 16; ++i) { f32x2 sum = (f32x2){0.f, 0.f};
#pragma unroll
            for (int k = 1; k < 16; ++k) { const float ok = (k < win && sb + i - k >= 0) ? 1.f : 0.f; sum += (f32x2){bflo(udr[15 + i - k]), bfhi(udr[15 + i - k])} * ok; }
            const int s = sb + i; const float rc = 1.0f / (float)((s + 1 < win) ? (s + 1) : win); const f32x2 ut = (f32x2){bflo(udr[15 + i]), bfhi(udr[15 + i])}; const f32x2 y = (sum + ut) * rc - ut;
            __builtin_amdgcn_raw_buffer_store_b32(pk2(y[0], y[1]), rm, vo, (rowbase + s) * (DM * 2) + 768 * 2, 0); }
    }
    {
        unsigned rv[46], rg[46];
#pragma unroll
        for (int j = 0; j < 46; ++j) { const int s = sb - 30 + j, sc = s < 0 ? 0 : s; const int so = (rowbase + sc) * (NIN * 2) + 768 * 2; rv[j] = bld(rp, vo, so); rg[j] = bld(rp, vo, so + 512); }
        const __amdgpu_buffer_rsrc_t rw = __builtin_amdgcn_make_buffer_rsrc((void*)(F.cdw + (size_t)l * 31 * 256), 0, 31 * 256 * 4, 0x00020000);
        f32x2 w[31];
#pragma unroll
        for (int k = 0; k < 31; ++k) w[k] = bld2(rw, c2 * 4, k * 1024);
        f32x2 acc[16];
        const f32x2 bias = *(const f32x2*)(F.cdb + l * 256 + c2);
#pragma unroll
        for (int i = 0; i < 16; ++i) acc[i] = bias;
#pragma unroll
        for (int j = 0; j < 46; ++j) { const float ok = (sb - 30 + j) >= 0 ? 1.f : 0.f;
            const f32x2 hv = (f32x2){bflo(rv[j]) * sigmoidf_(bflo(rg[j])) * ok, bfhi(rv[j]) * sigmoidf_(bfhi(rg[j])) * ok};
#pragma unroll
            for (int i = 0; i < 16; ++i) { if (j - i >= 0 && j - i <= 30) acc[i] += w[j - i] * hv; } }
#pragma unroll
        for (int i = 0; i < 16; ++i) *(LAS f32x2*)(cbuf + (16 * tq + i) * 256 + c2) = acc[i];
    }
    LDS_WAIT(); __syncthreads();
    {
        const f32x4 g = *(const f32x4*)(F.clg + l * 256 + 4 * lane), bb = *(const f32x4*)(F.clb + l * 256 + 4 * lane);
#pragma unroll 2
        for (int i = 0; i < 8; ++i) { const int t = 8 * F.wave + i; const f32x4 v = *(const LAS f32x4*)(cbuf + t * 256 + 4 * lane);
            const float mu = wave_sum((v[0] + v[1]) + (v[2] + v[3])) * (1.0f / 256.0f); const f32x4 d = v - mu;
            const float var = wave_sum((d[0] * d[0] + d[1] * d[1]) + (d[2] * d[2] + d[3] * d[3])) * (1.0f / 256.0f);
            const float rs = __builtin_amdgcn_rsqf(var + EPS); f32x4 y = d * rs * g + bb;
            y[0] *= sigmoidf_(y[0]); y[1] *= sigmoidf_(y[1]); y[2] *= sigmoidf_(y[2]); y[3] *= sigmoidf_(y[3]);
            v2u w; w.x = pk2(y[0], y[1]); w.y = pk2(y[2], y[3]);
            *(v2u*)(F.MIX + ((size_t)rowbase + s0 + t) * DM + 256 + 4 * lane) = w; }
    }
    __syncthreads();
}

struct Args { const float* in[21]; float* out; unsigned char* ws; int ph_lo, ph_hi, li, pad; };
__global__ void __launch_bounds__(NWAVES * 64, 2) trunk_fwd(Args args) {
    extern __shared__ __attribute__((aligned(16))) unsigned char lds[];
    Frame F;
    F.lds = (LAS unsigned char*)lds;
    F.MISC = (volatile LAS unsigned*)(F.lds + MISC_OFF);
    F.tid = threadIdx.x; F.lane = F.tid & 63; F.wave = __builtin_amdgcn_readfirstlane(F.tid >> 6);
    F.G = gridDim.x; { const int bx = blockIdx.x; F.vcu = (F.G % 8 == 0) ? (bx % 8) * (F.G / 8) + bx / 8 : bx; }
    unsigned char* ws = args.ws; F.ws = ws;
    F.ctl = (gu32*)(ws + WS_CTL);
    F.x = args.in[0]; F.c = args.in[1]; F.w_ada = args.in[2]; F.b_ada = args.in[3]; F.n1g = args.in[4]; F.n2g = args.in[5]; F.w_in = args.in[6]; F.w_out = args.in[7];
    F.qng = args.in[8]; F.kng = args.in[9]; F.lamp = args.in[10]; F.subg = args.in[11]; F.cdw = args.in[12]; F.cdb = args.in[13]; F.clg = args.in[14]; F.clb = args.in[15];
    F.scw = args.in[16]; F.poolw = args.in[17]; F.poolsc = args.in[18]; F.w_ff1 = args.in[19]; F.w_ff2 = args.in[20]; F.out = args.out;
    F.MOD = (float*)(ws + WS_MOD); F.BIAS1 = (float*)(ws + WS_BIAS1); F.BIAS2 = (float*)(ws + WS_BIAS2); F.SSQ1 = (float*)(ws + WS_SSQ1); F.SSQ2 = (float*)(ws + WS_SSQ2);
    F.HA = (bf16*)(ws + WS_HA); F.XB = (bf16*)(ws + WS_XB); F.PROJ = (bf16*)(ws + WS_PROJ); F.MIX = (bf16*)(ws + WS_MIX); F.HID = (bf16*)(ws + WS_HID);
    for (int u = F.tid; u < (LDS_BYTES - LDSCTL_OFF) / 4; u += NWAVES * 64) ((LAS unsigned*)(F.lds + LDSCTL_OFF))[u] = 0u;
    __syncthreads();
    XcdBarrier bar; bar.bar = (unsigned*)(F.ctl + CW_BAR); bar.x = 0; bar.st = nullptr;
    if (!MK_PER_PHASE) bar = xcd_barrier_post((unsigned*)(F.ctl + CW_BAR), F.MISC + 8);
    const int lo = args.ph_lo, hi = args.ph_hi;
#define IN(k) (lo <= (k) && (k) < hi)
#define SEAM(k) do { if (IN((k) + 1)) xcd_barrier(bar); } while (0)

#ifndef PROBE_DUP
#define PROBE_DUP 0
#endif
#ifndef PROBE_N
#define PROBE_N 2
#endif
#define REPS(k) (((PROBE_DUP >> (k)) & 1) ? PROBE_N : 1)
    if (IN(0)) { for (int rep = 0; rep < REPS(0); ++rep) { if (rep) xcd_barrier(bar);
#pragma unroll 1
        for (int L = 0; L < (PREP_UPFRONT ? DEPTH : 1); ++L) prep_layer(F, L, F.vcu, F.G, rep ? ((PROBE_DUP >> 8) & 15) : 3); } SEAM(0); }
    if (IN(1)) { for (int rep = 0; rep < REPS(1); ++rep) { if (rep) xcd_barrier(bar); p0b(F); } SEAM(1); }
#pragma unroll 1
    for (int l = 0; l < DEPTH; ++l) {
        const int p = 2 + 5 * l;
        { int tl = threadIdx.x; asm volatile("" : "+v"(tl)); F.tid = tl; F.lane = tl & 63; F.wave = __builtin_amdgcn_readfirstlane(tl >> 6); }
        int bxl = blockIdx.x; asm volatile("" : "+s"(bxl));
        const float* modl = F.MOD + (size_t)l * 8 * NMOD;
        if (IN(p)) {
            for (int rep = 0; rep < REPS(2); ++rep) { if (rep) { xcd_barrier(bar); int tl = threadIdx.x; asm volatile("" : "+v"(tl)); F.tid = tl; F.lane = tl & 63; F.wave = __builtin_amdgcn_readfirstlane(tl >> 6); asm volatile("" : "+s"(bxl)); }
            pg8::Gemm g{F.HA, wt_ptr(F, l, WT_IN), M, NIN, DM}; pg8::StaticOrder S; S.init(M, NIN, F.G, bxl);
            rstd_table(F, S, F.SSQ1);
            pg8::EpiProj E{F.PROJ, F.BIAS1 + (size_t)l * 8 * NIN, (const LAS float*)(F.lds + RT_OFF), F.qng + l * 32, F.kng + l * 32, QSCALE};
            pg8::gemm_phase<pg8::EpiProj, pg8::StaticOrder, true, true>(F.lds + RING_OFF, g, S, E, F.tid);
            if (!PREP_UPFRONT && l + 1 < DEPTH && !rep) {
                const int nun = (M / 256) * (NIN / 256), rounds = (nun + F.G - 1) / F.G, first_idle = nun - (rounds - 1) * F.G;
                if (first_idle >= F.G) prep_layer(F, l + 1, F.vcu, F.G); else if (bxl >= first_idle) prep_layer(F, l + 1, bxl - first_idle, F.G - first_idle); } }
            SEAM(p);
        }
        if (IN(p + 1)) {
            for (int rep = 0; rep < REPS(3); ++rep) { if (rep) xcd_barrier(bar); attn_phase(F, l); }
            for (int rep = 0; rep < REPS(4); ++rep) { if (rep) xcd_barrier(bar); for (int tt = F.vcu; tt < 256; tt += F.G) mixer_tile(F, l, tt); }
            if (!PREP_UPFRONT && l + 1 < DEPTH) bias_layer(F, l + 1);
            SEAM(p + 1);
        }
        if (IN(p + 2)) {
            for (int rep = 0; rep < REPS(5); ++rep) { if (rep) { xcd_barrier(bar); int tl = threadIdx.x; asm volatile("" : "+v"(tl)); F.tid = tl; F.lane = tl & 63; F.wave = __builtin_amdgcn_readfirstlane(tl >> 6); asm volatile("" : "+s"(bxl)); }
            pg8::Gemm g{F.MIX, wt_ptr(F, l, WT_OUT), M, DM, DM}; pg8::StaticOrder S; S.init(M, DM, F.G, bxl);
            pg8::EpiRes E{(l == 0 || rep) ? F.x : nullptr, F.XB, nullptr, rep ? F.PROJ : F.XB, modl + 2048, modl + 4096, F.n2g + l * DM, rep ? (bf16*)((unsigned char*)F.PROJ + 32 * MiB) : F.HA, rep ? (float*)((unsigned char*)F.PROJ + 64 * MiB) : F.SSQ2, 1};
            pg8::gemm_phase<pg8::EpiRes, pg8::StaticOrder, true, true>(F.lds + RING_OFF, g, S, E, F.tid); }
            SEAM(p + 2);
        }
        if (IN(p + 3)) {
            for (int rep = 0; rep < REPS(6); ++rep) { if (rep) { xcd_barrier(bar); int tl = threadIdx.x; asm volatile("" : "+v"(tl)); F.tid = tl; F.lane = tl & 63; F.wave = __builtin_amdgcn_readfirstlane(tl >> 6); asm volatile("" : "+s"(bxl)); }
            pg8::Gemm g{F.HA, wt_ptr(F, l, WT_FF1), M, FF, DM}; pg8::StaticOrder S; S.init(M, FF, F.G, bxl);
            rstd_table(F, S, F.SSQ2);
            pg8::EpiFF1 E{F.HID, F.BIAS2 + (size_t)l * 8 * FF, (const LAS float*)(F.lds + RT_OFF)};
            pg8::gemm_phase<pg8::EpiFF1, pg8::StaticOrder, true, true>(F.lds + RING_OFF, g, S, E, F.tid); }
            SEAM(p + 3);
        }
        if (IN(p + 4)) {
            for (int rep = 0; rep < REPS(7); ++rep) { if (rep) { xcd_barrier(bar); int tl = threadIdx.x; asm volatile("" : "+v"(tl)); F.tid = tl; F.lane = tl & 63; F.wave = __builtin_amdgcn_readfirstlane(tl >> 6); asm volatile("" : "+s"(bxl)); }
            pg8::Gemm g{F.HID, wt_ptr(F, l, WT_FF2), M, DM, FF}; pg8::StaticOrder S; S.init(M, DM, F.G, bxl);
            const int nl = l + 1 < DEPTH ? l + 1 : l;
            if (rep && l + 1 == DEPTH) break;
            pg8::EpiRes E{rep ? F.x : nullptr, F.XB, (l + 1 == DEPTH && !rep) ? F.out : nullptr, rep ? (bf16*)F.out : F.XB, modl + 5120, F.MOD + (size_t)nl * 8 * NMOD + 1024, F.n1g + nl * DM, rep ? (bf16*)((unsigned char*)F.out + 32 * MiB) : F.HA, rep ? (float*)(F.ws + WS_SSQ2) : F.SSQ1, (l + 1 < DEPTH || rep) ? 1 : 0};
            pg8::gemm_phase<pg8::EpiRes, pg8::StaticOrder, true, true>(F.lds + RING_OFF, g, S, E, F.tid); }
            if (l + 1 < DEPTH) SEAM(p + 4);
        }
    }
#undef IN
#undef SEAM
}

extern "C" void kernel_launch(void* const* d_in, const int* in_sizes, int n_in, void* d_out, int out_size, void* d_ws, size_t ws_size, hipStream_t stream) {
    static int grid = 0;
    if (grid == 0) {
        if (n_in != 21 || in_sizes[0] != M * DM || out_size != M * DM || ws_size < WS_END) { fprintf(stderr, "kernel_launch: unexpected problem shape (n_in %d, in0 %d, out %d, ws %zu, need %zu); nothing launched\n", n_in, n_in > 0 ? in_sizes[0] : -1, out_size, ws_size, (size_t)WS_END); grid = -1; return; }
        int dev = 0, cus = 0, per_cu = 0;
        if (hipGetDevice(&dev) != hipSuccess || hipDeviceGetAttribute(&cus, hipDeviceAttributeMultiprocessorCount, dev) != hipSuccess) { fprintf(stderr, "kernel_launch: device query failed\n"); grid = -1; return; }
        if (hipFuncSetAttribute((const void*)trunk_fwd, hipFuncAttributeMaxDynamicSharedMemorySize, LDS_BYTES) != hipSuccess) { fprintf(stderr, "kernel_launch: hipFuncSetAttribute failed\n"); grid = -1; return; }
        if (hipOccupancyMaxActiveBlocksPerMultiprocessor(&per_cu, (const void*)trunk_fwd, NWAVES * 64, LDS_BYTES) != hipSuccess || per_cu < 1) { fprintf(stderr, "kernel_launch: occupancy query reports %d workgroups per CU\n", per_cu); }
        (void)hipGetLastError();
        grid = cus;
    }
    if (grid < 0) return;
    if (hipMemsetAsync((char*)d_ws + WS_CTL, 0, CTL_ZERO_BYTES, stream) != hipSuccess) { fprintf(stderr, "kernel_launch: hipMemsetAsync failed\n"); return; }
    Args a{};
    for (int i = 0; i < 21; ++i) a.in[i] = (const float*)d_in[i];
    a.out = (float*)d_out; a.ws = (unsigned char*)d_ws;
#if MK_PER_PHASE
    for (int li = 0; li < N_PHASES; ++li) { a.ph_lo = li; a.ph_hi = li + 1; a.li = li;
        hipLaunchKernelGGL(trunk_fwd, dim3(grid), dim3(NWAVES * 64), LDS_BYTES, stream, a); }
#else
    a.ph_lo = 0; a.ph_hi = N_PHASES; a.li = 0;
    hipLaunchKernelGGL(trunk_fwd, dim3(grid), dim3(NWAVES * 64), LDS_BYTES, stream, a);
#endif
    const hipError_t le = hipPeekAtLastError();
    if (le != hipSuccess) fprintf(stderr, "kernel_launch: launch failed: %s\n", hipGetErrorName(le));
}
```

```cpp
#include <hip/hip_runtime.h>
#include <cstdio>
#include <cstdint>
#include <cmath>
namespace pg8 {
#define PG8_LAS __attribute__((address_space(3)))
typedef unsigned short bf16_t;
typedef short bf16x8 __attribute__((ext_vector_type(8)));
typedef float f32x4 __attribute__((ext_vector_type(4)));
typedef unsigned u32x4 __attribute__((ext_vector_type(4)));
constexpr int BM = 256, BK = 64, HALF = 128, HTB = HALF * BK * 2  , STAGE_BYTES = 8 * HTB, NXCD = 8, WGM = 8;

__host__ __device__ __forceinline__ int lds_byte(int r, int c) { const int st = (r >> 4) * 2 + (c >> 5), rr = r & 15, cc = c & 31, ob = rr * 64 + cc * 2; return st * 1024 + (ob ^ (((ob >> 9) & 1) << 5)); }
__host__ __device__ __forceinline__ void stage_rc(int b, int& R, int& C) { const int st = b / 1024, sb = b % 1024, swz = sb ^ (((sb >> 9) & 1) << 5); R = (st >> 1) * 16 + swz / 64; C = (st & 1) * 32 + (swz % 64) / 2; }
__host__ __device__ __forceinline__ int perm32(int rho) { const int n = rho >> 4, i = rho & 15; return 8 * (i >> 2) + 4 * n + (i & 3); }

struct Unit { int pm, pn; };
struct Gemm { const bf16_t* A; const bf16_t* Bt; int M, N, K; };

struct StaticOrder {
    int nM, nN, nwg, G, c;
    __host__ __device__ void init(int M, int N, int G_, int c_) { nM = M / BM; nN = N / BM; nwg = nM * nN; G = G_; c = c_; }
    __host__ __device__ bool next(int i, Unit& u) const {
        const long L = (long)i * G + c; if (L >= nwg) return false;
        int wgid = (int)L; { const int q = nwg / NXCD, r = nwg % NXCD, xcd = wgid % NXCD, off = wgid / NXCD; wgid = (xcd < r ? xcd * (q + 1) : r * (q + 1) + (xcd - r) * q) + off; }
        const int nig = WGM * nN, gid = wgid / nig, fm = gid * WGM, gsz = (nM - fm) < WGM ? (nM - fm) : WGM;
        u.pm = fm + ((wgid % nig) % gsz); u.pn = (wgid % nig) / gsz; return true;
    }
    __device__ __forceinline__ void a_ready(const Unit&) const {}
    __device__ __forceinline__ void done(const Unit&) const {}
};


__device__ __forceinline__ unsigned cvt_pk_bf16(float lo, float hi) { unsigned r; asm volatile("v_cvt_pk_bf16_f32 %0, %1, %2" : "=v"(r) : "v"(lo), "v"(hi)); return r; }
typedef unsigned u32x2 __attribute__((ext_vector_type(2)));
__device__ __forceinline__ float dot4(f32x4 a) { return (a[0] * a[0] + a[1] * a[1]) + (a[2] * a[2] + a[3] * a[3]); }

struct EpiProj {
    static constexpr bool PERM = true, AFTER_DRAIN = false;
    bf16_t* O; const float* bias; const PG8_LAS float* rtab; const float* qg; const float* kg; float qscale;
    __device__ __forceinline__ void operator()(const f32x4 (&acc)[2][2][4][2], const Unit& u, int ui, int wr, int wc, int fr, int fq) const {
        const int b = u.pm >> 3;
        const int row0 = u.pm * BM + wr * 64 + fr, col0 = u.pn * BM + wc * 32 + 8 * fq;
        const float* bp = bias + b * 2304 + col0;
        f32x4 bv[2][2];
#pragma unroll
        for (int bj = 0; bj < 2; ++bj)
#pragma unroll
            for (int n = 0; n < 2; ++n) bv[bj][n] = *(const f32x4*)(bp + bj * HALF + 4 * n);
        const bool isqk = u.pn < 2;
        f32x4 g0 = (f32x4){1.f, 1.f, 1.f, 1.f}, g1 = g0;
        if (isqk) { const float* gp = (u.pn == 0 ? qg : kg) + 8 * fq; g0 = *(const f32x4*)gp; g1 = *(const f32x4*)(gp + 4); if (u.pn == 0) { g0 = g0 * qscale; g1 = g1 * qscale; } }
        const PG8_LAS float* rt = rtab + ui * 256 + wr * 64 + fr;
#pragma unroll
        for (int ai = 0; ai < 2; ++ai)
#pragma unroll
            for (int m = 0; m < 4; ++m) { const float rs = rt[ai * HALF + m * 16]; bf16_t* rowp = O + (size_t)(row0 + ai * HALF + m * 16) * 2304 + col0;
#pragma unroll
                for (int bj = 0; bj < 2; ++bj) { f32x4 v0 = acc[ai][bj][m][0] * rs + bv[bj][0], v1 = acc[ai][bj][m][1] * rs + bv[bj][1];
                    if (isqk) { float ss = dot4(v0) + dot4(v1); ss += __shfl_xor(ss, 16); ss += __shfl_xor(ss, 32);
                        const float r = __builtin_amdgcn_rsqf(ss * (1.0f / 32.0f) + 1e-6f); v0 = v0 * r * g0; v1 = v1 * r * g1; }
                    u32x4 w; w.x = cvt_pk_bf16(v0[0], v0[1]); w.y = cvt_pk_bf16(v0[2], v0[3]); w.z = cvt_pk_bf16(v1[0], v1[1]); w.w = cvt_pk_bf16(v1[2], v1[3]);
                    *(u32x4*)(rowp + bj * HALF) = w; } }
    }
};
struct EpiFF1 {
    static constexpr bool PERM = true, AFTER_DRAIN = false;
    bf16_t* O; const float* bias; const PG8_LAS float* rtab;
    __device__ __forceinline__ void operator()(const f32x4 (&acc)[2][2][4][2], const Unit& u, int ui, int wr, int wc, int fr, int fq) const {
        const int b = u.pm >> 3;
        const int row0 = u.pm * BM + wr * 64 + fr, col0 = u.pn * BM + wc * 32 + 8 * fq;
        const float* bp = bias + b * 4096 + col0;
        f32x4 bv[2][2];
#pragma unroll
        for (int bj = 0; bj < 2; ++bj)
#pragma unroll
            for (int n = 0; n < 2; ++n) bv[bj][n] = *(const f32x4*)(bp + bj * HALF + 4 * n);
        const PG8_LAS float* rt = rtab + ui * 256 + wr * 64 + fr;
        const f32x4 z = (f32x4){0.f, 0.f, 0.f, 0.f};
#pragma unroll
        for (int ai = 0; ai < 2; ++ai)
#pragma unroll
            for (int m = 0; m < 4; ++m) {
#ifdef EXP_A
 const float rs = 1.0f;
#else
 const float rs = rt[ai * HALF + m * 16];
#endif
 bf16_t* rowp = O + (size_t)(row0 + ai * HALF + m * 16) * 4096 + col0;
#pragma unroll
                for (int bj = 0; bj < 2; ++bj) { f32x4 v0 = acc[ai][bj][m][0] * rs + bv[bj][0], v1 = acc[ai][bj][m][1] * rs + bv[bj][1];
                    v0 = __builtin_elementwise_max(v0, z); v1 = __builtin_elementwise_max(v1, z); v0 = v0 * v0; v1 = v1 * v1;
                    u32x4 w; w.x = cvt_pk_bf16(v0[0], v0[1]); w.y = cvt_pk_bf16(v0[2], v0[3]); w.z = cvt_pk_bf16(v1[0], v1[1]); w.w = cvt_pk_bf16(v1[2], v1[3]);
                    *(u32x4*)(rowp + bj * HALF) = w; } }
    }
};
struct EpiRes {
    static constexpr bool PERM = false, AFTER_DRAIN = false;
    const float* xin_f; const bf16_t* xin_h; float* xout_f; bf16_t* xout_h; const float* gate; const float* nsc; const float* ng; bf16_t* hA; float* ssq; int write_next;
    __device__ __forceinline__ void operator()(const f32x4 (&acc)[2][2][4][2], const Unit& u, int ui, int wr, int wc, int fr, int fq) const {
        const int b = u.pm >> 3;
        const int col0 = u.pn * BM + wc * 32 + 4 * fq;
        f32x4 gv[2][2], gm[2][2];
#pragma unroll
        for (int bj = 0; bj < 2; ++bj)
#pragma unroll
            for (int n = 0; n < 2; ++n) { const int c = col0 + bj * HALF + n * 16; gv[bj][n] = *(const f32x4*)(gate + b * 6144 + c);
                if (write_next) gm[bj][n] = *(const f32x4*)(ng + c) * (*(const f32x4*)(nsc + b * 6144 + c) + 1.0f); else gm[bj][n] = (f32x4){0.f, 0.f, 0.f, 0.f}; }
#pragma unroll
        for (int ai = 0; ai < 2; ++ai)
#pragma unroll
            for (int m = 0; m < 4; ++m) { const int row = u.pm * BM + ai * HALF + wr * 64 + m * 16 + fr; float ss = 0.f;
#pragma unroll
                for (int bj = 0; bj < 2; ++bj)
#pragma unroll
                    for (int n = 0; n < 2; ++n) { const size_t off = (size_t)row * 1024 + col0 + bj * HALF + n * 16;
                        f32x4 xi;
                        if (xin_f) xi = *(const f32x4*)(xin_f + off);
                        else { const u32x2 t = *(const u32x2*)(xin_h + off); xi = (f32x4){__builtin_bit_cast(float, t.x << 16), __builtin_bit_cast(float, t.x & 0xffff0000u), __builtin_bit_cast(float, t.y << 16), __builtin_bit_cast(float, t.y & 0xffff0000u)}; }
                        const f32x4 xo = xi + gv[bj][n] * acc[ai][bj][m][n]; ss += dot4(xo);
                        if (xout_f) *(f32x4*)(xout_f + off) = xo;
                        else { u32x2 w; w.x = cvt_pk_bf16(xo[0], xo[1]); w.y = cvt_pk_bf16(xo[2], xo[3]); *(u32x2*)(xout_h + off) = w; }
                        if (write_next) { const f32x4 h = xo * gm[bj][n]; u32x2 w; w.x = cvt_pk_bf16(h[0], h[1]); w.y = cvt_pk_bf16(h[2], h[3]); *(u32x2*)(hA + off) = w; } }
                ss += __shfl_xor(ss, 16); ss += __shfl_xor(ss, 32);
                if (write_next && fq == 0) ssq[(size_t)(u.pn * 4 + wc) * 16384 + row] = ss;
                if (m & 1) asm volatile("" ::: "memory"); }
    }
};

template <class Epi, class Sched, bool ALIGN_EPI = false, bool SP2 = false>
__device__ __forceinline__ void gemm_phase(PG8_LAS unsigned char* lds, const Gemm g, const Sched& S, const Epi& E, const int tid_in) {
    const int tid = tid_in, wid = __builtin_amdgcn_readfirstlane(tid >> 6), lane = tid & 63, wr = wid >> 2, wc = wid & 3, fr = lane & 15, fq = lane >> 4;
    const int K = g.K, nt = K / BK;
    unsigned voffA[2], voffB[2];
#pragma unroll
    for (int i = 0; i < 2; ++i) { int R, C; stage_rc(tid * 16 + i * 8192, R, C); const int Rb = Epi::PERM ? ((R & ~31) + perm32(R & 31)) : R;
        voffA[i] = (unsigned)(R * K + C) * 2u; voffB[i] = (unsigned)(Rb * K + C) * 2u; }
    const size_t kstep = (size_t)(BK * 2);
    const size_t hstep = (size_t)HALF * K * 2;
    const size_t tstep = 2 * hstep;
    const unsigned ldsw = (unsigned)wid * 1024u;
    const int aoff = lds_byte(wr * 64 + fr, fq * 8), boff = lds_byte(wc * 32 + fr, fq * 8);
#define PG8_SA(b, h) (((b) * 2 + (h)) * HTB)
#define PG8_SB(b, h) ((4 + (b) * 2 + (h)) * HTB)
#define PG8_STAGE(bufoff, gbase, voff) do { _Pragma("unroll") for (int _i = 0; _i < 2; ++_i) \
        __builtin_amdgcn_global_load_lds((const unsigned*)((const char*)(gbase) + (voff)[_i]), (PG8_LAS unsigned*)(lds + (bufoff) + ldsw + _i * 8192), 16, 0, 0); } while (0)
#define PG8_LDA(dst, b, h) do { _Pragma("unroll") for (int m = 0; m < 4; ++m) _Pragma("unroll") for (int k = 0; k < 2; ++k) dst[m][k] = *(const PG8_LAS bf16x8*)(lds + PG8_SA(b, h) + aoff + m * 2048 + k * 1024); } while (0)
#define PG8_LDB(dst, b, h) do { _Pragma("unroll") for (int n = 0; n < 2; ++n) _Pragma("unroll") for (int k = 0; k < 2; ++k) dst[n][k] = *(const PG8_LAS bf16x8*)(lds + PG8_SB(b, h) + boff + n * 2048 + k * 1024); } while (0)
#define PG8_MMA(ai, bj, At, Bt) do { __builtin_amdgcn_s_setprio(1); _Pragma("unroll") for (int m = 0; m < 4; ++m) _Pragma("unroll") for (int n = 0; n < 2; ++n) _Pragma("unroll") for (int k = 0; k < 2; ++k) \
        acc[ai][bj][m][n] = __builtin_amdgcn_mfma_f32_16x16x32_bf16(Bt[n][k], At[m][k], acc[ai][bj][m][n], 0, 0, 0); __builtin_amdgcn_s_setprio(0); } while (0)
#define PG8_WAIT_V(n) asm volatile("s_waitcnt vmcnt(" #n ")" ::: "memory")
#define PG8_WAIT_L(n) asm volatile("s_waitcnt lgkmcnt(" #n ")" ::: "memory")
#define PG8_BAR __builtin_amdgcn_s_barrier()
#define PG8_SCHED __builtin_amdgcn_sched_barrier(0)
    Unit cur, nxt; int ui = 0;
    if (!S.next(0, cur)) return;
    f32x4 acc[2][2][4][2];
#pragma unroll
    for (int a = 0; a < 2; ++a)
#pragma unroll
        for (int b = 0; b < 2; ++b)
#pragma unroll
            for (int m = 0; m < 4; ++m)
#pragma unroll
                for (int n = 0; n < 2; ++n) acc[a][b][m][n] = (f32x4){0.f, 0.f, 0.f, 0.f};
    bf16x8 At[4][2], B0[2][2], B1[2][2];
    const char* cA = (const char*)g.A + (size_t)cur.pm * tstep; const char* cB = (const char*)g.Bt + (size_t)cur.pn * tstep;
    S.a_ready(cur);
    if constexpr (SP2) {
        PG8_STAGE(PG8_SB(0, 0), cB, voffB); PG8_STAGE(PG8_SB(0, 1), cB + hstep, voffB); PG8_STAGE(PG8_SA(0, 0), cA, voffA); PG8_STAGE(PG8_SA(0, 1), cA + hstep, voffA);
        if (wr == 1) PG8_BAR;
        PG8_WAIT_V(2); PG8_BAR;
        PG8_STAGE(PG8_SB(1, 0), cB + kstep, voffB); PG8_STAGE(PG8_SA(1, 0), cA + kstep, voffA); PG8_STAGE(PG8_SB(1, 1), cB + hstep + kstep, voffB);
        PG8_WAIT_V(6); PG8_BAR;
    } else {
        PG8_STAGE(PG8_SB(0, 0), cB, voffB); PG8_STAGE(PG8_SA(0, 0), cA, voffA); PG8_STAGE(PG8_SB(0, 1), cB + hstep, voffB); PG8_STAGE(PG8_SA(0, 1), cA + hstep, voffA);
        if (wr == 1) PG8_BAR;
        PG8_WAIT_V(4); PG8_BAR;
        PG8_STAGE(PG8_SB(1, 0), cB + kstep, voffB); PG8_STAGE(PG8_SA(1, 0), cA + kstep, voffA); PG8_STAGE(PG8_SB(1, 1), cB + hstep + kstep, voffB);
        PG8_WAIT_V(6); PG8_BAR;
    }
    for (;;) {
        const bool has_next = S.next(ui + 1, nxt);
        const char* nA = has_next ? (const char*)g.A + (size_t)nxt.pm * tstep : cA; const char* nB = has_next ? (const char*)g.Bt + (size_t)nxt.pn * tstep : cB;
        for (int t = 0; t < nt; t += 2) {
            const bool last = (t == nt - 2);
            const char* a1 = cA + (size_t)(t + 1) * kstep;
            const char* a2 = last ? nA : cA + (size_t)(t + 2) * kstep; const char* b2 = last ? nB : cB + (size_t)(t + 2) * kstep;
            const char* a3 = a2 + kstep; const char* b3 = b2 + kstep;
            if (last && has_next) S.a_ready(nxt);
            if constexpr (SP2) {
            PG8_LDB(B0, 0, 0); PG8_LDB(B1, 0, 1); PG8_SCHED; PG8_LDA(At, 0, 0); PG8_STAGE(PG8_SA(1, 1), a1 + hstep, voffA);
            PG8_WAIT_V(8); PG8_WAIT_L(0); PG8_BAR; PG8_MMA(0, 0, At, B0); PG8_MMA(0, 1, At, B1); PG8_BAR; PG8_SCHED;
            PG8_LDA(At, 0, 1); PG8_STAGE(PG8_SB(0, 0), b2, voffB); PG8_STAGE(PG8_SB(0, 1), b2 + hstep, voffB); PG8_STAGE(PG8_SA(0, 0), a2, voffA);
            PG8_WAIT_V(8); PG8_WAIT_L(0); PG8_BAR; PG8_MMA(1, 0, At, B0); PG8_MMA(1, 1, At, B1); PG8_BAR; PG8_SCHED;
            PG8_LDB(B0, 1, 0); PG8_LDB(B1, 1, 1); PG8_SCHED; PG8_LDA(At, 1, 0); PG8_STAGE(PG8_SA(0, 1), a2 + hstep, voffA);
            PG8_WAIT_V(8); PG8_WAIT_L(0); PG8_BAR; PG8_MMA(0, 0, At, B0); PG8_MMA(0, 1, At, B1); PG8_BAR; PG8_SCHED;
            PG8_LDA(At, 1, 1); PG8_STAGE(PG8_SB(1, 0), b3, voffB); PG8_STAGE(PG8_SB(1, 1), b3 + hstep, voffB); PG8_STAGE(PG8_SA(1, 0), a3, voffA);
            PG8_WAIT_V(8); PG8_WAIT_L(0); PG8_BAR; PG8_MMA(1, 0, At, B0); PG8_MMA(1, 1, At, B1); PG8_BAR; PG8_SCHED;
            } else {
            PG8_LDB(B0, 0, 0); PG8_SCHED; PG8_LDA(At, 0, 0); PG8_STAGE(PG8_SA(1, 1), a1 + hstep, voffA);
            PG8_WAIT_L(8); PG8_BAR; PG8_WAIT_L(0); PG8_MMA(0, 0, At, B0); PG8_BAR; PG8_SCHED;
            PG8_LDB(B1, 0, 1); PG8_STAGE(PG8_SB(0, 0), b2, voffB);
            PG8_BAR; PG8_WAIT_L(0); PG8_MMA(0, 1, At, B1); PG8_BAR;
            PG8_LDA(At, 0, 1); PG8_STAGE(PG8_SA(0, 0), a2, voffA);
            PG8_BAR; PG8_WAIT_L(0); PG8_MMA(1, 0, At, B0); PG8_BAR; PG8_SCHED;
            PG8_STAGE(PG8_SB(0, 1), b2 + hstep, voffB);
            PG8_WAIT_V(6); PG8_BAR; PG8_MMA(1, 1, At, B1); PG8_BAR;
            PG8_LDB(B0, 1, 0); PG8_SCHED; PG8_LDA(At, 1, 0); PG8_STAGE(PG8_SA(0, 1), a2 + hstep, voffA);
            PG8_WAIT_L(8); PG8_BAR; PG8_WAIT_L(0); PG8_MMA(0, 0, At, B0); PG8_BAR; PG8_SCHED;
            PG8_LDB(B1, 1, 1); PG8_STAGE(PG8_SB(1, 0), b3, voffB);
            PG8_BAR; PG8_WAIT_L(0); PG8_MMA(0, 1, At, B1); PG8_BAR;
            PG8_LDA(At, 1, 1); PG8_STAGE(PG8_SA(1, 0), a3, voffA);
            PG8_BAR; PG8_WAIT_L(0); PG8_MMA(1, 0, At, B0); PG8_BAR; PG8_SCHED;
            PG8_STAGE(PG8_SB(1, 1), b3 + hstep, voffB);
            PG8_WAIT_V(6); PG8_BAR; PG8_MMA(1, 1, At, B1); PG8_BAR;
            }
        }
        if constexpr (ALIGN_EPI) { if (wr == 0) PG8_BAR; }
        if constexpr (!Epi::AFTER_DRAIN) { E(acc, cur, ui, wr, wc, fr, fq); S.done(cur); }
        if (!has_next) break;
#pragma unroll
        for (int a = 0; a < 2; ++a)
#pragma unroll
            for (int b = 0; b < 2; ++b)
#pragma unroll
                for (int m = 0; m < 4; ++m)
#pragma unroll
                    for (int n = 0; n < 2; ++n) acc[a][b][m][n] = (f32x4){0.f, 0.f, 0.f, 0.f};
        cur = nxt; cA = nA; cB = nB; ++ui;
        if constexpr (ALIGN_EPI) { if (wr == 1) PG8_BAR; }
    }
    PG8_WAIT_V(0);
    if constexpr (!ALIGN_EPI) { if (wr == 0) PG8_BAR; }
    PG8_BAR;
    if constexpr (Epi::AFTER_DRAIN) { E.fused(acc, cur, wr, wc, fr, fq, lds, wid, lane); S.done(cur); }
#undef PG8_SA
#undef PG8_SB
#undef PG8_STAGE
#undef PG8_LDA
#undef PG8_LDB
#undef PG8_MMA
#undef PG8_WAIT_V
#undef PG8_WAIT_L
#undef PG8_BAR
#undef PG8_SCHED
}
}

constexpr int NWAVES = 8;
constexpr int DM = 1024, BATCH = 8, SEQ = 2048, M = BATCH * SEQ, DEPTH = 4, NIN = 2304, FF = 4096, NMOD = 6144;
constexpr float EPS = 1e-6f;
constexpr float QSCALE = 0.17677669529663687f * 1.4426950408889634f;

#ifndef MK_PER_PHASE
#define MK_PER_PHASE 0
#endif
constexpr int N_PHASES = 2 + 5 * DEPTH;
#ifndef PREP_UPFRONT
#define PREP_UPFRONT 1
#endif

constexpr size_t MiB = 1u << 20;
constexpr size_t WS_CTL = 0, CTL_ZERO_BYTES = 1 * MiB;
constexpr size_t WS_MOD = 1 * MiB;
constexpr size_t WS_BIAS1 = 2 * MiB;
constexpr size_t WS_BIAS2 = 3 * MiB;
constexpr size_t WS_SSQ1 = 4 * MiB, WS_SSQ2 = 5 * MiB;
constexpr size_t WS_WT = 8 * MiB;
constexpr size_t WT_IN = 0, WT_OUT = (size_t)NIN * DM * 2, WT_FF1 = WT_OUT + (size_t)DM * DM * 2, WT_FF2 = WT_FF1 + (size_t)FF * DM * 2, WT_LAYER = WT_FF2 + (size_t)FF * DM * 2;
constexpr size_t WS_HA = WS_WT + DEPTH * WT_LAYER;
constexpr size_t WS_XB = WS_HA + (size_t)M * DM * 2;
constexpr size_t WS_PROJ = WS_XB + (size_t)M * DM * 2;
constexpr size_t WS_MIX = WS_PROJ + (size_t)M * NIN * 2;
constexpr size_t WS_HID = WS_PROJ;
constexpr size_t WS_END = WS_HID + (size_t)M * FF * 2;
static_assert(WT_LAYER == (size_t)(NIN + DM + FF + FF) * DM * 2 && WS_HA % 256 == 0 && WS_PROJ % 256 == 0 && WS_MIX % 256 == 0 && WS_HID % 256 == 0 && WS_MIX + (size_t)M * DM * 2 <= WS_END, "ws map");
constexpr int CW_BAR = 4096;

constexpr int RING_OFF = 0, RING_BYTES = 131072;
constexpr int LDSCTL_OFF = RING_BYTES, MISC_OFF = LDSCTL_OFF + 320;
constexpr int RT_OFF = LDSCTL_OFF + 512;
constexpr int LDS_BYTES = 147456;
static_assert(RT_OFF + 8 * 256 * 4 <= LDS_BYTES, "LDS map");

#define GAS __attribute__((address_space(1)))
#define LAS __attribute__((address_space(3)))
typedef unsigned short bf16;
typedef unsigned v4u __attribute__((ext_vector_type(4)));
typedef unsigned v2u __attribute__((ext_vector_type(2)));
typedef float f32x4 __attribute__((ext_vector_type(4)));
typedef float f32x2 __attribute__((ext_vector_type(2)));
typedef short bf16x8 __attribute__((ext_vector_type(8)));
typedef short s16x4 __attribute__((ext_vector_type(4)));
typedef GAS unsigned gu32;
#define RLX_AGENT __ATOMIC_RELAXED, __HIP_MEMORY_SCOPE_AGENT
#define LDS_WAIT() asm volatile("s_waitcnt lgkmcnt(0)" ::: "memory")
#define VM_WAIT() asm volatile("s_waitcnt vmcnt(0)" ::: "memory")
__device__ __forceinline__ unsigned f2bf(float f) { unsigned u = __builtin_bit_cast(unsigned, f); return (u + 0x7fffu + ((u >> 16) & 1u)) >> 16; }
__device__ __forceinline__ unsigned pk2(float lo, float hi) { return f2bf(lo) | (f2bf(hi) << 16); }
__device__ __forceinline__ float bflo(unsigned v) { return __builtin_bit_cast(float, v << 16); }
__device__ __forceinline__ float bfhi(unsigned v) { return __builtin_bit_cast(float, v & 0xffff0000u); }
__device__ __forceinline__ float wave_sum(float v) {
#pragma unroll
    for (int o = 1; o < 64; o <<= 1) v += __shfl_xor(v, o);
    return v;
}
__device__ __forceinline__ float wave_max(float v) {
#pragma unroll
    for (int o = 1; o < 64; o <<= 1) v = fmaxf(v, __shfl_xor(v, o));
    return v;
}
__device__ __forceinline__ float sigmoidf_(float v) { return 1.0f / (1.0f + __expf(-v)); }

#define XB_TMO      128
#define XB_XCNT(j)  (256  + 64 * (j))
#define XB_XSUB(j)  (1280 + 64 * (j))
#define XB_XGEN(j)  (2304 + 64 * (j))
#define XB_TOP      3328
#define XB_TOPGEN   3392
#define XCD_BAR_WORDS 3456
#define XB_SPIN_CAP (1u << 18)

__device__ __forceinline__ unsigned xb_ld(unsigned* p)              { return __hip_atomic_load(p, __ATOMIC_RELAXED, __HIP_MEMORY_SCOPE_AGENT); }
__device__ __forceinline__ unsigned xb_add(unsigned* p, unsigned v) { return __hip_atomic_fetch_add(p, v, __ATOMIC_RELAXED, __HIP_MEMORY_SCOPE_AGENT); }
__device__ __forceinline__ unsigned xb_xcc_id() { return (unsigned)__builtin_amdgcn_s_getreg((3 << 11) | 20) & 0xFu; }
#define XB_SPIN(cond, bar) do { unsigned _sp = 0; while (cond) { __builtin_amdgcn_s_sleep(1); \
    if ((++_sp & 255u) == 0u) { if (xb_ld(&(bar)[XB_TMO])) break; if (_sp > XB_SPIN_CAP) { atomicAdd(&(bar)[XB_TMO], 1u); break; } } } } while (0)

struct XcdBarrier { unsigned* bar; unsigned x; volatile LAS unsigned* st; };

__device__ __forceinline__ XcdBarrier xcd_barrier_post(unsigned* bar, volatile LAS unsigned* st) {
    XcdBarrier b; b.bar = bar; b.x = xb_xcc_id(); b.st = st;
    if (threadIdx.x == 0) (void)xb_add(&bar[XB_XCNT(b.x)], 1u);
    return b;
}
__device__ __forceinline__ void xcd_barrier_complete(unsigned* bar, unsigned x, unsigned& nloc, unsigned& nx) {
    const unsigned G = gridDim.x * gridDim.y * gridDim.z;
    unsigned sum, cnt, mine, sp = 0u;
    for (;;) {
        sum = 0u; cnt = 0u; mine = 0u;
#pragma unroll
        for (unsigned j = 0; j < 16; ++j) { const unsigned c = xb_ld(&bar[XB_XCNT(j)]); sum += c; cnt += (c > 0u) ? 1u : 0u; mine = (j == x) ? c : mine; }
        if (sum == G) break;
        __builtin_amdgcn_s_sleep(1);
        if ((++sp & 255u) == 0u) { if (xb_ld(&bar[XB_TMO])) break; if (sp > XB_SPIN_CAP) { atomicAdd(&bar[XB_TMO], 1u); break; } }
    }
    nloc = mine > 0u ? mine : 1u; nx = cnt > 0u ? cnt : 1u;
}
__device__ __forceinline__ void xcd_barrier(const XcdBarrier& b) {
    asm volatile("s_waitcnt vmcnt(0)" ::: "memory");
    __syncthreads();
    if (threadIdx.x == 0) {
        unsigned* bar = b.bar;
        __builtin_amdgcn_s_waitcnt(0);
        unsigned nloc = b.st[0], nx = b.st[1];
        if (nloc == 0u) { xcd_barrier_complete(bar, b.x, nloc, nx); b.st[0] = nloc; b.st[1] = nx; }
        const unsigned old = xb_add(&bar[XB_XSUB(b.x)], 1u);
        const unsigned gen = old / nloc;
        if (old + 1u == (gen + 1u) * nloc) {
            __builtin_amdgcn_fence(__ATOMIC_RELEASE, "agent");
            asm volatile("s_waitcnt vmcnt(0)" ::: "memory");
            const unsigned og = xb_add(&bar[XB_TOP], 1u);
            const unsigned tg = og / nx;
            if (og + 1u == (tg + 1u) * nx) xb_add(&bar[XB_TOPGEN], 1u);
            else XB_SPIN(xb_ld(&bar[XB_TOPGEN]) == tg, bar);
            __builtin_amdgcn_fence(__ATOMIC_ACQUIRE, "agent");
            xb_add(&bar[XB_XGEN(b.x)], 1u);
            asm volatile("s_waitcnt vmcnt(0)" ::: "memory");
        } else {
            XB_SPIN(xb_ld(&bar[XB_XGEN(b.x)]) == gen, bar);
            __builtin_amdgcn_fence(__ATOMIC_ACQUIRE, "agent");
            asm volatile("s_waitcnt vmcnt(0)" ::: "memory");
        }
    }
    __syncthreads();
}

struct Frame {
    LAS unsigned char* lds;
    volatile LAS unsigned* MISC;
    gu32* ctl;
    int tid, lane, wave;
    int vcu, G;
    const float *x, *c, *w_ada, *b_ada, *n1g, *n2g, *w_in, *w_out, *qng, *kng, *lamp, *subg, *cdw, *cdb, *clg, *clb, *scw, *poolw, *poolsc, *w_ff1, *w_ff2;
    float* out;
    unsigned char* ws;
    float *MOD, *BIAS1, *BIAS2, *SSQ1, *SSQ2;
    bf16 *HA, *XB, *PROJ, *MIX, *HID;
};
__device__ __forceinline__ bf16* wt_ptr(const Frame& F, int l, size_t off) { return (bf16*)(F.ws + WS_WT + (size_t)l * WT_LAYER + off); }

__device__ __forceinline__ void mod_item(Frame& F, int l, int strip) {
    const int j0 = strip * 32, tid = F.tid;
    LAS float* cact = (LAS float*)(F.lds);
    LAS float* red = (LAS float*)(F.lds + 32768);
    for (int i = tid; i < 8192; i += NWAVES * 64) { const int b = i >> 10, k = i & 1023; const float v = F.c[b * 1024 + k]; cact[k * 8 + b] = v * sigmoidf_(v); }
    __syncthreads();
    {
        const int col4 = tid & 7, kp = tid >> 3;
        const float* wp = F.w_ada + ((size_t)l * 1024 + kp * 16) * NMOD + j0 + col4 * 4;
        f32x4 w[16];
#pragma unroll
        for (int k = 0; k < 16; ++k) w[k] = *(const f32x4*)(wp + (size_t)k * NMOD);
        f32x4 acc[8];
#pragma unroll
        for (int b = 0; b < 8; ++b) acc[b] = (f32x4){0.f, 0.f, 0.f, 0.f};
#pragma unroll
        for (int k = 0; k < 16; ++k) {
            const LAS f32x4* ca = (const LAS f32x4*)(cact + (kp * 16 + k) * 8);
            const f32x4 c0 = ca[0], c1 = ca[1];
            acc[0] += w[k] * c0[0]; acc[1] += w[k] * c0[1]; acc[2] += w[k] * c0[2]; acc[3] += w[k] * c0[3];
            acc[4] += w[k] * c1[0]; acc[5] += w[k] * c1[1]; acc[6] += w[k] * c1[2]; acc[7] += w[k] * c1[3];
        }
#pragma unroll
        for (int b = 0; b < 8; ++b) *(LAS f32x4*)(red + (kp * 8 + b) * 32 + col4 * 4) = acc[b];
    }
    __syncthreads();
    if (tid < 256) { const int b = tid >> 5, cc = tid & 31; float s = F.b_ada[l * NMOD + j0 + cc];
#pragma unroll 16
        for (int kp = 0; kp < 64; ++kp) s += red[(kp * 8 + b) * 32 + cc];
        F.MOD[((size_t)l * 8 + b) * NMOD + j0 + cc] = s; }
    __syncthreads();
}
constexpr int TS = 260;
__device__ __forceinline__ void transpose_item(Frame& F, const float* W, int K, int N, bf16* WT, int kb, int nb, const float* Wp, const float* psc, int mode = 0) {
    const int k0 = 64 * kb, n0 = 256 * nb, lane = F.lane, wv = F.wave;
    LAS float* tile = (LAS float*)(F.lds);
    {
        f32x4 v[8];
#pragma unroll
        for (int i = 0; i < 8; ++i) v[i] = *(const f32x4*)(W + (size_t)(k0 + 8 * wv + i) * N + n0 + 4 * lane);
#pragma unroll
        for (int i = 0; i < 8; ++i) { if (psc) v[i] = v[i] * psc[8 * wv + i]; if (mode < 3) *(LAS f32x4*)(tile + (8 * wv + i) * TS + 4 * lane) = v[i]; else asm volatile("" :: "v"(v[i])); }
    }
    LDS_WAIT(); __syncthreads();
    if (mode >= 2) return;
    if (Wp) {
        typedef float f32x4_t __attribute__((ext_vector_type(4)));
        const int li = lane & 15, lk = lane >> 4;
        f32x4_t acc[4][2];
#pragma unroll
        for (int ct = 0; ct < 4; ++ct) { acc[ct][0] = (f32x4_t){0.f, 0.f, 0.f, 0.f}; acc[ct][1] = acc[ct][0]; }
#pragma unroll 4
        for (int d0 = 0; d0 < 64; d0 += 4) {
            const float b0 = tile[(d0 + lk) * TS + 32 * wv + li], b1 = tile[(d0 + lk) * TS + 32 * wv + 16 + li];
#pragma unroll
            for (int ct = 0; ct < 4; ++ct) { const float a = Wp[(16 * ct + li) * 64 + d0 + lk];
                acc[ct][0] = __builtin_amdgcn_mfma_f32_16x16x4f32(a, b0, acc[ct][0], 0, 0, 0); acc[ct][1] = __builtin_amdgcn_mfma_f32_16x16x4f32(a, b1, acc[ct][1], 0, 0, 0); }
        }
        LDS_WAIT(); __syncthreads();
#pragma unroll
        for (int ct = 0; ct < 4; ++ct)
#pragma unroll
            for (int r = 0; r < 4; ++r) { tile[(16 * ct + 4 * lk + r) * TS + 32 * wv + li] = acc[ct][0][r]; tile[(16 * ct + 4 * lk + r) * TS + 32 * wv + 16 + li] = acc[ct][1][r]; }
        LDS_WAIT(); __syncthreads();
    }
    {
        const int n = 32 * wv + (lane & 31), ch = lane >> 5;
#pragma unroll
        for (int j = 0; j < 4; ++j) { const int c = 4 * ch + j; const LAS float* s = tile + (8 * c) * TS + n;
            v4u o; o.x = pk2(s[0 * TS], s[1 * TS]); o.y = pk2(s[2 * TS], s[3 * TS]); o.z = pk2(s[4 * TS], s[5 * TS]); o.w = pk2(s[6 * TS], s[7 * TS]);
            if (mode == 0) *(GAS v4u*)(WT + (size_t)(n0 + n) * K + k0 + 8 * c) = o; else asm volatile("" :: "v"(o)); }
    }
    LDS_WAIT(); __syncthreads();
}
__device__ __forceinline__ void prep_layer(Frame& F, int L, int rank, int nranks, int what = 3) {
    constexpr int I_MOD = NMOD / 32, I_IN = (DM / 64) * (NIN / 256), I_OUT = (DM / 64) * (DM / 256), I_1 = (DM / 64) * (FF / 256), I_2 = (FF / 64) * (DM / 256), I_ALL = I_MOD + I_IN + I_OUT + I_1 + I_2;
    const int l = L;
#pragma unroll 1
    for (int it = rank; it < I_ALL; it += nranks) {
        int r = it;
        if (r < I_MOD) { if (what & 1) mod_item(F, l, r); continue; } r -= I_MOD;
        if (!(what & 2)) continue;
        if (r < I_IN) { transpose_item(F, F.w_in + (size_t)l * DM * NIN, DM, NIN, wt_ptr(F, l, WT_IN), r / (NIN / 256), r % (NIN / 256), nullptr, nullptr, what >> 2); continue; } r -= I_IN;
        if (r < I_OUT) { const int kb = r / 4, nb = r % 4;
            if (kb < 12) transpose_item(F, F.w_out + (size_t)l * DM * DM, DM, DM, wt_ptr(F, l, WT_OUT), kb, nb, nullptr, nullptr, what >> 2);
            else transpose_item(F, F.w_out + (size_t)l * DM * DM, DM, DM, wt_ptr(F, l, WT_OUT), kb, nb, F.poolw + ((size_t)l * 4 + (kb - 12)) * 4096, F.poolsc + l * 256 + 64 * (kb - 12), what >> 2);
            continue; } r -= I_OUT;
        if (r < I_1) { transpose_item(F, F.w_ff1 + (size_t)l * DM * FF, DM, FF, wt_ptr(F, l, WT_FF1), r / (FF / 256), r % (FF / 256), nullptr, nullptr, what >> 2); continue; } r -= I_1;
        transpose_item(F, F.w_ff2 + (size_t)l * FF * DM, FF, DM, wt_ptr(F, l, WT_FF2), r / 4, r % 4, nullptr, nullptr, what >> 2);
    }
}
__device__ __forceinline__ void bias_layer(Frame& F, int l) {
    const int gw = F.vcu * NWAVES + F.wave, NGW = F.G * NWAVES, lane = F.lane;
#pragma unroll 1
    for (int kind = 0; kind < 2; ++kind) {
        const int N = kind ? FF : NIN;
        const bf16* Wt = wt_ptr(F, l, kind ? WT_FF1 : WT_IN);
        const float* sh = F.MOD + (size_t)l * 8 * NMOD + (kind ? 3072 : 0);
        float* outp = kind ? F.BIAS2 + (size_t)l * 8 * FF : F.BIAS1 + (size_t)l * 8 * NIN;
        f32x4 shr[8][4];
#pragma unroll
        for (int b = 0; b < 8; ++b)
#pragma unroll
            for (int j = 0; j < 4; ++j) shr[b][j] = *(const f32x4*)(sh + (size_t)b * NMOD + 16 * lane + 4 * j);
        for (int n = gw; n < N; n += NGW) {
            const v4u w0 = *(const v4u*)(Wt + (size_t)n * DM + 16 * lane), w1 = *(const v4u*)(Wt + (size_t)n * DM + 16 * lane + 8);
            const f32x4 wv0 = (f32x4){bflo(w0.x), bfhi(w0.x), bflo(w0.y), bfhi(w0.y)}, wv1 = (f32x4){bflo(w0.z), bfhi(w0.z), bflo(w0.w), bfhi(w0.w)};
            const f32x4 wv2 = (f32x4){bflo(w1.x), bfhi(w1.x), bflo(w1.y), bfhi(w1.y)}, wv3 = (f32x4){bflo(w1.z), bfhi(w1.z), bflo(w1.w), bfhi(w1.w)};
            float a[8];
#pragma unroll
            for (int b = 0; b < 8; ++b) { const f32x4 t = shr[b][0] * wv0 + shr[b][1] * wv1 + shr[b][2] * wv2 + shr[b][3] * wv3; a[b] = wave_sum((t[0] + t[1]) + (t[2] + t[3])); }
            if (lane == 0) {
#pragma unroll
                for (int b = 0; b < 8; ++b) outp[(size_t)b * N + n] = a[b]; }
        }
    }
}
__device__ __forceinline__ void p0b(Frame& F) {
#pragma unroll 1
    for (int L = 0; L < (PREP_UPFRONT ? DEPTH : 1); ++L) bias_layer(F, L);
    const int gw = F.vcu * NWAVES + F.wave, NGW = F.G * NWAVES, lane = F.lane;
    for (int m = gw; m < M; m += NGW) {
        const int b = m >> 11; const GAS f32x4* xr = (const GAS f32x4*)(F.x + (size_t)m * DM) + lane;
        const f32x4* gr = (const f32x4*)(F.n1g) + lane; const f32x4* sr = (const f32x4*)(F.MOD + (size_t)b * NMOD + 1024) + lane;
        float ss = 0.f; GAS v2u* o8 = (GAS v2u*)(F.HA + (size_t)m * DM) + lane;
#pragma unroll
        for (int j = 0; j < 4; ++j) { const f32x4 v = xr[64 * j]; ss += (v[0] * v[0] + v[1] * v[1]) + (v[2] * v[2] + v[3] * v[3]);
            const f32x4 h = v * gr[64 * j] * (sr[64 * j] + 1.0f); v2u w; w.x = pk2(h[0], h[1]); w.y = pk2(h[2], h[3]); o8[64 * j] = w; }
        ss = wave_sum(ss);
        if (lane < 16) F.SSQ1[(size_t)lane * M + m] = lane == 0 ? ss : 0.f;
    }
}
__device__ __forceinline__ void rstd_table(Frame& F, const pg8::StaticOrder& S, const float* ssq) {
    LAS float* tab = (LAS float*)(F.lds + RT_OFF);
    pg8::Unit u;
    for (int ui = 0; ui < 8 && S.next(ui, u); ++ui) {
        if (F.tid < 256) { const int row = u.pm * 256 + F.tid; float s = 0.f;
#pragma unroll
            for (int p = 0; p < 16; ++p) s += ssq[(size_t)p * M + row];
            tab[ui * 256 + F.tid] = __builtin_amdgcn_rsqf(s * (1.0f / DM) + EPS); }
    }
    LDS_WAIT(); __syncthreads();
}

__device__ __forceinline__ s16x4 vtr(const LAS unsigned char* p) { typedef short v4i16_t __attribute__((ext_vector_type(4))); return __builtin_bit_cast(s16x4, __builtin_amdgcn_ds_read_tr16_b64_v4i16((LAS v4i16_t*)p)); }
__device__ __forceinline__ void glds16(const void* gsrc, LAS unsigned char* dst) { __builtin_amdgcn_global_load_lds((const unsigned*)gsrc, (LAS unsigned*)dst, 16, 0, 0); }
__device__ __forceinline__ void attn_qk(f32x4 (&s)[2][4], const LAS unsigned char* kb_, bf16x8 q0, bf16x8 q1, f32x4 negM) {
#pragma unroll
    for (int kb = 0; kb < 4; ++kb) { const bf16x8 k0 = *(const LAS bf16x8*)(kb_ + kb * 256), k1 = *(const LAS bf16x8*)(kb_ + 4096 + kb * 256);
        s[0][kb] = __builtin_amdgcn_mfma_f32_16x16x32_bf16(k0, q0, negM, 0, 0, 0); s[1][kb] = __builtin_amdgcn_mfma_f32_16x16x32_bf16(k1, q1, negM, 0, 0, 0); }
}
__device__ __forceinline__ void attn_exp(f32x4 (&s)[2][4], bf16x8 (&pw)[2][2], bool band, int key0, int qrow) {
    if (band) {
#pragma unroll
        for (int kb = 0; kb < 4; ++kb)
#pragma unroll
            for (int r = 0; r < 4; ++r) { const int key = key0 + 16 * kb + r; if (key > qrow) { s[0][kb][r] = -INFINITY; s[1][kb][r] = -INFINITY; } }
    }
#pragma unroll
    for (int kb = 0; kb < 4; ++kb)
#pragma unroll
        for (int r = 0; r < 4; ++r) { s[0][kb][r] = __builtin_amdgcn_exp2f(s[0][kb][r]); s[1][kb][r] = __builtin_amdgcn_exp2f(s[1][kb][r]); }
#pragma unroll
    for (int m = 0; m < 2; ++m)
#pragma unroll
        for (int ks = 0; ks < 2; ++ks) { v4u w; w.x = pg8::cvt_pk_bf16(s[m][2 * ks][0], s[m][2 * ks][1]); w.y = pg8::cvt_pk_bf16(s[m][2 * ks][2], s[m][2 * ks][3]);
            w.z = pg8::cvt_pk_bf16(s[m][2 * ks + 1][0], s[m][2 * ks + 1][1]); w.w = pg8::cvt_pk_bf16(s[m][2 * ks + 1][2], s[m][2 * ks + 1][3]); pw[m][ks] = __builtin_bit_cast(bf16x8, w); }
}
__device__ __forceinline__ void attn_pv(const bf16x8 (&pw)[2][2], f32x4 (&o)[2][4], f32x4 (&ol)[2], const LAS unsigned char* vb_, int vE, int vO) {
    const bf16x8 ones = (bf16x8){0x3F80, 0x3F80, 0x3F80, 0x3F80, 0x3F80, 0x3F80, 0x3F80, 0x3F80};
    const unsigned va0 = (unsigned)(size_t)(vb_ + vE), va1 = (unsigned)(size_t)(vb_ + vO);
#pragma unroll
    for (int ks = 0; ks < 2; ++ks) {
        s16x4 lo[4], hi[4];
#define ATT_TR(dst, addr, off) asm volatile("ds_read_b64_tr_b16 %0, %1 offset:%c2" : "=&v"(dst) : "v"(addr), "i"(off) : "memory")
        if (ks == 0) { ATT_TR(lo[0], va0, 0); ATT_TR(hi[0], va0, 1024); ATT_TR(lo[1], va1, 0); ATT_TR(hi[1], va1, 1024);
                       ATT_TR(lo[2], va0, 4096); ATT_TR(hi[2], va0, 4096 + 1024); ATT_TR(lo[3], va1, 4096); ATT_TR(hi[3], va1, 4096 + 1024); }
        else         { ATT_TR(lo[0], va0, 2048); ATT_TR(hi[0], va0, 2048 + 1024); ATT_TR(lo[1], va1, 2048); ATT_TR(hi[1], va1, 2048 + 1024);
                       ATT_TR(lo[2], va0, 4096 + 2048); ATT_TR(hi[2], va0, 4096 + 2048 + 1024); ATT_TR(lo[3], va1, 4096 + 2048); ATT_TR(hi[3], va1, 4096 + 2048 + 1024); }
#undef ATT_TR
        asm volatile("s_waitcnt lgkmcnt(0)" : "+v"(lo[0]), "+v"(hi[0]), "+v"(lo[1]), "+v"(hi[1]), "+v"(lo[2]), "+v"(hi[2]), "+v"(lo[3]), "+v"(hi[3]) :: "memory");
        __builtin_amdgcn_sched_barrier(0);
#pragma unroll
        for (int d0 = 0; d0 < 4; ++d0) {
            const bf16x8 vf = (bf16x8){lo[d0][0], lo[d0][1], lo[d0][2], lo[d0][3], hi[d0][0], hi[d0][1], hi[d0][2], hi[d0][3]};
            o[0][d0] = __builtin_amdgcn_mfma_f32_16x16x32_bf16(pw[0][ks], vf, o[0][d0], 0, 0, 0);
            o[1][d0] = __builtin_amdgcn_mfma_f32_16x16x32_bf16(pw[1][ks], vf, o[1][d0], 0, 0, 0); }
        ol[0] = __builtin_amdgcn_mfma_f32_16x16x32_bf16(pw[0][ks], ones, ol[0], 0, 0, 0);
        ol[1] = __builtin_amdgcn_mfma_f32_16x16x32_bf16(pw[1][ks], ones, ol[1], 0, 0, 0); }
}
__device__ __forceinline__ void attn_epilogue(Frame& F, const f32x4 (&o)[2][4], const f32x4 (&ol)[2], const float (&sgv)[4], float lam, bf16* op) {
    const int lane = F.lane;
#pragma unroll
    for (int r = 0; r < 4; ++r) {
        const float a0 = 1.0f / ol[0][r], a1 = lam / ol[1][r];
        float ov[4], ss = 0.f;
#pragma unroll
        for (int d0 = 0; d0 < 4; ++d0) { ov[d0] = o[0][d0][r] * a0 - o[1][d0][r] * a1; ss += ov[d0] * ov[d0]; }
        ss += __shfl_xor(ss, 1); ss += __shfl_xor(ss, 2); ss += __shfl_xor(ss, 4); ss += __shfl_xor(ss, 8);
        const float rn = __builtin_amdgcn_rsqf(ss * (1.0f / 64.0f) + EPS);
#pragma unroll
        for (int d0 = 0; d0 < 4; ++d0) op[(size_t)r * DM + 16 * d0] = (bf16)f2bf(ov[d0] * rn * sgv[d0]);
    }
    (void)lane;
}
__device__ __forceinline__ void attn_pair(Frame& F, int l, int b, int h, int sidx, float lam, float negMv, float outscale) {
    const int lane = F.lane, wid = F.wave, fr = lane & 15, fq = lane >> 4;
    LAS unsigned char* lds = F.lds;
    const size_t rowbase = (size_t)b * SEQ;
    const bf16* proj = F.PROJ;
    const int qbA = 15 - sidx, qbB = sidx, NTa = 2 * (qbA + 1), NTb = 2 * (qbB + 1), S = NTa + NTb;
    const bf16* qpA = proj + (rowbase + qbA * 128 + 16 * wid + fr) * NIN + h * 64 + 8 * fq;
    const bf16* qpB = proj + (rowbase + qbB * 128 + 16 * wid + fr) * NIN + h * 64 + 8 * fq;
    const bf16x8 qa0 = *(const bf16x8*)qpA, qa1 = *(const bf16x8*)(qpA + 32), qb0 = *(const bf16x8*)qpB, qb1 = *(const bf16x8*)(qpB + 32);
    const bf16* ksrc = proj + (rowbase + lane) * NIN + 256 + h * 64 + wid * 8;
    const bf16* vsrc = proj + (rowbase + 16 * (wid & 3) + (lane >> 2)) * NIN + 512 + h * 64 + (wid >> 2) * 32 + 8 * ((lane & 3) ^ (2 * ((lane >> 4) & 1)));
    LAS unsigned char* kdst = lds + wid * 1024;
    LAS unsigned char* vdst = lds + 65536 + wid * 1024;
    f32x4 o[2][4], ol[2];
#pragma unroll
    for (int m = 0; m < 2; ++m) { ol[m] = (f32x4){0.f, 0.f, 0.f, 0.f};
#pragma unroll
        for (int d = 0; d < 4; ++d) o[m][d] = (f32x4){0.f, 0.f, 0.f, 0.f}; }
    const f32x4 negM = (f32x4){negMv, negMv, negMv, negMv};
    const int koff = fq * 1024 + fr * 16;
    const int prow = fr >> 2, pp = fr & 3;
    const int vrow = (4 * fq + prow) * 64 + (pp & 1) * 8 + (pp >> 1) * 16;
    const int vE = vrow + 32 * (fq & 1), vO = vrow + 32 * (1 - (fq & 1));
    float sgv[4];
#pragma unroll
    for (int d0 = 0; d0 < 4; ++d0) sgv[d0] = F.subg[l * 64 + 16 * d0 + fr] * outscale;
#define ATT_TILE(s) ((s) < NTa ? (s) : (s) - NTa)
#define ATT_SRC(s) ((size_t)ATT_TILE((s) < S ? (s) : S - 1) * 64 * NIN)
#define ATT_BAR(N) do { asm volatile("s_waitcnt vmcnt(" #N ") lgkmcnt(0)" ::: "memory"); __builtin_amdgcn_s_barrier(); asm volatile("" ::: "memory"); } while (0)
#define ATT_BARL() do { asm volatile("s_waitcnt lgkmcnt(0)" ::: "memory"); __builtin_amdgcn_s_barrier(); asm volatile("" ::: "memory"); } while (0)
    glds16(ksrc + ATT_SRC(0), kdst);
    glds16(ksrc + ATT_SRC(1), kdst + 8192); glds16(vsrc + ATT_SRC(0), vdst);
    glds16(ksrc + ATT_SRC(2), kdst + 2 * 8192); glds16(vsrc + ATT_SRC(1), vdst + 8192);
    glds16(ksrc + ATT_SRC(3), kdst + 3 * 8192); glds16(vsrc + ATT_SRC(2), vdst + 2 * 8192);
    ATT_BAR(6);
    f32x4 sA[2][4], sB[2][4]; bf16x8 pw[2][2];
    attn_qk(sA, lds + koff, qa0, qa1, negM);
    const bool late = wid >= 4;
#define ATT_A(s, CUR, NXT) do { \
        glds16(ksrc + ATT_SRC((s) + 4), kdst + (((s) + 4) & 7) * 8192); glds16(vsrc + ATT_SRC((s) + 3), vdst + (((s) + 3) & 7) * 8192); \
        if ((s) + 1 < S) { const bool nb_ = ((s) + 1 >= NTa); attn_qk(NXT, lds + (((s) + 1) & 7) * 8192 + koff, nb_ ? qb0 : qa0, nb_ ? qb1 : qa1, negM); } \
        { const bool inB_ = (s) >= NTa; const int tile_ = ATT_TILE(s), NTu_ = inB_ ? NTb : NTa, q0_ = (inB_ ? qbB : qbA) * 128; \
          attn_exp(CUR, pw, tile_ >= NTu_ - 2, 64 * tile_ + 4 * fq, q0_ + 16 * wid + fr); } \
    } while (0)
#define ATT_B(s) do { \
        const bool inB_ = (s) >= NTa; const int tile_ = ATT_TILE(s), NTu_ = inB_ ? NTb : NTa, q0_ = (inB_ ? qbB : qbA) * 128; \
        attn_pv(pw, o, ol, lds + 65536 + ((s) & 7) * 8192, vE, vO); \
        if (tile_ == NTu_ - 1) { attn_epilogue(F, o, ol, sgv, lam, F.MIX + (rowbase + q0_ + 16 * wid + 4 * fq) * DM + h * 64 + fr); \
            asm volatile("s_waitcnt vmcnt(0)" ::: "memory");      \
            _Pragma("unroll") for (int m_ = 0; m_ < 2; ++m_) { ol[m_] = (f32x4){0.f, 0.f, 0.f, 0.f}; _Pragma("unroll") for (int d_ = 0; d_ < 4; ++d_) o[m_][d_] = (f32x4){0.f, 0.f, 0.f, 0.f}; } } \
    } while (0)
#define ATT_STEP(s, CUR, NXT) do { ATT_BAR(4); ATT_A(s, CUR, NXT); ATT_BAR(4); ATT_B(s); } while (0)
    if (late) ATT_BAR(4);
#pragma unroll 1
    for (int s = 0; s < S; s += 2) { ATT_STEP(s, sA, sB); ATT_STEP(s + 1, sB, sA); }
    if (!late) ATT_BAR(4);
#undef ATT_STEP
#undef ATT_A
#undef ATT_B
#undef ATT_TILE
#undef ATT_SRC
    ATT_BAR(0);
#undef ATT_BAR
#undef ATT_BARL
}
__device__ __forceinline__ void attn_phase(Frame& F, int l) {
    const int lane = F.lane; const float* lp = F.lamp + l * 128;
    float pa = lane < 32 ? lp[lane] * lp[32 + lane] : 0.f, pb = lane < 32 ? lp[64 + lane] * lp[96 + lane] : 0.f;
    pa = wave_sum(pa); pb = wave_sum(pb);
    const float lam_init = 0.8f - 0.6f * __expf(-0.3f * (float)l);
    const float lam = __expf(pa) - __expf(pb) + lam_init;
    const float gq = wave_max(fabsf(F.qng[l * 32 + (lane & 31)])), gk = wave_max(fabsf(F.kng[l * 32 + (lane & 31)]));
    const float negMv = -(QSCALE * 32.0f * gq * gk);
    for (int pi = F.vcu; pi < 256; pi += F.G) {
        const int bh = pi >> 3, s = pi & 7;
        attn_pair(F, l, bh >> 2, bh & 3, s, lam, negMv, 1.0f - lam_init);
    }
}
__device__ __forceinline__ unsigned bld(__amdgpu_buffer_rsrc_t r, int voff, int soff) { return __builtin_amdgcn_raw_buffer_load_b32(r, voff, soff, 0); }
__device__ __forceinline__ f32x2 bld2(__amdgpu_buffer_rsrc_t r, int voff, int soff) { typedef unsigned u2 __attribute__((ext_vector_type(2))); const u2 v = __builtin_amdgcn_raw_buffer_load_b64(r, voff, soff, 0); return __builtin_bit_cast(f32x2, v); }
__device__ __forceinline__ void mixer_tile(Frame& F, int l, int tt) {
    const int tid = F.tid, lane = F.lane; const int b = tt >> 5, s0 = (tt & 31) * 64; const int rowbase = b * SEQ;
    LAS float* cbuf = (LAS float*)F.lds;
    const int c2 = (tid & 127) * 2, tq = F.wave >> 1, sb = s0 + 16 * tq;
    const __amdgpu_buffer_rsrc_t rp = __builtin_amdgcn_make_buffer_rsrc((void*)F.PROJ, 0, (int)((size_t)M * NIN * 2), 0x00020000);
    const __amdgpu_buffer_rsrc_t rm = __builtin_amdgcn_make_buffer_rsrc((void*)F.MIX, 0, (int)((size_t)M * DM * 2), 0x00020000);
    const int vo = c2 * 2;
    {
        unsigned cgr[18], xcr[18], bgr[16], udr[31];
#pragma unroll
        for (int j = 0; j < 18; ++j) { const int s = sb - 2 + j, sc = s < 0 ? 0 : s; const int so = (rowbase + sc) * (NIN * 2) + 1536 * 2; cgr[j] = bld(rp, vo, so); xcr[j] = bld(rp, vo, so + 512); }
#pragma unroll
        for (int j = 0; j < 16; ++j) bgr[j] = bld(rp, vo, (rowbase + sb + j) * (NIN * 2) + 1280 * 2);
#pragma unroll
        for (int j = 0; j < 31; ++j) { const int s = sb - 15 + j, sc = s < 0 ? 0 : s; udr[j] = bld(rp, vo, (rowbase + sc) * (NIN * 2) + 2048 * 2); }
        const __amdgpu_buffer_rsrc_t rw = __builtin_amdgcn_make_buffer_rsrc((void*)(F.scw + (size_t)l * 3 * 256), 0, 3 * 256 * 4, 0x00020000);
        f32x2 w3[3];
#pragma unroll
        for (int k = 0; k < 3; ++k) w3[k] = bld2(rw, c2 * 4, k * 1024);
        f32x2 pr[18];
#pragma unroll
        for (int j = 0; j < 18; ++j) { const float ok = (sb - 2 + j) >= 0 ? 1.f : 0.f; pr[j] = (f32x2){bflo(cgr[j]) * bflo(xcr[j]) * ok, bfhi(cgr[j]) * bfhi(xcr[j]) * ok}; }
#pragma unroll
        for (int i = 0; i < 16; ++i) { const f32x2 cv = w3[0] * pr[i] + w3[1] * pr[i + 1] + w3[2] * pr[i + 2];
            __builtin_amdgcn_raw_buffer_store_b32(pk2(bflo(bgr[i]) * cv[0], bfhi(bgr[i]) * cv[1]), rm, vo, (rowbase + sb + i) * (DM * 2) + 512 * 2, 0); }
        const int win = 2 << (c2 >> 6);
#pragma unroll
        for (int i = 0; i < 16; ++i) { f32x2 sum = (f32x2){0.f, 0.f};
#pragma unroll
            for (int k = 1; k < 16; ++k) { const float ok = (k < win && sb + i - k >= 0) ? 1.f : 0.f; sum += (f32x2){bflo(udr[15 + i - k]), bfhi(udr[15 + i - k])} * ok; }
            const int s = sb + i; const float rc = 1.0f / (float)((s + 1 < win) ? (s + 1) : win); const f32x2 ut = (f32x2){bflo(udr[15 + i]), bfhi(udr[15 + i])}; const f32x2 y = (sum + ut) * rc - ut;
            __builtin_amdgcn_raw_buffer_store_b32(pk2(y[0], y[1]), rm, vo, (rowbase + s) * (DM * 2) + 768 * 2, 0); }
    }
    {
        unsigned rv[46], rg[46];
#pragma unroll
        for (int j = 0; j < 46; ++j) { const int s = sb - 30 + j, sc = s < 0 ? 0 : s; const int so = (rowbase + sc) * (NIN * 2) + 768 * 2; rv[j] = bld(rp, vo, so); rg[j] = bld(rp, vo, so + 512); }
        const __amdgpu_buffer_rsrc_t rw = __builtin_amdgcn_make_buffer_rsrc((void*)(F.cdw + (size_t)l * 31 * 256), 0, 31 * 256 * 4, 0x00020000);
        f32x2 w[31];
#pragma unroll
        for (int k = 0; k < 31; ++k) w[k] = bld2(rw, c2 * 4, k * 1024);
        f32x2 acc[16];
        const f32x2 bias = *(const f32x2*)(F.cdb + l * 256 + c2);
#pragma unroll
        for (int i = 0; i < 16; ++i) acc[i] = bias;
#pragma unroll
        for (int j = 0; j < 46; ++j) { const float ok = (sb - 30 + j) >= 0 ? 1.f : 0.f;
            const f32x2 hv = (f32x2){bflo(rv[j]) * sigmoidf_(bflo(rg[j])) * ok, bfhi(rv[j]) * sigmoidf_(bfhi(rg[j])) * ok};
#pragma unroll
            for (int i = 0; i < 16; ++i) { if (j - i >= 0 && j - i <= 30) acc[i] += w[j - i] * hv; } }
#pragma unroll
        for (int i = 0; i < 16; ++i) *(LAS f32x2*)(cbuf + (16 * tq + i) * 256 + c2) = acc[i];
    }
    LDS_WAIT(); __syncthreads();
    {
        const f32x4 g = *(const f32x4*)(F.clg + l * 256 + 4 * lane), bb = *(const f32x4*)(F.clb + l * 256 + 4 * lane);
#pragma unroll 2
        for (int i = 0; i < 8; ++i) { const int t = 8 * F.wave + i; const f32x4 v = *(const LAS f32x4*)(cbuf + t * 256 + 4 * lane);
            const float mu = wave_sum((v[0] + v[1]) + (v[2] + v[3])) * (1.0f / 256.0f); const f32x4 d = v - mu;
            const float var = wave_sum((d[0] * d[0] + d[1] * d[1]) + (d[2] * d[2] + d[3] * d[3])) * (1.0f / 256.0f);
            const float rs = __builtin_amdgcn_rsqf(var + EPS); f32x4 y = d * rs * g + bb;
            y[0] *= sigmoidf_(y[0]); y[1] *= sigmoidf_(y[1]); y[2] *= sigmoidf_(y[2]); y[3] *= sigmoidf_(y[3]);
            v2u w; w.x = pk2(y[0], y[1]); w.y = pk2(y[2], y[3]);
            *(v2u*)(F.MIX + ((size_t)rowbase + s0 + t) * DM + 256 + 4 * lane) = w; }
    }
    __syncthreads();
}

struct Args { const float* in[21]; float* out; unsigned char* ws; int ph_lo, ph_hi, li, pad; };
__global__ void __launch_bounds__(NWAVES * 64, 2) trunk_fwd(Args args) {
    extern __shared__ __attribute__((aligned(16))) unsigned char lds[];
    Frame F;
    F.lds = (LAS unsigned char*)lds;
    F.MISC = (volatile LAS unsigned*)(F.lds + MISC_OFF);
    F.tid = threadIdx.x; F.lane = F.tid & 63; F.wave = __builtin_amdgcn_readfirstlane(F.tid >> 6);
    F.G = gridDim.x; { const int bx = blockIdx.x; F.vcu = (F.G % 8 == 0) ? (bx % 8) * (F.G / 8) + bx / 8 : bx; }
    unsigned char* ws = args.ws; F.ws = ws;
    F.ctl = (gu32*)(ws + WS_CTL);
    F.x = args.in[0]; F.c = args.in[1]; F.w_ada = args.in[2]; F.b_ada = args.in[3]; F.n1g = args.in[4]; F.n2g = args.in[5]; F.w_in = args.in[6]; F.w_out = args.in[7];
    F.qng = args.in[8]; F.kng = args.in[9]; F.lamp = args.in[10]; F.subg = args.in[11]; F.cdw = args.in[12]; F.cdb = args.in[13]; F.clg = args.in[14]; F.clb = args.in[15];
    F.scw = args.in[16]; F.poolw = args.in[17]; F.poolsc = args.in[18]; F.w_ff1 = args.in[19]; F.w_ff2 = args.in[20]; F.out = args.out;
    F.MOD = (float*)(ws + WS_MOD); F.BIAS1 = (float*)(ws + WS_BIAS1); F.BIAS2 = (float*)(ws + WS_BIAS2); F.SSQ1 = (float*)(ws + WS_SSQ1); F.SSQ2 = (float*)(ws + WS_SSQ2);
    F.HA = (bf16*)(ws + WS_HA); F.XB = (bf16*)(ws + WS_XB); F.PROJ = (bf16*)(ws + WS_PROJ); F.MIX = (bf16*)(ws + WS_MIX); F.HID = (bf16*)(ws + WS_HID);
    for (int u = F.tid; u < (LDS_BYTES - LDSCTL_OFF) / 4; u += NWAVES * 64) ((LAS unsigned*)(F.lds + LDSCTL_OFF))[u] = 0u;
    __syncthreads();
    XcdBarrier bar; bar.bar = (unsigned*)(F.ctl + CW_BAR); bar.x = 0; bar.st = nullptr;
    if (!MK_PER_PHASE) bar = xcd_barrier_post((unsigned*)(F.ctl + CW_BAR), F.MISC + 8);
    const int lo = args.ph_lo, hi = args.ph_hi;
#define IN(k) (lo <= (k) && (k) < hi)
#define SEAM(k) do { if (IN((k) + 1)) xcd_barrier(bar); } while (0)

#ifndef PROBE_DUP
#define PROBE_DUP 0
#endif
#ifndef PROBE_N
#define PROBE_N 2
#endif
#define REPS(k) (((PROBE_DUP >> (k)) & 1) ? PROBE_N : 1)
    if (IN(0)) { for (int rep = 0; rep < REPS(0); ++rep) { if (rep) xcd_barrier(bar);
#pragma unroll 1
        for (int L = 0; L < (PREP_UPFRONT ? DEPTH : 1); ++L) prep_layer(F, L, F.vcu, F.G, rep ? ((PROBE_DUP >> 8) & 15) : 3); } SEAM(0); }
    if (IN(1)) { for (int rep = 0; rep < REPS(1); ++rep) { if (rep) xcd_barrier(bar); p0b(F); } SEAM(1); }
#pragma unroll 1
    for (int l = 0; l < DEPTH; ++l) {
        const int p = 2 + 5 * l;
        { int tl = threadIdx.x; asm volatile("" : "+v"(tl)); F.tid = tl; F.lane = tl & 63; F.wave = __builtin_amdgcn_readfirstlane(tl >> 6); }
        int bxl = blockIdx.x; asm volatile("" : "+s"(bxl));
        const float* modl = F.MOD + (size_t)l * 8 * NMOD;
        if (IN(p)) {
            for (int rep = 0; rep < REPS(2); ++rep) { if (rep) { xcd_barrier(bar); int tl = threadIdx.x; asm volatile("" : "+v"(tl)); F.tid = tl; F.lane = tl & 63; F.wave = __builtin_amdgcn_readfirstlane(tl >> 6); asm volatile("" : "+s"(bxl)); }
            pg8::Gemm g{F.HA, wt_ptr(F, l, WT_IN), M, NIN, DM}; pg8::StaticOrder S; S.init(M, NIN, F.G, bxl);
            rstd_table(F, S, F.SSQ1);
            pg8::EpiProj E{F.PROJ, F.BIAS1 + (size_t)l * 8 * NIN, (const LAS float*)(F.lds + RT_OFF), F.qng + l * 32, F.kng + l * 32, QSCALE};
            pg8::gemm_phase<pg8::EpiProj, pg8::StaticOrder, true, true>(F.lds + RING_OFF, g, S, E, F.tid);
            if (!PREP_UPFRONT && l + 1 < DEPTH && !rep) {
                const int nun = (M / 256) * (NIN / 256), rounds = (nun + F.G - 1) / F.G, first_idle = nun - (rounds - 1) * F.G;
                if (first_idle >= F.G) prep_layer(F, l + 1, F.vcu, F.G); else if (bxl >= first_idle) prep_layer(F, l + 1, bxl - first_idle, F.G - first_idle); } }
            SEAM(p);
        }
        if (IN(p + 1)) {
            for (int rep = 0; rep < REPS(3); ++rep) { if (rep) xcd_barrier(bar); attn_phase(F, l); }
            for (int rep = 0; rep < REPS(4); ++rep) { if (rep) xcd_barrier(bar); for (int tt = F.vcu; tt < 256; tt += F.G) mixer_tile(F, l, tt); }
            if (!PREP_UPFRONT && l + 1 < DEPTH) bias_layer(F, l + 1);
            SEAM(p + 1);
        }
        if (IN(p + 2)) {
            for (int rep = 0; rep < REPS(5); ++rep) { if (rep) { xcd_barrier(bar); int tl = threadIdx.x; asm volatile("" : "+v"(tl)); F.tid = tl; F.lane = tl & 63; F.wave = __builtin_amdgcn_readfirstlane(tl >> 6); asm volatile("" : "+s"(bxl)); }
            pg8::Gemm g{F.MIX, wt_ptr(F, l, WT_OUT), M, DM, DM}; pg8::StaticOrder S; S.init(M, DM, F.G, bxl);
            pg8::EpiRes E{(l == 0 || rep) ? F.x : nullptr, F.XB, nullptr, rep ? F.PROJ : F.XB, modl + 2048, modl + 4096, F.n2g + l * DM, rep ? (bf16*)((unsigned char*)F.PROJ + 32 * MiB) : F.HA, rep ? (float*)((unsigned char*)F.PROJ + 64 * MiB) : F.SSQ2, 1};
            pg8::gemm_phase<pg8::EpiRes, pg8::StaticOrder, true, true>(F.lds + RING_OFF, g, S, E, F.tid); }
            SEAM(p + 2);
        }
        if (IN(p + 3)) {
            for (int rep = 0; rep < REPS(6); ++rep) { if (rep) { xcd_barrier(bar); int tl = threadIdx.x; asm volatile("" : "+v"(tl)); F.tid = tl; F.lane = tl & 63; F.wave = __builtin_amdgcn_readfirstlane(tl >> 6); asm volatile("" : "+s"(bxl)); }
            pg8::Gemm g{F.HA, wt_ptr(F, l, WT_FF1), M, FF, DM}; pg8::StaticOrder S; S.init(M, FF, F.G, bxl);
            rstd_table(F, S, F.SSQ2);
            pg8::EpiFF1 E{F.HID, F.BIAS2 + (size_t)l * 8 * FF, (const LAS float*)(F.lds + RT_OFF)};
            pg8::gemm_phase<pg8::EpiFF1, pg8::StaticOrder, true, true>(F.lds + RING_OFF, g, S, E, F.tid); }
            SEAM(p + 3);
        }
        if (IN(p + 4)) {
            for (int rep = 0; rep < REPS(7); ++rep) { if (rep) { xcd_barrier(bar); int tl = threadIdx.x; asm volatile("" : "+v"(tl)); F.tid = tl; F.lane = tl & 63; F.wave = __builtin_amdgcn_readfirstlane(tl >> 6); asm volatile("" : "+s"(bxl)); }
            pg8::Gemm g{F.HID, wt_ptr(F, l, WT_FF2), M, DM, FF}; pg8::StaticOrder S; S.init(M, DM, F.G, bxl);
            const int nl = l + 1 < DEPTH ? l + 1 : l;
            if (rep && l + 1 == DEPTH) break;
            pg8::EpiRes E{rep ? F.x : nullptr, F.XB, (l + 1 == DEPTH && !rep) ? F.out : nullptr, rep ? (bf16*)F.out : F.XB, modl + 5120, F.MOD + (size_t)nl * 8 * NMOD + 1024, F.n1g + nl * DM, rep ? (bf16*)((unsigned char*)F.out + 32 * MiB) : F.HA, rep ? (float*)(F.ws + WS_SSQ2) : F.SSQ1, (l + 1 < DEPTH || rep) ? 1 : 0};
            pg8::gemm_phase<pg8::EpiRes, pg8::StaticOrder, true, true>(F.lds + RING_OFF, g, S, E, F.tid); }
            if (l + 1 < DEPTH) SEAM(p + 4);
        }
    }
#undef IN
#undef SEAM
}

extern "C" void kernel_launch(void* const* d_in, const int* in_sizes, int n_in, void* d_out, int out_size, void* d_ws, size_t ws_size, hipStream_t stream) {
    static int grid = 0;
    if (grid == 0) {
        if (n_in != 21 || in_sizes[0] != M * DM || out_size != M * DM || ws_size < WS_END) { fprintf(stderr, "kernel_launch: unexpected problem shape (n_in %d, in0 %d, out %d, ws %zu, need %zu); nothing launched\n", n_in, n_in > 0 ? in_sizes[0] : -1, out_size, ws_size, (size_t)WS_END); grid = -1; return; }
        int dev = 0, cus = 0, per_cu = 0;
        if (hipGetDevice(&dev) != hipSuccess || hipDeviceGetAttribute(&cus, hipDeviceAttributeMultiprocessorCount, dev) != hipSuccess) { fprintf(stderr, "kernel_launch: device query failed\n"); grid = -1; return; }
        if (hipFuncSetAttribute((const void*)trunk_fwd, hipFuncAttributeMaxDynamicSharedMemorySize, LDS_BYTES) != hipSuccess) { fprintf(stderr, "kernel_launch: hipFuncSetAttribute failed\n"); grid = -1; return; }
        if (hipOccupancyMaxActiveBlocksPerMultiprocessor(&per_cu, (const void*)trunk_fwd, NWAVES * 64, LDS_BYTES) != hipSuccess || per_cu < 1) { fprintf(stderr, "kernel_launch: occupancy query reports %d workgroups per CU\n", per_cu); }
        (void)hipGetLastError();
        grid = cus;
    }
    if (grid < 0) return;
    if (hipMemsetAsync((char*)d_ws + WS_CTL, 0, CTL_ZERO_BYTES, stream) != hipSuccess) { fprintf(stderr, "kernel_launch: hipMemsetAsync failed\n"); return; }
    Args a{};
    for (int i = 0; i < 21; ++i) a.in[i] = (const float*)d_in[i];
    a.out = (float*)d_out; a.ws = (unsigned char*)d_ws;
#if MK_PER_PHASE
    for (int li = 0; li < N_PHASES; ++li) { a.ph_lo = li; a.ph_hi = li + 1; a.li = li;
        hipLaunchKernelGGL(trunk_fwd, dim3(grid), dim3(NWAVES * 64), LDS_BYTES, stream, a); }
#else
    a.ph_lo = 0; a.ph_hi = N_PHASES; a.li = 0;
    hipLaunchKernelGGL(trunk_fwd, dim3(grid), dim3(NWAVES * 64), LDS_BYTES, stream, a);
#endif
    const hipError_t le = hipPeekAtLastError();
    if (le != hipSuccess) fprintf(stderr, "kernel_launch: launch failed: %s\n", hipGetErrorName(le));
}
```

```cpp
#include <hip/hip_runtime.h>
#include <cstdio>
#include <cstdint>
#include <cmath>
namespace pg8 {
#define PG8_LAS __attribute__((address_space(3)))
typedef unsigned short bf16_t;
typedef short bf16x8 __attribute__((ext_vector_type(8)));
typedef float f32x4 __attribute__((ext_vector_type(4)));
typedef unsigned u32x4 __attribute__((ext_vector_type(4)));
constexpr int BM = 256, BK = 64, HALF = 128, HTB = HALF * BK * 2  , STAGE_BYTES = 8 * HTB, NXCD = 8, WGM = 8;

__host__ __device__ __forceinline__ int lds_byte(int r, int c) { const int st = (r >> 4) * 2 + (c >> 5), rr = r & 15, cc = c & 31, ob = rr * 64 + cc * 2; return st * 1024 + (ob ^ (((ob >> 9) & 1) << 5)); }
__host__ __device__ __forceinline__ void stage_rc(int b, int& R, int& C) { const int st = b / 1024, sb = b % 1024, swz = sb ^ (((sb >> 9) & 1) << 5); R = (st >> 1) * 16 + swz / 64; C = (st & 1) * 32 + (swz % 64) / 2; }
__host__ __device__ __forceinline__ int perm32(int rho) { const int n = rho >> 4, i = rho & 15; return 8 * (i >> 2) + 4 * n + (i & 3); }

struct Unit { int pm, pn; };
struct Gemm { const bf16_t* A; const bf16_t* Bt; int M, N, K; };

struct StaticOrder {
    int nM, nN, nwg, G, c;
    __host__ __device__ void init(int M, int N, int G_, int c_) { nM = M / BM; nN = N / BM; nwg = nM * nN; G = G_; c = c_; }
    __host__ __device__ bool next(int i, Unit& u) const {
        const long L = (long)i * G + c; if (L >= nwg) return false;
        int wgid = (int)L; { const int q = nwg / NXCD, r = nwg % NXCD, xcd = wgid % NXCD, off = wgid / NXCD; wgid = (xcd < r ? xcd * (q + 1) : r * (q + 1) + (xcd - r) * q) + off; }
        const int nig = WGM * nN, gid = wgid / nig, fm = gid * WGM, gsz = (nM - fm) < WGM ? (nM - fm) : WGM;
        u.pm = fm + ((wgid % nig) % gsz); u.pn = (wgid % nig) / gsz; return true;
    }
    __device__ __forceinline__ void a_ready(const Unit&) const {}
    __device__ __forceinline__ void done(const Unit&) const {}
};


__device__ __forceinline__ unsigned cvt_pk_bf16(float lo, float hi) { unsigned r; asm volatile("v_cvt_pk_bf16_f32 %0, %1, %2" : "=v"(r) : "v"(lo), "v"(hi)); return r; }
typedef unsigned u32x2 __attribute__((ext_vector_type(2)));
__device__ __forceinline__ float dot4(f32x4 a) { return (a[0] * a[0] + a[1] * a[1]) + (a[2] * a[2] + a[3] * a[3]); }

struct EpiProj {
    static constexpr bool PERM = true, AFTER_DRAIN = false;
    bf16_t* O; const float* bias; const PG8_LAS float* rtab; const float* qg; const float* kg; float qscale;
    __device__ __forceinline__ void operator()(const f32x4 (&acc)[2][2][4][2], const Unit& u, int ui, int wr, int wc, int fr, int fq) const {
        const int b = u.pm >> 3;
        const int row0 = u.pm * BM + wr * 64 + fr, col0 = u.pn * BM + wc * 32 + 8 * fq;
        const float* bp = bias + b * 2304 + col0;
        f32x4 bv[2][2];
#pragma unroll
        for (int bj = 0; bj < 2; ++bj)
#pragma unroll
            for (int n = 0; n < 2; ++n) bv[bj][n] = *(const f32x4*)(bp + bj * HALF + 4 * n);
        const bool isqk = u.pn < 2;
        f32x4 g0 = (f32x4){1.f, 1.f, 1.f, 1.f}, g1 = g0;
        if (isqk) { const float* gp = (u.pn == 0 ? qg : kg) + 8 * fq; g0 = *(const f32x4*)gp; g1 = *(const f32x4*)(gp + 4); if (u.pn == 0) { g0 = g0 * qscale; g1 = g1 * qscale; } }
        const PG8_LAS float* rt = rtab + ui * 256 + wr * 64 + fr;
#pragma unroll
        for (int ai = 0; ai < 2; ++ai)
#pragma unroll
            for (int m = 0; m < 4; ++m) { const float rs = rt[ai * HALF + m * 16]; bf16_t* rowp = O + (size_t)(row0 + ai * HALF + m * 16) * 2304 + col0;
#pragma unroll
                for (int bj = 0; bj < 2; ++bj) { f32x4 v0 = acc[ai][bj][m][0] * rs + bv[bj][0], v1 = acc[ai][bj][m][1] * rs + bv[bj][1];
                    if (isqk) { float ss = dot4(v0) + dot4(v1); ss += __shfl_xor(ss, 16); ss += __shfl_xor(ss, 32);
                        const float r = __builtin_amdgcn_rsqf(ss * (1.0f / 32.0f) + 1e-6f); v0 = v0 * r * g0; v1 = v1 * r * g1; }
                    u32x4 w; w.x = cvt_pk_bf16(v0[0], v0[1]); w.y = cvt_pk_bf16(v0[2], v0[3]); w.z = cvt_pk_bf16(v1[0], v1[1]); w.w = cvt_pk_bf16(v1[2], v1[3]);
                    *(u32x4*)(rowp + bj * HALF) = w; } }
    }
};
struct EpiFF1 {
    static constexpr bool PERM = true, AFTER_DRAIN = false;
    bf16_t* O; const float* bias; const PG8_LAS float* rtab;
    __device__ __forceinline__ void operator()(const f32x4 (&acc)[2][2][4][2], const Unit& u, int ui, int wr, int wc, int fr, int fq) const {
        const int b = u.pm >> 3;
        const int row0 = u.pm * BM + wr * 64 + fr, col0 = u.pn * BM + wc * 32 + 8 * fq;
        const float* bp = bias + b * 4096 + col0;
        f32x4 bv[2][2];
#pragma unroll
        for (int bj = 0; bj < 2; ++bj)
#pragma unroll
            for (int n = 0; n < 2; ++n) bv[bj][n] = *(const f32x4*)(bp + bj * HALF + 4 * n);
        const PG8_LAS float* rt = rtab + ui * 256 + wr * 64 + fr;
        const f32x4 z = (f32x4){0.f, 0.f, 0.f, 0.f};
#pragma unroll
        for (int ai = 0; ai < 2; ++ai)
#pragma unroll
            for (int m = 0; m < 4; ++m) {
#ifdef EXP_A
 const float rs = 1.0f;
#else
 const float rs = rt[ai * HALF + m * 16];
#endif
 bf16_t* rowp = O + (size_t)(row0 + ai * HALF + m * 16) * 4096 + col0;
#pragma unroll
                for (int bj = 0; bj < 2; ++bj) { f32x4 v0 = acc[ai][bj][m][0] * rs + bv[bj][0], v1 = acc[ai][bj][m][1] * rs + bv[bj][1];
                    v0 = __builtin_elementwise_max(v0, z); v1 = __builtin_elementwise_max(v1, z); v0 = v0 * v0; v1 = v1 * v1;
                    u32x4 w; w.x = cvt_pk_bf16(v0[0], v0[1]); w.y = cvt_pk_bf16(v0[2], v0[3]); w.z = cvt_pk_bf16(v1[0], v1[1]); w.w = cvt_pk_bf16(v1[2], v1[3]);
                    *(u32x4*)(rowp + bj * HALF) = w; } }
    }
};
struct EpiRes {
    static constexpr bool PERM = false, AFTER_DRAIN = false;
    const float* xin_f; const bf16_t* xin_h; float* xout_f; bf16_t* xout_h; const float* gate; const float* nsc; const float* ng; bf16_t* hA; float* ssq; int write_next;
    __device__ __forceinline__ void operator()(const f32x4 (&acc)[2][2][4][2], const Unit& u, int ui, int wr, int wc, int fr, int fq) const {
        const int b = u.pm >> 3;
        const int col0 = u.pn * BM + wc * 32 + 4 * fq;
        f32x4 gv[2][2], gm[2][2];
#pragma unroll
        for (int bj = 0; bj < 2; ++bj)
#pragma unroll
            for (int n = 0; n < 2; ++n) { const int c = col0 + bj * HALF + n * 16; gv[bj][n] = *(const f32x4*)(gate + b * 6144 + c);
                if (write_next) gm[bj][n] = *(const f32x4*)(ng + c) * (*(const f32x4*)(nsc + b * 6144 + c) + 1.0f); else gm[bj][n] = (f32x4){0.f, 0.f, 0.f, 0.f}; }
#pragma unroll
        for (int ai = 0; ai < 2; ++ai)
#pragma unroll
            for (int m = 0; m < 4; ++m) { const int row = u.pm * BM + ai * HALF + wr * 64 + m * 16 + fr; float ss = 0.f;
#pragma unroll
                for (int bj = 0; bj < 2; ++bj)
#pragma unroll
                    for (int n = 0; n < 2; ++n) { const size_t off = (size_t)row * 1024 + col0 + bj * HALF + n * 16;
                        f32x4 xi;
                        if (xin_f) xi = *(const f32x4*)(xin_f + off);
                        else { const u32x2 t = *(const u32x2*)(xin_h + off); xi = (f32x4){__builtin_bit_cast(float, t.x << 16), __builtin_bit_cast(float, t.x & 0xffff0000u), __builtin_bit_cast(float, t.y << 16), __builtin_bit_cast(float, t.y & 0xffff0000u)}; }
                        const f32x4 xo = xi + gv[bj][n] * acc[ai][bj][m][n]; ss += dot4(xo);
                        if (xout_f) *(f32x4*)(xout_f + off) = xo;
                        else { u32x2 w; w.x = cvt_pk_bf16(xo[0], xo[1]); w.y = cvt_pk_bf16(xo[2], xo[3]); *(u32x2*)(xout_h + off) = w; }
                        if (write_next) { const f32x4 h = xo * gm[bj][n]; u32x2 w; w.x = cvt_pk_bf16(h[0], h[1]); w.y = cvt_pk_bf16(h[2], h[3]); *(u32x2*)(hA + off) = w; } }
                ss += __shfl_xor(ss, 16); ss += __shfl_xor(ss, 32);
                if (write_next && fq == 0) ssq[(size_t)(u.pn * 4 + wc) * 16384 + row] = ss;
                if (m & 1) asm volatile("" ::: "memory"); }
    }
};

template <class Epi, class Sched, bool ALIGN_EPI = false, bool SP2 = false>
__device__ __forceinline__ void gemm_phase(PG8_LAS unsigned char* lds, const Gemm g, const Sched& S, const Epi& E, const int tid_in) {
    const int tid = tid_in, wid = __builtin_amdgcn_readfirstlane(tid >> 6), lane = tid & 63, wr = wid >> 2, wc = wid & 3, fr = lane & 15, fq = lane >> 4;
    const int K = g.K, nt = K / BK;
    unsigned voffA[2], voffB[2];
#pragma unroll
    for (int i = 0; i < 2; ++i) { int R, C; stage_rc(tid * 16 + i * 8192, R, C); const int Rb = Epi::PERM ? ((R & ~31) + perm32(R & 31)) : R;
        voffA[i] = (unsigned)(R * K + C) * 2u; voffB[i] = (unsigned)(Rb * K + C) * 2u; }
    const size_t kstep = (size_t)(BK * 2);
    const size_t hstep = (size_t)HALF * K * 2;
    const size_t tstep = 2 * hstep;
    const unsigned ldsw = (unsigned)wid * 1024u;
    const int aoff = lds_byte(wr * 64 + fr, fq * 8), boff = lds_byte(wc * 32 + fr, fq * 8);
#define PG8_SA(b, h) (((b) * 2 + (h)) * HTB)
#define PG8_SB(b, h) ((4 + (b) * 2 + (h)) * HTB)
#define PG8_STAGE(bufoff, gbase, voff) do { _Pragma("unroll") for (int _i = 0; _i < 2; ++_i) \
        __builtin_amdgcn_global_load_lds((const unsigned*)((const char*)(gbase) + (voff)[_i]), (PG8_LAS unsigned*)(lds + (bufoff) + ldsw + _i * 8192), 16, 0, 0); } while (0)
#define PG8_LDA(dst, b, h) do { _Pragma("unroll") for (int m = 0; m < 4; ++m) _Pragma("unroll") for (int k = 0; k < 2; ++k) dst[m][k] = *(const PG8_LAS bf16x8*)(lds + PG8_SA(b, h) + aoff + m * 2048 + k * 1024); } while (0)
#define PG8_LDB(dst, b, h) do { _Pragma("unroll") for (int n = 0; n < 2; ++n) _Pragma("unroll") for (int k = 0; k < 2; ++k) dst[n][k] = *(const PG8_LAS bf16x8*)(lds + PG8_SB(b, h) + boff + n * 2048 + k * 1024); } while (0)
#define PG8_MMA(ai, bj, At, Bt) do { __builtin_amdgcn_s_setprio(1); _Pragma("unroll") for (int m = 0; m < 4; ++m) _Pragma("unroll") for (int n = 0; n < 2; ++n) _Pragma("unroll") for (int k = 0; k < 2; ++k) \
        acc[ai][bj][m][n] = __builtin_amdgcn_mfma_f32_16x16x32_bf16(Bt[n][k], At[m][k], acc[ai][bj][m][n], 0, 0, 0); __builtin_amdgcn_s_setprio(0); } while (0)
#define PG8_WAIT_V(n) asm volatile("s_waitcnt vmcnt(" #n ")" ::: "memory")
#define PG8_WAIT_L(n) asm volatile("s_waitcnt lgkmcnt(" #n ")" ::: "memory")
#define PG8_BAR __builtin_amdgcn_s_barrier()
#define PG8_SCHED __builtin_amdgcn_sched_barrier(0)
    Unit cur, nxt; int ui = 0;
    if (!S.next(0, cur)) return;
    f32x4 acc[2][2][4][2];
#pragma unroll
    for (int a = 0; a < 2; ++a)
#pragma unroll
        for (int b = 0; b < 2; ++b)
#pragma unroll
            for (int m = 0; m < 4; ++m)
#pragma unroll
                for (int n = 0; n < 2; ++n) acc[a][b][m][n] = (f32x4){0.f, 0.f, 0.f, 0.f};
    bf16x8 At[4][2], B0[2][2], B1[2][2];
    const char* cA = (const char*)g.A + (size_t)cur.pm * tstep; const char* cB = (const char*)g.Bt + (size_t)cur.pn * tstep;
    S.a_ready(cur);
    if constexpr (SP2) {
        PG8_STAGE(PG8_SB(0, 0), cB, voffB); PG8_STAGE(PG8_SB(0, 1), cB + hstep, voffB); PG8_STAGE(PG8_SA(0, 0), cA, voffA); PG8_STAGE(PG8_SA(0, 1), cA + hstep, voffA);
        if (wr == 1) PG8_BAR;
        PG8_WAIT_V(2); PG8_BAR;
        PG8_STAGE(PG8_SB(1, 0), cB + kstep, voffB); PG8_STAGE(PG8_SA(1, 0), cA + kstep, voffA); PG8_STAGE(PG8_SB(1, 1), cB + hstep + kstep, voffB);
        PG8_WAIT_V(6); PG8_BAR;
    } else {
        PG8_STAGE(PG8_SB(0, 0), cB, voffB); PG8_STAGE(PG8_SA(0, 0), cA, voffA); PG8_STAGE(PG8_SB(0, 1), cB + hstep, voffB); PG8_STAGE(PG8_SA(0, 1), cA + hstep, voffA);
        if (wr == 1) PG8_BAR;
        PG8_WAIT_V(4); PG8_BAR;
        PG8_STAGE(PG8_SB(1, 0), cB + kstep, voffB); PG8_STAGE(PG8_SA(1, 0), cA + kstep, voffA); PG8_STAGE(PG8_SB(1, 1), cB + hstep + kstep, voffB);
        PG8_WAIT_V(6); PG8_BAR;
    }
    for (;;) {
        const bool has_next = S.next(ui + 1, nxt);
        const char* nA = has_next ? (const char*)g.A + (size_t)nxt.pm * tstep : cA; const char* nB = has_next ? (const char*)g.Bt + (size_t)nxt.pn * tstep : cB;
        for (int t = 0; t < nt; t += 2) {
            const bool last = (t == nt - 2);
            const char* a1 = cA + (size_t)(t + 1) * kstep;
            const char* a2 = last ? nA : cA + (size_t)(t + 2) * kstep; const char* b2 = last ? nB : cB + (size_t)(t + 2) * kstep;
            const char* a3 = a2 + kstep; const char* b3 = b2 + kstep;
            if (last && has_next) S.a_ready(nxt);
            if constexpr (SP2) {
            PG8_LDB(B0, 0, 0); PG8_LDB(B1, 0, 1); PG8_SCHED; PG8_LDA(At, 0, 0); PG8_STAGE(PG8_SA(1, 1), a1 + hstep, voffA);
            PG8_WAIT_V(8); PG8_WAIT_L(0); PG8_BAR; PG8_MMA(0, 0, At, B0); PG8_MMA(0, 1, At, B1); PG8_BAR; PG8_SCHED;
            PG8_LDA(At, 0, 1); PG8_STAGE(PG8_SB(0, 0), b2, voffB); PG8_STAGE(PG8_SB(0, 1), b2 + hstep, voffB); PG8_STAGE(PG8_SA(0, 0), a2, voffA);
            PG8_WAIT_V(8); PG8_WAIT_L(0); PG8_BAR; PG8_MMA(1, 0, At, B0); PG8_MMA(1, 1, At, B1); PG8_BAR; PG8_SCHED;
            PG8_LDB(B0, 1, 0); PG8_LDB(B1, 1, 1); PG8_SCHED; PG8_LDA(At, 1, 0); PG8_STAGE(PG8_SA(0, 1), a2 + hstep, voffA);
            PG8_WAIT_V(8); PG8_WAIT_L(0); PG8_BAR; PG8_MMA(0, 0, At, B0); PG8_MMA(0, 1, At, B1); PG8_BAR; PG8_SCHED;
            PG8_LDA(At, 1, 1); PG8_STAGE(PG8_SB(1, 0), b3, voffB); PG8_STAGE(PG8_SB(1, 1), b3 + hstep, voffB); PG8_STAGE(PG8_SA(1, 0), a3, voffA);
            PG8_WAIT_V(8); PG8_WAIT_L(0); PG8_BAR; PG8_MMA(1, 0, At, B0); PG8_MMA(1, 1, At, B1); PG8_BAR; PG8_SCHED;
            } else {
            PG8_LDB(B0, 0, 0); PG8_SCHED; PG8_LDA(At, 0, 0); PG8_STAGE(PG8_SA(1, 1), a1 + hstep, voffA);
            PG8_WAIT_L(8); PG8_BAR; PG8_WAIT_L(0); PG8_MMA(0, 0, At, B0); PG8_BAR; PG8_SCHED;
            PG8_LDB(B1, 0, 1); PG8_STAGE(PG8_SB(0, 0), b2, voffB);
            PG8_BAR; PG8_WAIT_L(0); PG8_MMA(0, 1, At, B1); PG8_BAR;
            PG8_LDA(At, 0, 1); PG8_STAGE(PG8_SA(0, 0), a2, voffA);
            PG8_BAR; PG8_WAIT_L(0); PG8_MMA(1, 0, At, B0); PG8_BAR; PG8_SCHED;
            PG8_STAGE(PG8_SB(0, 1), b2 + hstep, voffB);
            PG8_WAIT_V(6); PG8_BAR; PG8_MMA(1, 1, At, B1); PG8_BAR;
            PG8_LDB(B0, 1, 0); PG8_SCHED; PG8_LDA(At, 1, 0); PG8_STAGE(PG8_SA(0, 1), a2 + hstep, voffA);
            PG8_WAIT_L(8); PG8_BAR; PG8_WAIT_L(0); PG8_MMA(0, 0, At, B0); PG8_BAR; PG8_SCHED;
            PG8_LDB(B1, 1, 1); PG8_STAGE(PG8_SB(1, 0), b3, voffB);
            PG8_BAR; PG8_WAIT_L(0); PG8_MMA(0, 1, At, B1); PG8_BAR;
            PG8_LDA(At, 1, 1); PG8_STAGE(PG8_SA(1, 0), a3, voffA);
            PG8_BAR; PG8_WAIT_L(0); PG8_MMA(1, 0, At, B0); PG8_BAR; PG8_SCHED;
            PG8_STAGE(PG8_SB(1, 1), b3 + hstep, voffB);
            PG8_WAIT_V(6); PG8_BAR; PG8_MMA(1, 1, At, B1); PG8_BAR;
            }
        }
        if constexpr (ALIGN_EPI) { if (wr == 0) PG8_BAR; }
        if constexpr (!Epi::AFTER_DRAIN) { E(acc, cur, ui, wr, wc, fr, fq); S.done(cur); }
        if (!has_next) break;
#pragma unroll
        for (int a = 0; a < 2; ++a)
#pragma unroll
            for (int b = 0; b < 2; ++b)
#pragma unroll
                for (int m = 0; m < 4; ++m)
#pragma unroll
                    for (int n = 0; n < 2; ++n) acc[a][b][m][n] = (f32x4){0.f, 0.f, 0.f, 0.f};
        cur = nxt; cA = nA; cB = nB; ++ui;
        if constexpr (ALIGN_EPI) { if (wr == 1) PG8_BAR; }
    }
    PG8_WAIT_V(0);
    if constexpr (!ALIGN_EPI) { if (wr == 0) PG8_BAR; }
    PG8_BAR;
    if constexpr (Epi::AFTER_DRAIN) { E.fused(acc, cur, wr, wc, fr, fq, lds, wid, lane); S.done(cur); }
#undef PG8_SA
#undef PG8_SB
#undef PG8_STAGE
#undef PG8_LDA
#undef PG8_LDB
#undef PG8_MMA
#undef PG8_WAIT_V
#undef PG8_WAIT_L
#undef PG8_BAR
#undef PG8_SCHED
}
}

constexpr int NWAVES = 8;
constexpr int DM = 1024, BATCH = 8, SEQ = 2048, M = BATCH * SEQ, DEPTH = 4, NIN = 2304, FF = 4096, NMOD = 6144;
constexpr float EPS = 1e-6f;
constexpr float QSCALE = 0.17677669529663687f * 1.4426950408889634f;

#ifndef MK_PER_PHASE
#define MK_PER_PHASE 0
#endif
constexpr int N_PHASES = 2 + 5 * DEPTH;
#ifndef PREP_UPFRONT
#define PREP_UPFRONT 1
#endif

constexpr size_t MiB = 1u << 20;
constexpr size_t WS_CTL = 0, CTL_ZERO_BYTES = 1 * MiB;
constexpr size_t WS_MOD = 1 * MiB;
constexpr size_t WS_BIAS1 = 2 * MiB;
constexpr size_t WS_BIAS2 = 3 * MiB;
constexpr size_t WS_SSQ1 = 4 * MiB, WS_SSQ2 = 5 * MiB;
constexpr size_t WS_WT = 8 * MiB;
constexpr size_t WT_IN = 0, WT_OUT = (size_t)NIN * DM * 2, WT_FF1 = WT_OUT + (size_t)DM * DM * 2, WT_FF2 = WT_FF1 + (size_t)FF * DM * 2, WT_LAYER = WT_FF2 + (size_t)FF * DM * 2;
constexpr size_t WS_HA = WS_WT + DEPTH * WT_LAYER;
constexpr size_t WS_XB = WS_HA + (size_t)M * DM * 2;
constexpr size_t WS_PROJ = WS_XB + (size_t)M * DM * 2;
constexpr size_t WS_MIX = WS_PROJ + (size_t)M * NIN * 2;
constexpr size_t WS_HID = WS_PROJ;
constexpr size_t WS_END = WS_HID + (size_t)M * FF * 2;
static_assert(WT_LAYER == (size_t)(NIN + DM + FF + FF) * DM * 2 && WS_HA % 256 == 0 && WS_PROJ % 256 == 0 && WS_MIX % 256 == 0 && WS_HID % 256 == 0 && WS_MIX + (size_t)M * DM * 2 <= WS_END, "ws map");
constexpr int CW_BAR = 4096;

constexpr int RING_OFF = 0, RING_BYTES = 131072;
constexpr int LDSCTL_OFF = RING_BYTES, MISC_OFF = LDSCTL_OFF + 320;
constexpr int RT_OFF = LDSCTL_OFF + 512;
constexpr int LDS_BYTES = 147456;
static_assert(RT_OFF + 8 * 256 * 4 <= LDS_BYTES, "LDS map");

#define GAS __attribute__((address_space(1)))
#define LAS __attribute__((address_space(3)))
typedef unsigned short bf16;
typedef unsigned v4u __attribute__((ext_vector_type(4)));
typedef unsigned v2u __attribute__((ext_vector_type(2)));
typedef float f32x4 __attribute__((ext_vector_type(4)));
typedef float f32x2 __attribute__((ext_vector_type(2)));
typedef short bf16x8 __attribute__((ext_vector_type(8)));
typedef short s16x4 __attribute__((ext_vector_type(4)));
typedef GAS unsigned gu32;
#define RLX_AGENT __ATOMIC_RELAXED, __HIP_MEMORY_SCOPE_AGENT
#define LDS_WAIT() asm volatile("s_waitcnt lgkmcnt(0)" ::: "memory")
#define VM_WAIT() asm volatile("s_waitcnt vmcnt(0)" ::: "memory")
__device__ __forceinline__ unsigned f2bf(float f) { unsigned u = __builtin_bit_cast(unsigned, f); return (u + 0x7fffu + ((u >> 16) & 1u)) >> 16; }
__device__ __forceinline__ unsigned pk2(float lo, float hi) { return f2bf(lo) | (f2bf(hi) << 16); }
__device__ __forceinline__ float bflo(unsigned v) { return __builtin_bit_cast(float, v << 16); }
__device__ __forceinline__ float bfhi(unsigned v) { return __builtin_bit_cast(float, v & 0xffff0000u); }
__device__ __forceinline__ float wave_sum(float v) {
#pragma unroll
    for (int o = 1; o < 64; o <<= 1) v += __shfl_xor(v, o);
    return v;
}
__device__ __forceinline__ float wave_max(float v) {
#pragma unroll
    for (int o = 1; o < 64; o <<= 1) v = fmaxf(v, __shfl_xor(v, o));
    return v;
}
__device__ __forceinline__ float sigmoidf_(float v) { return 1.0f / (1.0f + __expf(-v)); }

#define XB_TMO      128
#define XB_XCNT(j)  (256  + 64 * (j))
#define XB_XSUB(j)  (1280 + 64 * (j))
#define XB_XGEN(j)  (2304 + 64 * (j))
#define XB_TOP      3328
#define XB_TOPGEN   3392
#define XCD_BAR_WORDS 3456
#define XB_SPIN_CAP (1u << 18)

__device__ __forceinline__ unsigned xb_ld(unsigned* p)              { return __hip_atomic_load(p, __ATOMIC_RELAXED, __HIP_MEMORY_SCOPE_AGENT); }
__device__ __forceinline__ unsigned xb_add(unsigned* p, unsigned v) { return __hip_atomic_fetch_add(p, v, __ATOMIC_RELAXED, __HIP_MEMORY_SCOPE_AGENT); }
__device__ __forceinline__ unsigned xb_xcc_id() { return (unsigned)__builtin_amdgcn_s_getreg((3 << 11) | 20) & 0xFu; }
#define XB_SPIN(cond, bar) do { unsigned _sp = 0; while (cond) { __builtin_amdgcn_s_sleep(1); \
    if ((++_sp & 255u) == 0u) { if (xb_ld(&(bar)[XB_TMO])) break; if (_sp > XB_SPIN_CAP) { atomicAdd(&(bar)[XB_TMO], 1u); break; } } } } while (0)

struct XcdBarrier { unsigned* bar; unsigned x; volatile LAS unsigned* st; };

__device__ __forceinline__ XcdBarrier xcd_barrier_post(unsigned* bar, volatile LAS unsigned* st) {
    XcdBarrier b; b.bar = bar; b.x = xb_xcc_id(); b.st = st;
    if (threadIdx.x == 0) (void)xb_add(&bar[XB_XCNT(b.x)], 1u);
    return b;
}
__device__ __forceinline__ void xcd_barrier_complete(unsigned* bar, unsigned x, unsigned& nloc, unsigned& nx) {
    const unsigned G = gridDim.x * gridDim.y * gridDim.z;
    unsigned sum, cnt, mine, sp = 0u;
    for (;;) {
        sum = 0u; cnt = 0u; mine = 0u;
#pragma unroll
        for (unsigned j = 0; j < 16; ++j) { const unsigned c = xb_ld(&bar[XB_XCNT(j)]); sum += c; cnt += (c > 0u) ? 1u : 0u; mine = (j == x) ? c : mine; }
        if (sum == G) break;
        __builtin_amdgcn_s_sleep(1);
        if ((++sp & 255u) == 0u) { if (xb_ld(&bar[XB_TMO])) break; if (sp > XB_SPIN_CAP) { atomicAdd(&bar[XB_TMO], 1u); break; } }
    }
    nloc = mine > 0u ? mine : 1u; nx = cnt > 0u ? cnt : 1u;
}
__device__ __forceinline__ void xcd_barrier(const XcdBarrier& b) {
    asm volatile("s_waitcnt vmcnt(0)" ::: "memory");
    __syncthreads();
    if (threadIdx.x == 0) {
        unsigned* bar = b.bar;
        __builtin_amdgcn_s_waitcnt(0);
        unsigned nloc = b.st[0], nx = b.st[1];
        if (nloc == 0u) { xcd_barrier_complete(bar, b.x, nloc, nx); b.st[0] = nloc; b.st[1] = nx; }
        const unsigned old = xb_add(&bar[XB_XSUB(b.x)], 1u);
        const unsigned gen = old / nloc;
        if (old + 1u == (gen + 1u) * nloc) {
            __builtin_amdgcn_fence(__ATOMIC_RELEASE, "agent");
            asm volatile("s_waitcnt vmcnt(0)" ::: "memory");
            const unsigned og = xb_add(&bar[XB_TOP], 1u);
            const unsigned tg = og / nx;
            if (og + 1u == (tg + 1u) * nx) xb_add(&bar[XB_TOPGEN], 1u);
            else XB_SPIN(xb_ld(&bar[XB_TOPGEN]) == tg, bar);
            __builtin_amdgcn_fence(__ATOMIC_ACQUIRE, "agent");
            xb_add(&bar[XB_XGEN(b.x)], 1u);
            asm volatile("s_waitcnt vmcnt(0)" ::: "memory");
        } else {
            XB_SPIN(xb_ld(&bar[XB_XGEN(b.x)]) == gen, bar);
            __builtin_amdgcn_fence(__ATOMIC_ACQUIRE, "agent");
            asm volatile("s_waitcnt vmcnt(0)" ::: "memory");
        }
    }
    __syncthreads();
}

struct Frame {
    LAS unsigned char* lds;
    volatile LAS unsigned* MISC;
    gu32* ctl;
    int tid, lane, wave;
    int vcu, G;
    const float *x, *c, *w_ada, *b_ada, *n1g, *n2g, *w_in, *w_out, *qng, *kng, *lamp, *subg, *cdw, *cdb, *clg, *clb, *scw, *poolw, *poolsc, *w_ff1, *w_ff2;
    float* out;
    unsigned char* ws;
    float *MOD, *BIAS1, *BIAS2, *SSQ1, *SSQ2;
    bf16 *HA, *XB, *PROJ, *MIX, *HID;
};
__device__ __forceinline__ bf16* wt_ptr(const Frame& F, int l, size_t off) { return (bf16*)(F.ws + WS_WT + (size_t)l * WT_LAYER + off); }

__device__ __forceinline__ void mod_item(Frame& F, int l, int strip) {
    const int j0 = strip * 32, tid = F.tid;
    LAS float* cact = (LAS float*)(F.lds);
    LAS float* red = (LAS float*)(F.lds + 32768);
    for (int i = tid; i < 8192; i += NWAVES * 64) { const int b = i >> 10, k = i & 1023; const float v = F.c[b * 1024 + k]; cact[k * 8 + b] = v * sigmoidf_(v); }
    __syncthreads();
    {
        const int col4 = tid & 7, kp = tid >> 3;
        const float* wp = F.w_ada + ((size_t)l * 1024 + kp * 16) * NMOD + j0 + col4 * 4;
        f32x4 w[16];
#pragma unroll
        for (int k = 0; k < 16; ++k) w[k] = *(const f32x4*)(wp + (size_t)k * NMOD);
        f32x4 acc[8];
#pragma unroll
        for (int b = 0; b < 8; ++b) acc[b] = (f32x4){0.f, 0.f, 0.f, 0.f};
#pragma unroll
        for (int k = 0; k < 16; ++k) {
            const LAS f32x4* ca = (const LAS f32x4*)(cact + (kp * 16 + k) * 8);
            const f32x4 c0 = ca[0], c1 = ca[1];
            acc[0] += w[k] * c0[0]; acc[1] += w[k] * c0[1]; acc[2] += w[k] * c0[2]; acc[3] += w[k] * c0[3];
            acc[4] += w[k] * c1[0]; acc[5] += w[k] * c1[1]; acc[6] += w[k] * c1[2]; acc[7] += w[k] * c1[3];
        }
#pragma unroll
        for (int b = 0; b < 8; ++b) *(LAS f32x4*)(red + (kp * 8 + b) * 32 + col4 * 4) = acc[b];
    }
    __syncthreads();
    if (tid < 256) { const int b = tid >> 5, cc = tid & 31; float s = F.b_ada[l * NMOD + j0 + cc];
#pragma unroll 16
        for (int kp = 0; kp < 64; ++kp) s += red[(kp * 8 + b) * 32 + cc];
        F.MOD[((size_t)l * 8 + b) * NMOD + j0 + cc] = s; }
    __syncthreads();
}
constexpr int TS = 260;
__device__ __forceinline__ void transpose_item(Frame& F, const float* W, int K, int N, bf16* WT, int kb, int nb, const float* Wp, const float* psc, int mode = 0) {
    const int k0 = 64 * kb, n0 = 256 * nb, lane = F.lane, wv = F.wave;
    LAS float* tile = (LAS float*)(F.lds);
    {
        f32x4 v[8];
#pragma unroll
        for (int i = 0; i < 8; ++i) v[i] = *(const f32x4*)(W + (size_t)(k0 + 8 * wv + i) * N + n0 + 4 * lane);
#pragma unroll
        for (int i = 0; i < 8; ++i) { if (psc) v[i] = v[i] * psc[8 * wv + i]; if (mode < 3) *(LAS f32x4*)(tile + (8 * wv + i) * TS + 4 * lane) = v[i]; else asm volatile("" :: "v"(v[i])); }
    }
    LDS_WAIT(); __syncthreads();
    if (mode >= 2) return;
    if (Wp) {
        typedef float f32x4_t __attribute__((ext_vector_type(4)));
        const int li = lane & 15, lk = lane >> 4;
        f32x4_t acc[4][2];
#pragma unroll
        for (int ct = 0; ct < 4; ++ct) { acc[ct][0] = (f32x4_t){0.f, 0.f, 0.f, 0.f}; acc[ct][1] = acc[ct][0]; }
#pragma unroll 4
        for (int d0 = 0; d0 < 64; d0 += 4) {
            const float b0 = tile[(d0 + lk) * TS + 32 * wv + li], b1 = tile[(d0 + lk) * TS + 32 * wv + 16 + li];
#pragma unroll
            for (int ct = 0; ct < 4; ++ct) { const float a = Wp[(16 * ct + li) * 64 + d0 + lk];
                acc[ct][0] = __builtin_amdgcn_mfma_f32_16x16x4f32(a, b0, acc[ct][0], 0, 0, 0); acc[ct][1] = __builtin_amdgcn_mfma_f32_16x16x4f32(a, b1, acc[ct][1], 0, 0, 0); }
        }
        LDS_WAIT(); __syncthreads();
#pragma unroll
        for (int ct = 0; ct < 4; ++ct)
#pragma unroll
            for (int r = 0; r < 4; ++r) { tile[(16 * ct + 4 * lk + r) * TS + 32 * wv + li] = acc[ct][0][r]; tile[(16 * ct + 4 * lk + r) * TS + 32 * wv + 16 + li] = acc[ct][1][r]; }
        LDS_WAIT(); __syncthreads();
    }
    {
        const int n = 32 * wv + (lane & 31), ch = lane >> 5;
#pragma unroll
        for (int j = 0; j < 4; ++j) { const int c = 4 * ch + j; const LAS float* s = tile + (8 * c) * TS + n;
            v4u o; o.x = pk2(s[0 * TS], s[1 * TS]); o.y = pk2(s[2 * TS], s[3 * TS]); o.z = pk2(s[4 * TS], s[5 * TS]); o.w = pk2(s[6 * TS], s[7 * TS]);
            if (mode == 0) *(GAS v4u*)(WT + (size_t)(n0 + n) * K + k0 + 8 * c) = o; else asm volatile("" :: "v"(o)); }
    }
    LDS_WAIT(); __syncthreads();
}
__device__ __forceinline__ void prep_layer(Frame& F, int L, int rank, int nranks, int what = 3) {
    constexpr int I_MOD = NMOD / 32, I_IN = (DM / 64) * (NIN / 256), I_OUT = (DM / 64) * (DM / 256), I_1 = (DM / 64) * (FF / 256), I_2 = (FF / 64) * (DM / 256), I_ALL = I_MOD + I_IN + I_OUT + I_1 + I_2;
    const int l = L;
#pragma unroll 1
    for (int it = rank; it < I_ALL; it += nranks) {
        int r = it;
        if (r < I_MOD) { if (what & 1) mod_item(F, l, r); continue; } r -= I_MOD;
        if (!(what & 2)) continue;
        if (r < I_IN) { transpose_item(F, F.w_in + (size_t)l * DM * NIN, DM, NIN, wt_ptr(F, l, WT_IN), r / (NIN / 256), r % (NIN / 256), nullptr, nullptr, what >> 2); continue; } r -= I_IN;
        if (r < I_OUT) { const int kb = r / 4, nb = r % 4;
            if (kb < 12) transpose_item(F, F.w_out + (size_t)l * DM * DM, DM, DM, wt_ptr(F, l, WT_OUT), kb, nb, nullptr, nullptr, what >> 2);
            else transpose_item(F, F.w_out + (size_t)l * DM * DM, DM, DM, wt_ptr(F, l, WT_OUT), kb, nb, F.poolw + ((size_t)l * 4 + (kb - 12)) * 4096, F.poolsc + l * 256 + 64 * (kb - 12), what >> 2);
            continue; } r -= I_OUT;
        if (r < I_1) { transpose_item(F, F.w_ff1 + (size_t)l * DM * FF, DM, FF, wt_ptr(F, l, WT_FF1), r / (FF / 256), r % (FF / 256), nullptr, nullptr, what >> 2); continue; } r -= I_1;
        transpose_item(F, F.w_ff2 + (size_t)l * FF * DM, FF, DM, wt_ptr(F, l, WT_FF2), r / 4, r % 4, nullptr, nullptr, what >> 2);
    }
}
__device__ __forceinline__ void bias_layer(Frame& F, int l) {
    const int gw = F.vcu * NWAVES + F.wave, NGW = F.G * NWAVES, lane = F.lane;
#pragma unroll 1
    for (int kind = 0; kind < 2; ++kind) {
        const int N = kind ? FF : NIN;
        const bf16* Wt = wt_ptr(F, l, kind ? WT_FF1 : WT_IN);
        const float* sh = F.MOD + (size_t)l * 8 * NMOD + (kind ? 3072 : 0);
        float* outp = kind ? F.BIAS2 + (size_t)l * 8 * FF : F.BIAS1 + (size_t)l * 8 * NIN;
        f32x4 shr[8][4];
#pragma unroll
        for (int b = 0; b < 8; ++b)
#pragma unroll
            for (int j = 0; j < 4; ++j) shr[b][j] = *(const f32x4*)(sh + (size_t)b * NMOD + 16 * lane + 4 * j);
        for (int n0 = gw; n0 < N; n0 += 4 * NGW) {
            v4u w0[4], w1[4];
#pragma unroll
            for (int q = 0; q < 4; ++q) { const int n = (n0 + q * NGW < N) ? n0 + q * NGW : n0; w0[q] = *(const v4u*)(Wt + (size_t)n * DM + 16 * lane); w1[q] = *(const v4u*)(Wt + (size_t)n * DM + 16 * lane + 8); }
#pragma unroll
            for (int q = 0; q < 4; ++q) { const int n = n0 + q * NGW;
                const f32x4 wv0 = (f32x4){bflo(w0[q].x), bfhi(w0[q].x), bflo(w0[q].y), bfhi(w0[q].y)}, wv1 = (f32x4){bflo(w0[q].z), bfhi(w0[q].z), bflo(w0[q].w), bfhi(w0[q].w)};
                const f32x4 wv2 = (f32x4){bflo(w1[q].x), bfhi(w1[q].x), bflo(w1[q].y), bfhi(w1[q].y)}, wv3 = (f32x4){bflo(w1[q].z), bfhi(w1[q].z), bflo(w1[q].w), bfhi(w1[q].w)};
                float a[8];
#pragma unroll
                for (int b = 0; b < 8; ++b) { const f32x4 t = shr[b][0] * wv0 + shr[b][1] * wv1 + shr[b][2] * wv2 + shr[b][3] * wv3; a[b] = wave_sum((t[0] + t[1]) + (t[2] + t[3])); }
                if (lane == 0 && n < N) {
#pragma unroll
                    for (int b = 0; b < 8; ++b) outp[(size_t)b * N + n] = a[b]; } }
        }
    }
}
__device__ __forceinline__ void p0b(Frame& F) {
#pragma unroll 1
    for (int L = 0; L < (PREP_UPFRONT ? DEPTH : 1); ++L) bias_layer(F, L);
    const int gw = F.vcu * NWAVES + F.wave, NGW = F.G * NWAVES, lane = F.lane;
    for (int m0 = gw; m0 < M; m0 += 4 * NGW) {
        f32x4 v[4][4];
#pragma unroll
        for (int q = 0; q < 4; ++q) { const int mr = (m0 + q * NGW < M) ? m0 + q * NGW : m0; const GAS f32x4* xr = (const GAS f32x4*)(F.x + (size_t)mr * DM) + lane;
#pragma unroll
            for (int j = 0; j < 4; ++j) v[q][j] = xr[64 * j]; }
#pragma unroll
        for (int q = 0; q < 4; ++q) { const int m = m0 + q * NGW, b = m >> 11; if (m >= M) break;
            const f32x4* gr = (const f32x4*)(F.n1g) + lane; const f32x4* sr = (const f32x4*)(F.MOD + (size_t)b * NMOD + 1024) + lane;
            float ss = 0.f; GAS v2u* o8 = (GAS v2u*)(F.HA + (size_t)m * DM) + lane;
#pragma unroll
            for (int j = 0; j < 4; ++j) { const f32x4 vv = v[q][j]; ss += (vv[0] * vv[0] + vv[1] * vv[1]) + (vv[2] * vv[2] + vv[3] * vv[3]);
                const f32x4 h = vv * gr[64 * j] * (sr[64 * j] + 1.0f); v2u w; w.x = pk2(h[0], h[1]); w.y = pk2(h[2], h[3]); o8[64 * j] = w; }
            ss = wave_sum(ss);
            if (lane < 16) F.SSQ1[(size_t)lane * M + m] = lane == 0 ? ss : 0.f; }
    }
}
__device__ __forceinline__ void rstd_table(Frame& F, const pg8::StaticOrder& S, const float* ssq) {
    LAS float* tab = (LAS float*)(F.lds + RT_OFF);
    pg8::Unit u;
    for (int ui = 0; ui < 8 && S.next(ui, u); ++ui) {
        if (F.tid < 256) { const int row = u.pm * 256 + F.tid; float s = 0.f;
#pragma unroll
            for (int p = 0; p < 16; ++p) s += ssq[(size_t)p * M + row];
            tab[ui * 256 + F.tid] = __builtin_amdgcn_rsqf(s * (1.0f / DM) + EPS); }
    }
    LDS_WAIT(); __syncthreads();
}

__device__ __forceinline__ s16x4 vtr(const LAS unsigned char* p) { typedef short v4i16_t __attribute__((ext_vector_type(4))); return __builtin_bit_cast(s16x4, __builtin_amdgcn_ds_read_tr16_b64_v4i16((LAS v4i16_t*)p)); }
__device__ __forceinline__ void glds16(const void* gsrc, LAS unsigned char* dst) { __builtin_amdgcn_global_load_lds((const unsigned*)gsrc, (LAS unsigned*)dst, 16, 0, 0); }
__device__ __forceinline__ void attn_qk(f32x4 (&s)[2][4], const LAS unsigned char* kb_, bf16x8 q0, bf16x8 q1, f32x4 negM) {
#pragma unroll
    for (int kb = 0; kb < 4; ++kb) { const bf16x8 k0 = *(const LAS bf16x8*)(kb_ + kb * 256), k1 = *(const LAS bf16x8*)(kb_ + 4096 + kb * 256);
        s[0][kb] = __builtin_amdgcn_mfma_f32_16x16x32_bf16(k0, q0, negM, 0, 0, 0); s[1][kb] = __builtin_amdgcn_mfma_f32_16x16x32_bf16(k1, q1, negM, 0, 0, 0); }
}
__device__ __forceinline__ void attn_exp(f32x4 (&s)[2][4], bf16x8 (&pw)[2][2], bool band, int key0, int qrow) {
    if (band) {
#pragma unroll
        for (int kb = 0; kb < 4; ++kb)
#pragma unroll
            for (int r = 0; r < 4; ++r) { const int key = key0 + 16 * kb + r; if (key > qrow) { s[0][kb][r] = -INFINITY; s[1][kb][r] = -INFINITY; } }
    }
#pragma unroll
    for (int kb = 0; kb < 4; ++kb)
#pragma unroll
        for (int r = 0; r < 4; ++r) { s[0][kb][r] = __builtin_amdgcn_exp2f(s[0][kb][r]); s[1][kb][r] = __builtin_amdgcn_exp2f(s[1][kb][r]); }
#pragma unroll
    for (int m = 0; m < 2; ++m)
#pragma unroll
        for (int ks = 0; ks < 2; ++ks) { v4u w; w.x = pg8::cvt_pk_bf16(s[m][2 * ks][0], s[m][2 * ks][1]); w.y = pg8::cvt_pk_bf16(s[m][2 * ks][2], s[m][2 * ks][3]);
            w.z = pg8::cvt_pk_bf16(s[m][2 * ks + 1][0], s[m][2 * ks + 1][1]); w.w = pg8::cvt_pk_bf16(s[m][2 * ks + 1][2], s[m][2 * ks + 1][3]); pw[m][ks] = __builtin_bit_cast(bf16x8, w); }
}
__device__ __forceinline__ void attn_pv(const bf16x8 (&pw)[2][2], f32x4 (&o)[2][4], f32x4 (&ol)[2], const LAS unsigned char* vb_, int vE, int vO) {
    const bf16x8 ones = (bf16x8){0x3F80, 0x3F80, 0x3F80, 0x3F80, 0x3F80, 0x3F80, 0x3F80, 0x3F80};
    const unsigned va0 = (unsigned)(size_t)(vb_ + vE), va1 = (unsigned)(size_t)(vb_ + vO);
#pragma unroll
    for (int ks = 0; ks < 2; ++ks) {
        s16x4 lo[4], hi[4];
#define ATT_TR(dst, addr, off) asm volatile("ds_read_b64_tr_b16 %0, %1 offset:%c2" : "=&v"(dst) : "v"(addr), "i"(off) : "memory")
        if (ks == 0) { ATT_TR(lo[0], va0, 0); ATT_TR(hi[0], va0, 1024); ATT_TR(lo[1], va1, 0); ATT_TR(hi[1], va1, 1024);
                       ATT_TR(lo[2], va0, 4096); ATT_TR(hi[2], va0, 4096 + 1024); ATT_TR(lo[3], va1, 4096); ATT_TR(hi[3], va1, 4096 + 1024); }
        else         { ATT_TR(lo[0], va0, 2048); ATT_TR(hi[0], va0, 2048 + 1024); ATT_TR(lo[1], va1, 2048); ATT_TR(hi[1], va1, 2048 + 1024);
                       ATT_TR(lo[2], va0, 4096 + 2048); ATT_TR(hi[2], va0, 4096 + 2048 + 1024); ATT_TR(lo[3], va1, 4096 + 2048); ATT_TR(hi[3], va1, 4096 + 2048 + 1024); }
#undef ATT_TR
        asm volatile("s_waitcnt lgkmcnt(0)" : "+v"(lo[0]), "+v"(hi[0]), "+v"(lo[1]), "+v"(hi[1]), "+v"(lo[2]), "+v"(hi[2]), "+v"(lo[3]), "+v"(hi[3]) :: "memory");
        __builtin_amdgcn_sched_barrier(0);
#pragma unroll
        for (int d0 = 0; d0 < 4; ++d0) {
            const bf16x8 vf = (bf16x8){lo[d0][0], lo[d0][1], lo[d0][2], lo[d0][3], hi[d0][0], hi[d0][1], hi[d0][2], hi[d0][3]};
            o[0][d0] = __builtin_amdgcn_mfma_f32_16x16x32_bf16(pw[0][ks], vf, o[0][d0], 0, 0, 0);
            o[1][d0] = __builtin_amdgcn_mfma_f32_16x16x32_bf16(pw[1][ks], vf, o[1][d0], 0, 0, 0); }
        ol[0] = __builtin_amdgcn_mfma_f32_16x16x32_bf16(pw[0][ks], ones, ol[0], 0, 0, 0);
        ol[1] = __builtin_amdgcn_mfma_f32_16x16x32_bf16(pw[1][ks], ones, ol[1], 0, 0, 0); }
}
__device__ __forceinline__ void attn_epilogue(Frame& F, const f32x4 (&o)[2][4], const f32x4 (&ol)[2], const float (&sgv)[4], float lam, bf16* op) {
    const int lane = F.lane;
#pragma unroll
    for (int r = 0; r < 4; ++r) {
        const float a0 = 1.0f / ol[0][r], a1 = lam / ol[1][r];
        float ov[4], ss = 0.f;
#pragma unroll
        for (int d0 = 0; d0 < 4; ++d0) { ov[d0] = o[0][d0][r] * a0 - o[1][d0][r] * a1; ss += ov[d0] * ov[d0]; }
        ss += __shfl_xor(ss, 1); ss += __shfl_xor(ss, 2); ss += __shfl_xor(ss, 4); ss += __shfl_xor(ss, 8);
        const float rn = __builtin_amdgcn_rsqf(ss * (1.0f / 64.0f) + EPS);
#pragma unroll
        for (int d0 = 0; d0 < 4; ++d0) op[(size_t)r * DM + 16 * d0] = (bf16)f2bf(ov[d0] * rn * sgv[d0]);
    }
    (void)lane;
}
__device__ __forceinline__ void attn_pair(Frame& F, int l, int b, int h, int sidx, float lam, float negMv, float outscale, int mode = 0) {
    const int lane = F.lane, wid = F.wave, fr = lane & 15, fq = lane >> 4;
    LAS unsigned char* lds = F.lds;
    const size_t rowbase = (size_t)b * SEQ;
    const bf16* proj = F.PROJ;
    const int qbA = 15 - sidx, qbB = sidx, NTa = 2 * (qbA + 1), NTb = 2 * (qbB + 1), S = NTa + NTb;
    const bf16* qpA = proj + (rowbase + qbA * 128 + 16 * wid + fr) * NIN + h * 64 + 8 * fq;
    const bf16* qpB = proj + (rowbase + qbB * 128 + 16 * wid + fr) * NIN + h * 64 + 8 * fq;
    const bf16x8 qa0 = *(const bf16x8*)qpA, qa1 = *(const bf16x8*)(qpA + 32), qb0 = *(const bf16x8*)qpB, qb1 = *(const bf16x8*)(qpB + 32);
    const bf16* ksrc = proj + (rowbase + lane) * NIN + 256 + h * 64 + wid * 8;
    const bf16* vsrc = proj + (rowbase + 16 * (wid & 3) + (lane >> 2)) * NIN + 512 + h * 64 + (wid >> 2) * 32 + 8 * ((lane & 3) ^ (2 * ((lane >> 4) & 1)));
    LAS unsigned char* kdst = lds + wid * 1024;
    LAS unsigned char* vdst = lds + 65536 + wid * 1024;
    f32x4 o[2][4], ol[2];
#pragma unroll
    for (int m = 0; m < 2; ++m) { ol[m] = (f32x4){0.f, 0.f, 0.f, 0.f};
#pragma unroll
        for (int d = 0; d < 4; ++d) o[m][d] = (f32x4){0.f, 0.f, 0.f, 0.f}; }
    const f32x4 negM = (f32x4){negMv, negMv, negMv, negMv};
    const int koff = fq * 1024 + fr * 16;
    const int prow = fr >> 2, pp = fr & 3;
    const int vrow = (4 * fq + prow) * 64 + (pp & 1) * 8 + (pp >> 1) * 16;
    const int vE = vrow + 32 * (fq & 1), vO = vrow + 32 * (1 - (fq & 1));
    float sgv[4];
#pragma unroll
    for (int d0 = 0; d0 < 4; ++d0) sgv[d0] = F.subg[l * 64 + 16 * d0 + fr] * outscale;
#define ATT_TILE(s) ((s) < NTa ? (s) : (s) - NTa)
#define ATT_SRC(s) ((size_t)ATT_TILE((s) < S ? (s) : S - 1) * 64 * NIN)
#define ATT_BAR(N) do { asm volatile("s_waitcnt vmcnt(" #N ") lgkmcnt(0)" ::: "memory"); __builtin_amdgcn_s_barrier(); asm volatile("" ::: "memory"); } while (0)
#define ATT_BARL() do { asm volatile("s_waitcnt lgkmcnt(0)" ::: "memory"); __builtin_amdgcn_s_barrier(); asm volatile("" ::: "memory"); } while (0)
    glds16(ksrc + ATT_SRC(0), kdst);
    glds16(ksrc + ATT_SRC(1), kdst + 8192); glds16(vsrc + ATT_SRC(0), vdst);
    glds16(ksrc + ATT_SRC(2), kdst + 2 * 8192); glds16(vsrc + ATT_SRC(1), vdst + 8192);
    glds16(ksrc + ATT_SRC(3), kdst + 3 * 8192); glds16(vsrc + ATT_SRC(2), vdst + 2 * 8192);
    ATT_BAR(6);
    f32x4 sA[2][4], sB[2][4]; bf16x8 pw[2][2];
#pragma unroll
    for (int m = 0; m < 2; ++m) { pw[m][0] = (bf16x8){0, 0, 0, 0, 0, 0, 0, 0}; pw[m][1] = pw[m][0]; sB[m][0] = negM; sB[m][1] = negM; sB[m][2] = negM; sB[m][3] = negM; }
    attn_qk(sA, lds + koff, qa0, qa1, negM);
    const bool late = wid >= 4;
#define ATT_A(s, CUR, NXT) do { \
        if (!(mode & 1)) { glds16(ksrc + ATT_SRC((s) + 4), kdst + (((s) + 4) & 7) * 8192); glds16(vsrc + ATT_SRC((s) + 3), vdst + (((s) + 3) & 7) * 8192); } \
        if ((s) + 1 < S && !(mode & 8)) { const bool nb_ = ((s) + 1 >= NTa); attn_qk(NXT, lds + (((s) + 1) & 7) * 8192 + koff, nb_ ? qb0 : qa0, nb_ ? qb1 : qa1, negM); } \
        { const bool inB_ = (s) >= NTa; const int tile_ = ATT_TILE(s), NTu_ = inB_ ? NTb : NTa, q0_ = (inB_ ? qbB : qbA) * 128; \
          if (!(mode & 2)) attn_exp(CUR, pw, tile_ >= NTu_ - 2, 64 * tile_ + 4 * fq, q0_ + 16 * wid + fr); } \
    } while (0)
#define ATT_B(s) do { \
        const bool inB_ = (s) >= NTa; const int tile_ = ATT_TILE(s), NTu_ = inB_ ? NTb : NTa, q0_ = (inB_ ? qbB : qbA) * 128; \
        if (!(mode & 4)) attn_pv(pw, o, ol, lds + 65536 + ((s) & 7) * 8192, vE, vO); \
        if (tile_ == NTu_ - 1) { attn_epilogue(F, o, ol, sgv, lam, F.MIX + (rowbase + q0_ + 16 * wid + 4 * fq) * DM + h * 64 + fr); \
            asm volatile("s_waitcnt vmcnt(0)" ::: "memory");      \
            _Pragma("unroll") for (int m_ = 0; m_ < 2; ++m_) { ol[m_] = (f32x4){0.f, 0.f, 0.f, 0.f}; _Pragma("unroll") for (int d_ = 0; d_ < 4; ++d_) o[m_][d_] = (f32x4){0.f, 0.f, 0.f, 0.f}; } } \
    } while (0)
#define ATT_STEP(s, CUR, NXT) do { ATT_BAR(4); ATT_A(s, CUR, NXT); ATT_BAR(4); ATT_B(s); } while (0)
    if (late) ATT_BAR(4);
#pragma unroll 1
    for (int s = 0; s < S; s += 2) { ATT_STEP(s, sA, sB); ATT_STEP(s + 1, sB, sA); }
    if (!late) ATT_BAR(4);
#undef ATT_STEP
#undef ATT_A
#undef ATT_B
#undef ATT_TILE
#undef ATT_SRC
    ATT_BAR(0);
#undef ATT_BAR
#undef ATT_BARL
}
__device__ __forceinline__ void attn_phase(Frame& F, int l, int mode = 0) {
    const int lane = F.lane; const float* lp = F.lamp + l * 128;
    float pa = lane < 32 ? lp[lane] * lp[32 + lane] : 0.f, pb = lane < 32 ? lp[64 + lane] * lp[96 + lane] : 0.f;
    pa = wave_sum(pa); pb = wave_sum(pb);
    const float lam_init = 0.8f - 0.6f * __expf(-0.3f * (float)l);
    const float lam = __expf(pa) - __expf(pb) + lam_init;
    const float gq = wave_max(fabsf(F.qng[l * 32 + (lane & 31)])), gk = wave_max(fabsf(F.kng[l * 32 + (lane & 31)]));
    const float negMv = -(QSCALE * 32.0f * gq * gk);
    for (int pi = F.vcu; pi < 256; pi += F.G) {
        const int bh = pi >> 3, s = pi & 7;
        attn_pair(F, l, bh >> 2, bh & 3, s, lam, negMv, 1.0f - lam_init, mode);
    }
}
__device__ __forceinline__ unsigned bld(__amdgpu_buffer_rsrc_t r, int voff, int soff) { return __builtin_amdgcn_raw_buffer_load_b32(r, voff, soff, 0); }
__device__ __forceinline__ f32x2 bld2(__amdgpu_buffer_rsrc_t r, int voff, int soff) { typedef unsigned u2 __attribute__((ext_vector_type(2))); const u2 v = __builtin_amdgcn_raw_buffer_load_b64(r, voff, soff, 0); return __builtin_bit_cast(f32x2, v); }
__device__ __forceinline__ void mixer_tile(Frame& F, int l, int tt) {
    const int tid = F.tid, lane = F.lane; const int b = tt >> 5, s0 = (tt & 31) * 64; const int rowbase = b * SEQ;
    LAS float* cbuf = (LAS float*)F.lds;
    const int c2 = (tid & 127) * 2, tq = F.wave >> 1, sb = s0 + 16 * tq;
    const __amdgpu_buffer_rsrc_t rp = __builtin_amdgcn_make_buffer_rsrc((void*)F.PROJ, 0, (int)((size_t)M * NIN * 2), 0x00020000);
    const __amdgpu_buffer_rsrc_t rm = __builtin_amdgcn_make_buffer_rsrc((void*)F.MIX, 0, (int)((size_t)M * DM * 2), 0x00020000);
    const int vo = c2 * 2;
    {
        unsigned cgr[18], xcr[18], bgr[16], udr[31];
#pragma unroll
        for (int j = 0; j < 18; ++j) { const int s = sb - 2 + j, sc = s < 0 ? 0 : s; const int so = (rowbase + sc) * (NIN * 2) + 1536 * 2; cgr[j] = bld(rp, vo, so); xcr[j] = bld(rp, vo, so + 512); }
#pragma unroll
        for (int j = 0; j < 16; ++j) bgr[j] = bld(rp, vo, (rowbase + sb + j) * (NIN * 2) + 1280 * 2);
#pragma unroll
        for (int j = 0; j < 31; ++j) { const int s = sb - 15 + j, sc = s < 0 ? 0 : s; udr[j] = bld(rp, vo, (rowbase + sc) * (NIN * 2) + 2048 * 2); }
        const __amdgpu_buffer_rsrc_t rw = __builtin_amdgcn_make_buffer_rsrc((void*)(F.scw + (size_t)l * 3 * 256), 0, 3 * 256 * 4, 0x00020000);
        f32x2 w3[3];
#pragma unroll
        for (int k = 0; k < 3; ++k) w3[k] = bld2(rw, c2 * 4, k * 1024);
        f32x2 pr[18];
#pragma unroll
        for (int j = 0; j < 18; ++j) { const float ok = (sb - 2 + j) >= 0 ? 1.f : 0.f; pr[j] = (f32x2){bflo(cgr[j]) * bflo(xcr[j]) * ok, bfhi(cgr[j]) * bfhi(xcr[j]) * ok}; }
#pragma unroll
        for (int i = 0; i < 16; ++i) { const f32x2 cv = w3[0] * pr[i] + w3[1] * pr[i + 1] + w3[2] * pr[i + 2];
            __builtin_amdgcn_raw_buffer_store_b32(pk2(bflo(bgr[i]) * cv[0], bfhi(bgr[i]) * cv[1]), rm, vo, (rowbase + sb + i) * (DM * 2) + 512 * 2, 0); }
        const int grp = c2 >> 6;
        const float m1 = grp >= 1 ? 1.f : 0.f, m2 = grp >= 2 ? 1.f : 0.f, m3 = grp >= 3 ? 1.f : 0.f;
        f32x2 t[31], ut[16];
#pragma unroll
        for (int j = 0; j < 31; ++j) { const float ok = (sb - 15 + j) >= 0 ? 1.f : 0.f; t[j] = (f32x2){bflo(udr[j]) * ok, bfhi(udr[j]) * ok}; }
#pragma unroll
        for (int i = 0; i < 16; ++i) ut[i] = t[15 + i];
#pragma unroll
        for (int j = 30; j >= 1; --j) t[j] += t[j - 1];
#pragma unroll
        for (int j = 30; j >= 3; --j) t[j] += t[j - 2] * m1;
#pragma unroll
        for (int j = 30; j >= 7; --j) t[j] += t[j - 4] * m2;
#pragma unroll
        for (int j = 30; j >= 15; --j) t[j] += t[j - 8] * m3;
#pragma unroll
        for (int i = 0; i < 16; ++i) { const int win = 2 << grp, s = sb + i; const float rc = 1.0f / (float)((s + 1 < win) ? (s + 1) : win); const f32x2 y = t[15 + i] * rc - ut[i];
            __builtin_amdgcn_raw_buffer_store_b32(pk2(y[0], y[1]), rm, vo, (rowbase + s) * (DM * 2) + 768 * 2, 0); }
    }
    {
        unsigned rv[46], rg[46];
#pragma unroll
        for (int j = 0; j < 46; ++j) { const int s = sb - 30 + j, sc = s < 0 ? 0 : s; const int so = (rowbase + sc) * (NIN * 2) + 768 * 2; rv[j] = bld(rp, vo, so); rg[j] = bld(rp, vo, so + 512); }
        const __amdgpu_buffer_rsrc_t rw = __builtin_amdgcn_make_buffer_rsrc((void*)(F.cdw + (size_t)l * 31 * 256), 0, 31 * 256 * 4, 0x00020000);
        f32x2 w[31];
#pragma unroll
        for (int k = 0; k < 31; ++k) w[k] = bld2(rw, c2 * 4, k * 1024);
        f32x2 acc[16];
        const f32x2 bias = *(const f32x2*)(F.cdb + l * 256 + c2);
#pragma unroll
        for (int i = 0; i < 16; ++i) acc[i] = bias;
#pragma unroll
        for (int j = 0; j < 46; ++j) { const float ok = (sb - 30 + j) >= 0 ? 1.f : 0.f;
            const f32x2 hv = (f32x2){bflo(rv[j]) * sigmoidf_(bflo(rg[j])) * ok, bfhi(rv[j]) * sigmoidf_(bfhi(rg[j])) * ok};
#pragma unroll
            for (int i = 0; i < 16; ++i) { if (j - i >= 0 && j - i <= 30) acc[i] += w[j - i] * hv; } }
#pragma unroll
        for (int i = 0; i < 16; ++i) *(LAS f32x2*)(cbuf + (16 * tq + i) * 256 + c2) = acc[i];
    }
    LDS_WAIT(); __syncthreads();
    {
        const f32x4 g = *(const f32x4*)(F.clg + l * 256 + 4 * lane), bb = *(const f32x4*)(F.clb + l * 256 + 4 * lane);
#pragma unroll 2
        for (int i = 0; i < 8; ++i) { const int t = 8 * F.wave + i; const f32x4 v = *(const LAS f32x4*)(cbuf + t * 256 + 4 * lane);
            const float mu = wave_sum((v[0] + v[1]) + (v[2] + v[3])) * (1.0f / 256.0f); const f32x4 d = v - mu;
            const float var = wave_sum((d[0] * d[0] + d[1] * d[1]) + (d[2] * d[2] + d[3] * d[3])) * (1.0f / 256.0f);
            const float rs = __builtin_amdgcn_rsqf(var + EPS); f32x4 y = d * rs * g + bb;
            y[0] *= sigmoidf_(y[0]); y[1] *= sigmoidf_(y[1]); y[2] *= sigmoidf_(y[2]); y[3] *= sigmoidf_(y[3]);
            v2u w; w.x = pk2(y[0], y[1]); w.y = pk2(y[2], y[3]);
            *(v2u*)(F.MIX + ((size_t)rowbase + s0 + t) * DM + 256 + 4 * lane) = w; }
    }
    __syncthreads();
}

struct Args { const float* in[21]; float* out; unsigned char* ws; int ph_lo, ph_hi, li, pad; };
__global__ void __launch_bounds__(NWAVES * 64, 2) trunk_fwd(Args args) {
    extern __shared__ __attribute__((aligned(16))) unsigned char lds[];
    Frame F;
    F.lds = (LAS unsigned char*)lds;
    F.MISC = (volatile LAS unsigned*)(F.lds + MISC_OFF);
    F.tid = threadIdx.x; F.lane = F.tid & 63; F.wave = __builtin_amdgcn_readfirstlane(F.tid >> 6);
    F.G = gridDim.x; { const int bx = blockIdx.x; F.vcu = (F.G % 8 == 0) ? (bx % 8) * (F.G / 8) + bx / 8 : bx; }
    unsigned char* ws = args.ws; F.ws = ws;
    F.ctl = (gu32*)(ws + WS_CTL);
    F.x = args.in[0]; F.c = args.in[1]; F.w_ada = args.in[2]; F.b_ada = args.in[3]; F.n1g = args.in[4]; F.n2g = args.in[5]; F.w_in = args.in[6]; F.w_out = args.in[7];
    F.qng = args.in[8]; F.kng = args.in[9]; F.lamp = args.in[10]; F.subg = args.in[11]; F.cdw = args.in[12]; F.cdb = args.in[13]; F.clg = args.in[14]; F.clb = args.in[15];
    F.scw = args.in[16]; F.poolw = args.in[17]; F.poolsc = args.in[18]; F.w_ff1 = args.in[19]; F.w_ff2 = args.in[20]; F.out = args.out;
    F.MOD = (float*)(ws + WS_MOD); F.BIAS1 = (float*)(ws + WS_BIAS1); F.BIAS2 = (float*)(ws + WS_BIAS2); F.SSQ1 = (float*)(ws + WS_SSQ1); F.SSQ2 = (float*)(ws + WS_SSQ2);
    F.HA = (bf16*)(ws + WS_HA); F.XB = (bf16*)(ws + WS_XB); F.PROJ = (bf16*)(ws + WS_PROJ); F.MIX = (bf16*)(ws + WS_MIX); F.HID = (bf16*)(ws + WS_HID);
    for (int u = F.tid; u < (LDS_BYTES - LDSCTL_OFF) / 4; u += NWAVES * 64) ((LAS unsigned*)(F.lds + LDSCTL_OFF))[u] = 0u;
    __syncthreads();
    XcdBarrier bar; bar.bar = (unsigned*)(F.ctl + CW_BAR); bar.x = 0; bar.st = nullptr;
    if (!MK_PER_PHASE) bar = xcd_barrier_post((unsigned*)(F.ctl + CW_BAR), F.MISC + 8);
    const int lo = args.ph_lo, hi = args.ph_hi;
#define IN(k) (lo <= (k) && (k) < hi)
#define SEAM(k) do { if (IN((k) + 1)) xcd_barrier(bar); } while (0)

#ifndef PROBE_DUP
#define PROBE_DUP 0
#endif
#ifndef PROBE_N
#define PROBE_N 2
#endif
#define REPS(k) (((PROBE_DUP >> (k)) & 1) ? PROBE_N : 1)
    if (IN(0)) { for (int rep = 0; rep < REPS(0); ++rep) { if (rep) xcd_barrier(bar);
#pragma unroll 1
        for (int L = 0; L < (PREP_UPFRONT ? DEPTH : 1); ++L) prep_layer(F, L, F.vcu, F.G, rep ? ((PROBE_DUP >> 8) & 15) : 3); } SEAM(0); }
    if (IN(1)) { for (int rep = 0; rep < REPS(1); ++rep) { if (rep) xcd_barrier(bar); p0b(F); } SEAM(1); }
#pragma unroll 1
    for (int l = 0; l < DEPTH; ++l) {
        const int p = 2 + 5 * l;
        { int tl = threadIdx.x; asm volatile("" : "+v"(tl)); F.tid = tl; F.lane = tl & 63; F.wave = __builtin_amdgcn_readfirstlane(tl >> 6); }
        int bxl = blockIdx.x; asm volatile("" : "+s"(bxl));
        const float* modl = F.MOD + (size_t)l * 8 * NMOD;
        if (IN(p)) {
            for (int rep = 0; rep < REPS(2); ++rep) { if (rep) { xcd_barrier(bar); int tl = threadIdx.x; asm volatile("" : "+v"(tl)); F.tid = tl; F.lane = tl & 63; F.wave = __builtin_amdgcn_readfirstlane(tl >> 6); asm volatile("" : "+s"(bxl)); }
            pg8::Gemm g{F.HA, wt_ptr(F, l, WT_IN), M, NIN, DM}; pg8::StaticOrder S; S.init(M, NIN, F.G, bxl);
            rstd_table(F, S, F.SSQ1);
            pg8::EpiProj E{F.PROJ, F.BIAS1 + (size_t)l * 8 * NIN, (const LAS float*)(F.lds + RT_OFF), F.qng + l * 32, F.kng + l * 32, QSCALE};
            pg8::gemm_phase<pg8::EpiProj, pg8::StaticOrder, true, true>(F.lds + RING_OFF, g, S, E, F.tid);
            if (!PREP_UPFRONT && l + 1 < DEPTH && !rep) {
                const int nun = (M / 256) * (NIN / 256), rounds = (nun + F.G - 1) / F.G, first_idle = nun - (rounds - 1) * F.G;
                if (first_idle >= F.G) prep_layer(F, l + 1, F.vcu, F.G); else if (bxl >= first_idle) prep_layer(F, l + 1, bxl - first_idle, F.G - first_idle); } }
            SEAM(p);
        }
        if (IN(p + 1)) {
            for (int rep = 0; rep < REPS(3); ++rep) { if (rep) xcd_barrier(bar); attn_phase(F, l, rep + 1 < REPS(3) ? ((PROBE_DUP >> 12) & 15) : 0); }
            for (int rep = 0; rep < REPS(4); ++rep) { if (rep) xcd_barrier(bar); for (int tt = F.vcu; tt < 256; tt += F.G) mixer_tile(F, l, tt); }
            if (!PREP_UPFRONT && l + 1 < DEPTH) bias_layer(F, l + 1);
            SEAM(p + 1);
        }
        if (IN(p + 2)) {
            for (int rep = 0; rep < REPS(5); ++rep) { if (rep) { xcd_barrier(bar); int tl = threadIdx.x; asm volatile("" : "+v"(tl)); F.tid = tl; F.lane = tl & 63; F.wave = __builtin_amdgcn_readfirstlane(tl >> 6); asm volatile("" : "+s"(bxl)); }
            pg8::Gemm g{F.MIX, wt_ptr(F, l, WT_OUT), M, DM, DM}; pg8::StaticOrder S; S.init(M, DM, F.G, bxl);
            pg8::EpiRes E{(l == 0 || rep) ? F.x : nullptr, F.XB, nullptr, rep ? F.PROJ : F.XB, modl + 2048, modl + 4096, F.n2g + l * DM, rep ? (bf16*)((unsigned char*)F.PROJ + 32 * MiB) : F.HA, rep ? (float*)((unsigned char*)F.PROJ + 64 * MiB) : F.SSQ2, 1};
            pg8::gemm_phase<pg8::EpiRes, pg8::StaticOrder, true, true>(F.lds + RING_OFF, g, S, E, F.tid); }
            SEAM(p + 2);
        }
        if (IN(p + 3)) {
            for (int rep = 0; rep < REPS(6); ++rep) { if (rep) { xcd_barrier(bar); int tl = threadIdx.x; asm volatile("" : "+v"(tl)); F.tid = tl; F.lane = tl & 63; F.wave = __builtin_amdgcn_readfirstlane(tl >> 6); asm volatile("" : "+s"(bxl)); }
            pg8::Gemm g{F.HA, wt_ptr(F, l, WT_FF1), M, FF, DM}; pg8::StaticOrder S; S.init(M, FF, F.G, bxl);
            rstd_table(F, S, F.SSQ2);
            pg8::EpiFF1 E{F.HID, F.BIAS2 + (size_t)l * 8 * FF, (const LAS float*)(F.lds + RT_OFF)};
            pg8::gemm_phase<pg8::EpiFF1, pg8::StaticOrder, true, true>(F.lds + RING_OFF, g, S, E, F.tid); }
            SEAM(p + 3);
        }
        if (IN(p + 4)) {
            for (int rep = 0; rep < REPS(7); ++rep) { if (rep) { xcd_barrier(bar); int tl = threadIdx.x; asm volatile("" : "+v"(tl)); F.tid = tl; F.lane = tl & 63; F.wave = __builtin_amdgcn_readfirstlane(tl >> 6); asm volatile("" : "+s"(bxl)); }
            pg8::Gemm g{F.HID, wt_ptr(F, l, WT_FF2), M, DM, FF}; pg8::StaticOrder S; S.init(M, DM, F.G, bxl);
            const int nl = l + 1 < DEPTH ? l + 1 : l;
            if (rep && l + 1 == DEPTH) break;
            pg8::EpiRes E{rep ? F.x : nullptr, F.XB, (l + 1 == DEPTH && !rep) ? F.out : nullptr, rep ? (bf16*)F.out : F.XB, modl + 5120, F.MOD + (size_t)nl * 8 * NMOD + 1024, F.n1g + nl * DM, rep ? (bf16*)((unsigned char*)F.out + 32 * MiB) : F.HA, rep ? (float*)(F.ws + WS_SSQ2) : F.SSQ1, (l + 1 < DEPTH || rep) ? 1 : 0};
            pg8::gemm_phase<pg8::EpiRes, pg8::StaticOrder, true, true>(F.lds + RING_OFF, g, S, E, F.tid); }
            if (l + 1 < DEPTH) SEAM(p + 4);
        }
    }
#undef IN
#undef SEAM
}

extern "C" void kernel_launch(void* const* d_in, const int* in_sizes, int n_in, void* d_out, int out_size, void* d_ws, size_t ws_size, hipStream_t stream) {
    static int grid = 0;
    if (grid == 0) {
        if (n_in != 21 || in_sizes[0] != M * DM || out_size != M * DM || ws_size < WS_END) { fprintf(stderr, "kernel_launch: unexpected problem shape (n_in %d, in0 %d, out %d, ws %zu, need %zu); nothing launched\n", n_in, n_in > 0 ? in_sizes[0] : -1, out_size, ws_size, (size_t)WS_END); grid = -1; return; }
        int dev = 0, cus = 0, per_cu = 0;
        if (hipGetDevice(&dev) != hipSuccess || hipDeviceGetAttribute(&cus, hipDeviceAttributeMultiprocessorCount, dev) != hipSuccess) { fprintf(stderr, "kernel_launch: device query failed\n"); grid = -1; return; }
        if (hipFuncSetAttribute((const void*)trunk_fwd, hipFuncAttributeMaxDynamicSharedMemorySize, LDS_BYTES) != hipSuccess) { fprintf(stderr, "kernel_launch: hipFuncSetAttribute failed\n"); grid = -1; return; }
        if (hipOccupancyMaxActiveBlocksPerMultiprocessor(&per_cu, (const void*)trunk_fwd, NWAVES * 64, LDS_BYTES) != hipSuccess || per_cu < 1) { fprintf(stderr, "kernel_launch: occupancy query reports %d workgroups per CU\n", per_cu); }
        (void)hipGetLastError();
        grid = cus;
    }
    if (grid < 0) return;
    if (hipMemsetAsync((char*)d_ws + WS_CTL, 0, CTL_ZERO_BYTES, stream) != hipSuccess) { fprintf(stderr, "kernel_launch: hipMemsetAsync failed\n"); return; }
    Args a{};
    for (int i = 0; i < 21; ++i) a.in[i] = (const float*)d_in[i];
    a.out = (float*)d_out; a.ws = (unsigned char*)d_ws;
#if MK_PER_PHASE
    for (int li = 0; li < N_PHASES; ++li) { a.ph_lo = li; a.ph_hi = li + 1; a.li = li;
        hipLaunchKernelGGL(trunk_fwd, dim3(grid), dim3(NWAVES * 64), LDS_BYTES, stream, a); }
#else
    a.ph_lo = 0; a.ph_hi = N_PHASES; a.li = 0;
    hipLaunchKernelGGL(trunk_fwd, dim3(grid), dim3(NWAVES * 64), LDS_BYTES, stream, a);
#endif
    const hipError_t le = hipPeekAtLastError();
    if (le != hipSuccess) fprintf(stderr, "kernel_launch: launch failed: %s\n", hipGetErrorName(le));
}
```

```cpp
#include <hip/hip_runtime.h>
#include <cstdio>
#include <cstdint>
#include <cmath>
namespace pg8 {
#define PG8_LAS __attribute__((address_space(3)))
typedef unsigned short bf16_t;
typedef short bf16x8 __attribute__((ext_vector_type(8)));
typedef float f32x4 __attribute__((ext_vector_type(4)));
typedef unsigned u32x4 __attribute__((ext_vector_type(4)));
constexpr int BM = 256, BK = 64, HALF = 128, HTB = HALF * BK * 2  , STAGE_BYTES = 8 * HTB, NXCD = 8, WGM = 8;

__host__ __device__ __forceinline__ int lds_byte(int r, int c) { const int st = (r >> 4) * 2 + (c >> 5), rr = r & 15, cc = c & 31, ob = rr * 64 + cc * 2; return st * 1024 + (ob ^ (((ob >> 9) & 1) << 5)); }
__host__ __device__ __forceinline__ void stage_rc(int b, int& R, int& C) { const int st = b / 1024, sb = b % 1024, swz = sb ^ (((sb >> 9) & 1) << 5); R = (st >> 1) * 16 + swz / 64; C = (st & 1) * 32 + (swz % 64) / 2; }
__host__ __device__ __forceinline__ int perm32(int rho) { const int n = rho >> 4, i = rho & 15; return 8 * (i >> 2) + 4 * n + (i & 3); }

struct Unit { int pm, pn; };
struct Gemm { const bf16_t* A; const bf16_t* Bt; int M, N, K; size_t gapA; };

struct StaticOrder {
    int nM, nN, nwg, G, c;
    __host__ __device__ void init(int M, int N, int G_, int c_) { nM = M / BM; nN = N / BM; nwg = nM * nN; G = G_; c = c_; }
    __host__ __device__ bool next(int i, Unit& u) const {
        const long L = (long)i * G + c; if (L >= nwg) return false;
        int wgid = (int)L; { const int q = nwg / NXCD, r = nwg % NXCD, xcd = wgid % NXCD, off = wgid / NXCD; wgid = (xcd < r ? xcd * (q + 1) : r * (q + 1) + (xcd - r) * q) + off; }
        const int nig = WGM * nN, gid = wgid / nig, fm = gid * WGM, gsz = (nM - fm) < WGM ? (nM - fm) : WGM;
        u.pm = fm + ((wgid % nig) % gsz); u.pn = (wgid % nig) / gsz; return true;
    }
    __device__ __forceinline__ void a_ready(const Unit&) const {}
    __device__ __forceinline__ void done(const Unit&) const {}
};


__device__ __forceinline__ unsigned cvt_pk_bf16(float lo, float hi) { unsigned r; asm volatile("v_cvt_pk_bf16_f32 %0, %1, %2" : "=v"(r) : "v"(lo), "v"(hi)); return r; }
typedef unsigned u32x2 __attribute__((ext_vector_type(2)));
__device__ __forceinline__ float dot4(f32x4 a) { return (a[0] * a[0] + a[1] * a[1]) + (a[2] * a[2] + a[3] * a[3]); }

struct EpiProj {
    static constexpr bool PERM = true, AFTER_DRAIN = false;
    bf16_t* O; const float* bias; const PG8_LAS float* rtab; const float* qg; const float* kg; float qscale; size_t obs;
    __device__ __forceinline__ void operator()(const f32x4 (&acc)[2][2][4][2], const Unit& u, int ui, int wr, int wc, int fr, int fq) const {
        const int b = u.pm >> 3;
        const int row0 = (u.pm & 7) * BM + wr * 64 + fr, col0 = u.pn * BM + wc * 32 + 8 * fq;
        bf16_t* Ob = O + (size_t)b * obs;
        const float* bp = bias + b * 2304 + col0;
        f32x4 bv[2][2];
#pragma unroll
        for (int bj = 0; bj < 2; ++bj)
#pragma unroll
            for (int n = 0; n < 2; ++n) bv[bj][n] = *(const f32x4*)(bp + bj * HALF + 4 * n);
        const PG8_LAS float* rt = rtab + ui * 256 + wr * 64 + fr;
        const int kind = (u.pn == 3 || u.pn == 4) ? 1 : ((u.pn == 6 || u.pn == 7) ? 2 : 0);
        if (kind) {
            const int ocol = (kind == 1 ? 768 + (u.pn - 3) * 128 : 1536 + (u.pn - 6) * 128) + wc * 32 + 8 * fq;
#pragma unroll
            for (int ai = 0; ai < 2; ++ai)
#pragma unroll
                for (int m = 0; m < 4; ++m) { const float rs = rt[ai * HALF + m * 16];
                    const f32x4 a0 = acc[ai][0][m][0] * rs + bv[0][0], a1 = acc[ai][0][m][1] * rs + bv[0][1], g0 = acc[ai][1][m][0] * rs + bv[1][0], g1 = acc[ai][1][m][1] * rs + bv[1][1];
                    f32x4 v0, v1;
                    if (kind == 1) {
#pragma unroll
                        for (int i = 0; i < 4; ++i) { v0[i] = a0[i] * __builtin_amdgcn_rcpf(1.0f + __expf(-g0[i])); v1[i] = a1[i] * __builtin_amdgcn_rcpf(1.0f + __expf(-g1[i])); }
                    } else { v0 = a0 * g0; v1 = a1 * g1; }
                    u32x4 w; w.x = cvt_pk_bf16(v0[0], v0[1]); w.y = cvt_pk_bf16(v0[2], v0[3]); w.z = cvt_pk_bf16(v1[0], v1[1]); w.w = cvt_pk_bf16(v1[2], v1[3]);
                    *(u32x4*)(Ob + (size_t)(row0 + ai * HALF + m * 16) * 2304 + ocol) = w; }
            return;
        }
        const bool isqk = u.pn < 2;
        f32x4 g0 = (f32x4){1.f, 1.f, 1.f, 1.f}, g1 = g0;
        if (isqk) { const float* gp = (u.pn == 0 ? qg : kg) + 8 * fq; g0 = *(const f32x4*)gp; g1 = *(const f32x4*)(gp + 4); if (u.pn == 0) { g0 = g0 * qscale; g1 = g1 * qscale; } }
#pragma unroll
        for (int ai = 0; ai < 2; ++ai)
#pragma unroll
            for (int m = 0; m < 4; ++m) { const float rs = rt[ai * HALF + m * 16]; bf16_t* rowp = Ob + (size_t)(row0 + ai * HALF + m * 16) * 2304 + col0;
#pragma unroll
                for (int bj = 0; bj < 2; ++bj) { f32x4 v0 = acc[ai][bj][m][0] * rs + bv[bj][0], v1 = acc[ai][bj][m][1] * rs + bv[bj][1];
                    if (isqk) { float ss = dot4(v0) + dot4(v1); ss += __shfl_xor(ss, 16); ss += __shfl_xor(ss, 32);
                        const float r = __builtin_amdgcn_rsqf(ss * (1.0f / 32.0f) + 1e-6f); v0 = v0 * r * g0; v1 = v1 * r * g1; }
                    u32x4 w; w.x = cvt_pk_bf16(v0[0], v0[1]); w.y = cvt_pk_bf16(v0[2], v0[3]); w.z = cvt_pk_bf16(v1[0], v1[1]); w.w = cvt_pk_bf16(v1[2], v1[3]);
                    *(u32x4*)(rowp + bj * HALF) = w; } }
    }
};
struct EpiFF1 {
    static constexpr bool PERM = true, AFTER_DRAIN = false;
    bf16_t* O; const float* bias; const PG8_LAS float* rtab;
    __device__ __forceinline__ void operator()(const f32x4 (&acc)[2][2][4][2], const Unit& u, int ui, int wr, int wc, int fr, int fq) const {
        const int b = u.pm >> 3;
        const int row0 = u.pm * BM + wr * 64 + fr, col0 = u.pn * BM + wc * 32 + 8 * fq;
        const float* bp = bias + b * 4096 + col0;
        f32x4 bv[2][2];
#pragma unroll
        for (int bj = 0; bj < 2; ++bj)
#pragma unroll
            for (int n = 0; n < 2; ++n) bv[bj][n] = *(const f32x4*)(bp + bj * HALF + 4 * n);
        const PG8_LAS float* rt = rtab + ui * 256 + wr * 64 + fr;
        const f32x4 z = (f32x4){0.f, 0.f, 0.f, 0.f};
#pragma unroll
        for (int ai = 0; ai < 2; ++ai)
#pragma unroll
            for (int m = 0; m < 4; ++m) {
#ifdef EXP_A
 const float rs = 1.0f;
#else
 const float rs = rt[ai * HALF + m * 16];
#endif
 bf16_t* rowp = O + (size_t)(row0 + ai * HALF + m * 16) * 4096 + col0;
#pragma unroll
                for (int bj = 0; bj < 2; ++bj) { f32x4 v0 = acc[ai][bj][m][0] * rs + bv[bj][0], v1 = acc[ai][bj][m][1] * rs + bv[bj][1];
                    v0 = __builtin_elementwise_max(v0, z); v1 = __builtin_elementwise_max(v1, z); v0 = v0 * v0; v1 = v1 * v1;
                    u32x4 w; w.x = cvt_pk_bf16(v0[0], v0[1]); w.y = cvt_pk_bf16(v0[2], v0[3]); w.z = cvt_pk_bf16(v1[0], v1[1]); w.w = cvt_pk_bf16(v1[2], v1[3]);
                    *(u32x4*)(rowp + bj * HALF) = w; } }
    }
};
struct EpiRes {
    static constexpr bool PERM = true, AFTER_DRAIN = false;
    const float* xin_f; const bf16_t* xin_h; float* xout_f; bf16_t* xout_h; const float* gate; const float* nsc; const float* ng; bf16_t* hA; float* ssq; int write_next;
    __device__ __forceinline__ void operator()(const f32x4 (&acc)[2][2][4][2], const Unit& u, int ui, int wr, int wc, int fr, int fq) const {
        const int b = u.pm >> 3;
        const int col0 = u.pn * BM + wc * 32 + 8 * fq;
        f32x4 gv[2][2], gm[2][2];
#pragma unroll
        for (int bj = 0; bj < 2; ++bj)
#pragma unroll
            for (int n = 0; n < 2; ++n) { const int c = col0 + bj * HALF + 4 * n; gv[bj][n] = *(const f32x4*)(gate + b * 6144 + c);
                if (write_next) gm[bj][n] = *(const f32x4*)(ng + c) * (*(const f32x4*)(nsc + b * 6144 + c) + 1.0f); else gm[bj][n] = (f32x4){0.f, 0.f, 0.f, 0.f}; }
#pragma unroll
        for (int ai = 0; ai < 2; ++ai) {
            u32x4 xr[4][2];
            if (!xin_f) {
#pragma unroll
                for (int m = 0; m < 4; ++m) { const size_t rbase = (size_t)(u.pm * BM + ai * HALF + wr * 64 + m * 16 + fr) * 1024 + col0;
#pragma unroll
                    for (int bj = 0; bj < 2; ++bj) xr[m][bj] = *(const u32x4*)(xin_h + rbase + bj * HALF); }
            }
#pragma unroll
            for (int m = 0; m < 4; ++m) { const int row = u.pm * BM + ai * HALF + wr * 64 + m * 16 + fr; float ss = 0.f;
#pragma unroll
                for (int bj = 0; bj < 2; ++bj) { const size_t off = (size_t)row * 1024 + col0 + bj * HALF;
                    f32x4 xi0, xi1;
                    if (xin_f) { xi0 = *(const f32x4*)(xin_f + off); xi1 = *(const f32x4*)(xin_f + off + 4); }
                    else { const u32x4 t = xr[m][bj];
                        xi0 = (f32x4){__builtin_bit_cast(float, t.x << 16), __builtin_bit_cast(float, t.x & 0xffff0000u), __builtin_bit_cast(float, t.y << 16), __builtin_bit_cast(float, t.y & 0xffff0000u)};
                        xi1 = (f32x4){__builtin_bit_cast(float, t.z << 16), __builtin_bit_cast(float, t.z & 0xffff0000u), __builtin_bit_cast(float, t.w << 16), __builtin_bit_cast(float, t.w & 0xffff0000u)}; }
                    const f32x4 xo0 = xi0 + gv[bj][0] * acc[ai][bj][m][0], xo1 = xi1 + gv[bj][1] * acc[ai][bj][m][1]; ss += dot4(xo0) + dot4(xo1);
                    if (xout_f) { *(f32x4*)(xout_f + off) = xo0; *(f32x4*)(xout_f + off + 4) = xo1; }
                    else { u32x4 w; w.x = cvt_pk_bf16(xo0[0], xo0[1]); w.y = cvt_pk_bf16(xo0[2], xo0[3]); w.z = cvt_pk_bf16(xo1[0], xo1[1]); w.w = cvt_pk_bf16(xo1[2], xo1[3]); *(u32x4*)(xout_h + off) = w; }
                    if (write_next) { const f32x4 h0 = xo0 * gm[bj][0], h1 = xo1 * gm[bj][1]; u32x4 w; w.x = cvt_pk_bf16(h0[0], h0[1]); w.y = cvt_pk_bf16(h0[2], h0[3]); w.z = cvt_pk_bf16(h1[0], h1[1]); w.w = cvt_pk_bf16(h1[2], h1[3]); *(u32x4*)(hA + off) = w; } }
                ss += __shfl_xor(ss, 16); ss += __shfl_xor(ss, 32);
                if (write_next && fq == 0) ssq[(size_t)(u.pn * 4 + wc) * 16384 + row] = ss;
                if ((m & 1) && xin_f) asm volatile("" ::: "memory"); }
            asm volatile("" ::: "memory"); }
    }
};

template <class Epi, class Sched, bool ALIGN_EPI = false, bool SP2 = false>
__device__ __forceinline__ void gemm_phase(PG8_LAS unsigned char* lds, const Gemm g, const Sched& S, const Epi& E, const int tid_in) {
    const int tid = tid_in, wid = __builtin_amdgcn_readfirstlane(tid >> 6), lane = tid & 63, wr = wid >> 2, wc = wid & 3, fr = lane & 15, fq = lane >> 4;
    const int K = g.K, nt = K / BK;
    unsigned voffA[2], voffB[2];
#pragma unroll
    for (int i = 0; i < 2; ++i) { int R, C; stage_rc(tid * 16 + i * 8192, R, C); const int Rb = Epi::PERM ? ((R & ~31) + perm32(R & 31)) : R;
        voffA[i] = (unsigned)(R * K + C) * 2u; voffB[i] = (unsigned)(Rb * K + C) * 2u; }
    const size_t kstep = (size_t)(BK * 2);
    const size_t hstep = (size_t)HALF * K * 2;
    const size_t tstep = 2 * hstep;
    const unsigned ldsw = (unsigned)wid * 1024u;
    const int aoff = lds_byte(wr * 64 + fr, fq * 8), boff = lds_byte(wc * 32 + fr, fq * 8);
#define PG8_SA(b, h) (((b) * 2 + (h)) * HTB)
#define PG8_SB(b, h) ((4 + (b) * 2 + (h)) * HTB)
#define PG8_STAGE(bufoff, gbase, voff) do { _Pragma("unroll") for (int _i = 0; _i < 2; ++_i) \
        __builtin_amdgcn_global_load_lds((const unsigned*)((const char*)(gbase) + (voff)[_i]), (PG8_LAS unsigned*)(lds + (bufoff) + ldsw + _i * 8192), 16, 0, 0); } while (0)
#define PG8_LDA(dst, b, h) do { _Pragma("unroll") for (int m = 0; m < 4; ++m) _Pragma("unroll") for (int k = 0; k < 2; ++k) dst[m][k] = *(const PG8_LAS bf16x8*)(lds + PG8_SA(b, h) + aoff + m * 2048 + k * 1024); } while (0)
#define PG8_LDB(dst, b, h) do { _Pragma("unroll") for (int n = 0; n < 2; ++n) _Pragma("unroll") for (int k = 0; k < 2; ++k) dst[n][k] = *(const PG8_LAS bf16x8*)(lds + PG8_SB(b, h) + boff + n * 2048 + k * 1024); } while (0)
#define PG8_MMA(ai, bj, At, Bt) do { __builtin_amdgcn_s_setprio(1); _Pragma("unroll") for (int m = 0; m < 4; ++m) _Pragma("unroll") for (int n = 0; n < 2; ++n) _Pragma("unroll") for (int k = 0; k < 2; ++k) \
        acc[ai][bj][m][n] = __builtin_amdgcn_mfma_f32_16x16x32_bf16(Bt[n][k], At[m][k], acc[ai][bj][m][n], 0, 0, 0); __builtin_amdgcn_s_setprio(0); } while (0)
#define PG8_WAIT_V(n) asm volatile("s_waitcnt vmcnt(" #n ")" ::: "memory")
#define PG8_WAIT_L(n) asm volatile("s_waitcnt lgkmcnt(" #n ")" ::: "memory")
#define PG8_BAR __builtin_amdgcn_s_barrier()
#define PG8_SCHED __builtin_amdgcn_sched_barrier(0)
    Unit cur, nxt; int ui = 0;
    if (!S.next(0, cur)) return;
    f32x4 acc[2][2][4][2];
#pragma unroll
    for (int a = 0; a < 2; ++a)
#pragma unroll
        for (int b = 0; b < 2; ++b)
#pragma unroll
            for (int m = 0; m < 4; ++m)
#pragma unroll
                for (int n = 0; n < 2; ++n) acc[a][b][m][n] = (f32x4){0.f, 0.f, 0.f, 0.f};
    bf16x8 At[4][2], B0[2][2], B1[2][2];
    const char* cA = (const char*)g.A + (size_t)cur.pm * tstep + (size_t)(cur.pm >> 3) * g.gapA; const char* cB = (const char*)g.Bt + (size_t)cur.pn * tstep;
    S.a_ready(cur);
    if constexpr (SP2) {
        PG8_STAGE(PG8_SB(0, 0), cB, voffB); PG8_STAGE(PG8_SB(0, 1), cB + hstep, voffB); PG8_STAGE(PG8_SA(0, 0), cA, voffA); PG8_STAGE(PG8_SA(0, 1), cA + hstep, voffA);
        if (wr == 1) PG8_BAR;
        PG8_WAIT_V(2); PG8_BAR;
        PG8_STAGE(PG8_SB(1, 0), cB + kstep, voffB); PG8_STAGE(PG8_SA(1, 0), cA + kstep, voffA); PG8_STAGE(PG8_SB(1, 1), cB + hstep + kstep, voffB);
        PG8_WAIT_V(6); PG8_BAR;
    } else {
        PG8_STAGE(PG8_SB(0, 0), cB, voffB); PG8_STAGE(PG8_SA(0, 0), cA, voffA); PG8_STAGE(PG8_SB(0, 1), cB + hstep, voffB); PG8_STAGE(PG8_SA(0, 1), cA + hstep, voffA);
        if (wr == 1) PG8_BAR;
        PG8_WAIT_V(4); PG8_BAR;
        PG8_STAGE(PG8_SB(1, 0), cB + kstep, voffB); PG8_STAGE(PG8_SA(1, 0), cA + kstep, voffA); PG8_STAGE(PG8_SB(1, 1), cB + hstep + kstep, voffB);
        PG8_WAIT_V(6); PG8_BAR;
    }
    for (;;) {
        const bool has_next = S.next(ui + 1, nxt);
        const char* nA = has_next ? (const char*)g.A + (size_t)nxt.pm * tstep + (size_t)(nxt.pm >> 3) * g.gapA : cA; const char* nB = has_next ? (const char*)g.Bt + (size_t)nxt.pn * tstep : cB;
        for (int t = 0; t < nt; t += 2) {
            const bool last = (t == nt - 2);
            const char* a1 = cA + (size_t)(t + 1) * kstep;
            const char* a2 = last ? nA : cA + (size_t)(t + 2) * kstep; const char* b2 = last ? nB : cB + (size_t)(t + 2) * kstep;
            const char* a3 = a2 + kstep; const char* b3 = b2 + kstep;
            if (last && has_next) S.a_ready(nxt);
            if constexpr (SP2) {
            PG8_LDB(B0, 0, 0); PG8_LDB(B1, 0, 1); PG8_SCHED; PG8_LDA(At, 0, 0); PG8_STAGE(PG8_SA(1, 1), a1 + hstep, voffA);
            PG8_WAIT_V(8); PG8_WAIT_L(0); PG8_BAR; PG8_MMA(0, 0, At, B0); PG8_MMA(0, 1, At, B1); PG8_BAR; PG8_SCHED;
            PG8_LDA(At, 0, 1); PG8_STAGE(PG8_SB(0, 0), b2, voffB); PG8_STAGE(PG8_SB(0, 1), b2 + hstep, voffB); PG8_STAGE(PG8_SA(0, 0), a2, voffA);
            PG8_WAIT_V(8); PG8_WAIT_L(0); PG8_BAR; PG8_MMA(1, 0, At, B0); PG8_MMA(1, 1, At, B1); PG8_BAR; PG8_SCHED;
            PG8_LDB(B0, 1, 0); PG8_LDB(B1, 1, 1); PG8_SCHED; PG8_LDA(At, 1, 0); PG8_STAGE(PG8_SA(0, 1), a2 + hstep, voffA);
            PG8_WAIT_V(8); PG8_WAIT_L(0); PG8_BAR; PG8_MMA(0, 0, At, B0); PG8_MMA(0, 1, At, B1); PG8_BAR; PG8_SCHED;
            PG8_LDA(At, 1, 1); PG8_STAGE(PG8_SB(1, 0), b3, voffB); PG8_STAGE(PG8_SB(1, 1), b3 + hstep, voffB); PG8_STAGE(PG8_SA(1, 0), a3, voffA);
            PG8_WAIT_V(8); PG8_WAIT_L(0); PG8_BAR; PG8_MMA(1, 0, At, B0); PG8_MMA(1, 1, At, B1); PG8_BAR; PG8_SCHED;
            } else {
            PG8_LDB(B0, 0, 0); PG8_SCHED; PG8_LDA(At, 0, 0); PG8_STAGE(PG8_SA(1, 1), a1 + hstep, voffA);
            PG8_WAIT_L(8); PG8_BAR; PG8_WAIT_L(0); PG8_MMA(0, 0, At, B0); PG8_BAR; PG8_SCHED;
            PG8_LDB(B1, 0, 1); PG8_STAGE(PG8_SB(0, 0), b2, voffB);
            PG8_BAR; PG8_WAIT_L(0); PG8_MMA(0, 1, At, B1); PG8_BAR;
            PG8_LDA(At, 0, 1); PG8_STAGE(PG8_SA(0, 0), a2, voffA);
            PG8_BAR; PG8_WAIT_L(0); PG8_MMA(1, 0, At, B0); PG8_BAR; PG8_SCHED;
            PG8_STAGE(PG8_SB(0, 1), b2 + hstep, voffB);
            PG8_WAIT_V(6); PG8_BAR; PG8_MMA(1, 1, At, B1); PG8_BAR;
            PG8_LDB(B0, 1, 0); PG8_SCHED; PG8_LDA(At, 1, 0); PG8_STAGE(PG8_SA(0, 1), a2 + hstep, voffA);
            PG8_WAIT_L(8); PG8_BAR; PG8_WAIT_L(0); PG8_MMA(0, 0, At, B0); PG8_BAR; PG8_SCHED;
            PG8_LDB(B1, 1, 1); PG8_STAGE(PG8_SB(1, 0), b3, voffB);
            PG8_BAR; PG8_WAIT_L(0); PG8_MMA(0, 1, At, B1); PG8_BAR;
            PG8_LDA(At, 1, 1); PG8_STAGE(PG8_SA(1, 0), a3, voffA);
            PG8_BAR; PG8_WAIT_L(0); PG8_MMA(1, 0, At, B0); PG8_BAR; PG8_SCHED;
            PG8_STAGE(PG8_SB(1, 1), b3 + hstep, voffB);
            PG8_WAIT_V(6); PG8_BAR; PG8_MMA(1, 1, At, B1); PG8_BAR;
            }
        }
        if constexpr (ALIGN_EPI) { if (wr == 0) PG8_BAR; }
        if constexpr (!Epi::AFTER_DRAIN) { E(acc, cur, ui, wr, wc, fr, fq); S.done(cur); }
        if (!has_next) break;
#pragma unroll
        for (int a = 0; a < 2; ++a)
#pragma unroll
            for (int b = 0; b < 2; ++b)
#pragma unroll
                for (int m = 0; m < 4; ++m)
#pragma unroll
                    for (int n = 0; n < 2; ++n) acc[a][b][m][n] = (f32x4){0.f, 0.f, 0.f, 0.f};
        cur = nxt; cA = nA; cB = nB; ++ui;
        if constexpr (ALIGN_EPI) { if (wr == 1) PG8_BAR; }
    }
    PG8_WAIT_V(0);
    if constexpr (!ALIGN_EPI) { if (wr == 0) PG8_BAR; }
    PG8_BAR;
    if constexpr (Epi::AFTER_DRAIN) { E.fused(acc, cur, wr, wc, fr, fq, lds, wid, lane); S.done(cur); }
#undef PG8_SA
#undef PG8_SB
#undef PG8_STAGE
#undef PG8_LDA
#undef PG8_LDB
#undef PG8_MMA
#undef PG8_WAIT_V
#undef PG8_WAIT_L
#undef PG8_BAR
#undef PG8_SCHED
}
}

constexpr int NWAVES = 8;
constexpr int DM = 1024, BATCH = 8, SEQ = 2048, M = BATCH * SEQ, DEPTH = 4, NIN = 2304, FF = 4096, NMOD = 6144;
constexpr float EPS = 1e-6f;
constexpr float QSCALE = 0.17677669529663687f * 1.4426950408889634f;

#ifndef MK_PER_PHASE
#define MK_PER_PHASE 0
#endif
constexpr int N_PHASES = 2 + 5 * DEPTH;
#ifndef PROBE_T
#define PROBE_T 0
#endif
#define T0(k) do { if (PROBE_T == (k)) F.tt0 = __builtin_amdgcn_s_memrealtime(); } while (0)
#define T1(k) do { if (PROBE_T == (k)) F.tacc += __builtin_amdgcn_s_memrealtime() - F.tt0; } while (0)
#ifndef PREP_UPFRONT
#define PREP_UPFRONT 1
#endif

constexpr size_t MiB = 1u << 20;
constexpr size_t WS_CTL = 0, CTL_ZERO_BYTES = 256 * 1024;
constexpr size_t WS_MOD = 1 * MiB;
constexpr size_t WS_BIAS1 = 2 * MiB;
constexpr size_t WS_BIAS2 = 3 * MiB;
constexpr size_t WS_SSQ1 = 4 * MiB, WS_SSQ2 = 5 * MiB;
constexpr size_t WS_WT = 8 * MiB;
constexpr size_t WT_IN = 0, WT_OUT = (size_t)NIN * DM * 2, WT_FF1 = WT_OUT + (size_t)DM * DM * 2, WT_FF2 = WT_FF1 + (size_t)FF * DM * 2, WT_LAYER = WT_FF2 + (size_t)FF * DM * 2;
constexpr size_t WS_HA = WS_WT + DEPTH * WT_LAYER;
constexpr size_t WS_XB = WS_HA + (size_t)M * DM * 2;
constexpr size_t ACT_BSTRIDE = (size_t)SEQ * FF * 2;
constexpr size_t ACT_MIXOFF = (size_t)SEQ * NIN * 2;
constexpr size_t WS_PROJ = WS_XB + (size_t)M * DM * 2;
constexpr size_t WS_MIX = WS_PROJ + ACT_MIXOFF;
constexpr size_t WS_HID = WS_PROJ;
constexpr size_t WS_END = WS_HID + (size_t)M * FF * 2;
static_assert(WT_LAYER == (size_t)(NIN + DM + FF + FF) * DM * 2 && WS_HA % 256 == 0 && WS_PROJ % 256 == 0 && ACT_MIXOFF % 256 == 0 && ACT_MIXOFF + (size_t)SEQ * DM * 2 <= ACT_BSTRIDE && ACT_BSTRIDE * BATCH == (size_t)M * FF * 2, "ws map");
constexpr int CW_BAR = 4096;

constexpr int RING_OFF = 0, RING_BYTES = 131072;
constexpr int LDSCTL_OFF = RING_BYTES, MISC_OFF = LDSCTL_OFF + 320;
constexpr int PTR_OFF = LDSCTL_OFF + 128;
constexpr int RT_OFF = LDSCTL_OFF + 512;
constexpr int LDS_BYTES = 147456;
static_assert(RT_OFF + 8 * 256 * 4 <= LDS_BYTES, "LDS map");

#define GAS __attribute__((address_space(1)))
#define LAS __attribute__((address_space(3)))
typedef unsigned short bf16;
typedef unsigned v4u __attribute__((ext_vector_type(4)));
typedef unsigned v2u __attribute__((ext_vector_type(2)));
typedef float f32x4 __attribute__((ext_vector_type(4)));
typedef float f32x2 __attribute__((ext_vector_type(2)));
typedef short bf16x8 __attribute__((ext_vector_type(8)));
typedef short s16x4 __attribute__((ext_vector_type(4)));
typedef GAS unsigned gu32;
#define RLX_AGENT __ATOMIC_RELAXED, __HIP_MEMORY_SCOPE_AGENT
#define LDS_WAIT() asm volatile("s_waitcnt lgkmcnt(0)" ::: "memory")
#define VM_WAIT() asm volatile("s_waitcnt vmcnt(0)" ::: "memory")
__device__ __forceinline__ unsigned f2bf(float f) { unsigned u = __builtin_bit_cast(unsigned, f); return (u + 0x7fffu + ((u >> 16) & 1u)) >> 16; }
__device__ __forceinline__ unsigned pk2(float lo, float hi) { return f2bf(lo) | (f2bf(hi) << 16); }
__device__ __forceinline__ float bflo(unsigned v) { return __builtin_bit_cast(float, v << 16); }
__device__ __forceinline__ float bfhi(unsigned v) { return __builtin_bit_cast(float, v & 0xffff0000u); }
__device__ __forceinline__ float wave_sum(float v) {
#pragma unroll
    for (int o = 1; o < 64; o <<= 1) v += __shfl_xor(v, o);
    return v;
}
__device__ __forceinline__ float wave_max(float v) {
#pragma unroll
    for (int o = 1; o < 64; o <<= 1) v = fmaxf(v, __shfl_xor(v, o));
    return v;
}
__device__ __forceinline__ float sigmoidf_(float v) { return 1.0f / (1.0f + __expf(-v)); }

#define XB_TMO      128
#define XB_XCNT(j)  (256  + 64 * (j))
#define XB_XSUB(j)  (1280 + 64 * (j))
#define XB_XGEN(j)  (2304 + 64 * (j))
#define XB_TOP      3328
#define XB_TOPGEN   3392
#define XCD_BAR_WORDS 3456
#define XB_SPIN_CAP (1u << 18)
#ifndef XB_EARLY_WB
#define XB_EARLY_WB 1
#endif

__device__ __forceinline__ unsigned xb_ld(unsigned* p)              { return __hip_atomic_load(p, __ATOMIC_RELAXED, __HIP_MEMORY_SCOPE_AGENT); }
__device__ __forceinline__ unsigned xb_add(unsigned* p, unsigned v) { return __hip_atomic_fetch_add(p, v, __ATOMIC_RELAXED, __HIP_MEMORY_SCOPE_AGENT); }
__device__ __forceinline__ unsigned xb_xcc_id() { return (unsigned)__builtin_amdgcn_s_getreg((3 << 11) | 20) & 0xFu; }
#define XB_SPIN(cond, bar) do { unsigned _sp = 0; while (cond) { __builtin_amdgcn_s_sleep(1); \
    if ((++_sp & 255u) == 0u) { if (xb_ld(&(bar)[XB_TMO])) break; if (_sp > XB_SPIN_CAP) { atomicAdd(&(bar)[XB_TMO], 1u); break; } } } } while (0)

struct XcdBarrier { unsigned* bar; unsigned x; volatile LAS unsigned* st; unsigned gsize; };

__device__ __forceinline__ XcdBarrier xcd_barrier_post(unsigned* bar, volatile LAS unsigned* st, unsigned gsize) {
    XcdBarrier b; b.bar = bar; b.x = xb_xcc_id(); b.st = st; b.gsize = gsize;
    if (threadIdx.x == 0) (void)xb_add(&bar[XB_XCNT(b.x)], 1u);
    return b;
}
__device__ __forceinline__ void xcd_barrier_complete(unsigned* bar, unsigned x, unsigned G, unsigned& nloc, unsigned& nx) {
    unsigned sum, cnt, mine, sp = 0u;
    for (;;) {
        sum = 0u; cnt = 0u; mine = 0u;
#pragma unroll
        for (unsigned j = 0; j < 16; ++j) { const unsigned c = xb_ld(&bar[XB_XCNT(j)]); sum += c; cnt += (c > 0u) ? 1u : 0u; mine = (j == x) ? c : mine; }
        if (sum == G) break;
        __builtin_amdgcn_s_sleep(1);
        if ((++sp & 255u) == 0u) { if (xb_ld(&bar[XB_TMO])) break; if (sp > XB_SPIN_CAP) { atomicAdd(&bar[XB_TMO], 1u); break; } }
    }
    nloc = mine > 0u ? mine : 1u; nx = cnt > 0u ? cnt : 1u;
}
__device__ __forceinline__ void xcd_barrier(const XcdBarrier& b) {
    asm volatile("s_waitcnt vmcnt(0)" ::: "memory");
    __syncthreads();
    if (threadIdx.x == 0) {
        unsigned* bar = b.bar;
        __builtin_amdgcn_s_waitcnt(0);
        unsigned nloc = b.st[0], nx = b.st[1];
        if (nloc == 0u) { xcd_barrier_complete(bar, b.x, b.gsize, nloc, nx); b.st[0] = nloc; b.st[1] = nx; }
#if XB_EARLY_WB
        __builtin_amdgcn_fence(__ATOMIC_RELEASE, "agent"); asm volatile("s_waitcnt vmcnt(0)" ::: "memory");
#endif
        const unsigned old = xb_add(&bar[XB_XSUB(b.x)], 1u);
        const unsigned gen = old / nloc;
        if (old + 1u == (gen + 1u) * nloc) {
            __builtin_amdgcn_fence(__ATOMIC_RELEASE, "agent");
            asm volatile("s_waitcnt vmcnt(0)" ::: "memory");
            if (nx > 1u) {
                const unsigned og = xb_add(&bar[XB_TOP], 1u);
                const unsigned tg = og / nx;
                if (og + 1u == (tg + 1u) * nx) xb_add(&bar[XB_TOPGEN], 1u);
                else XB_SPIN(xb_ld(&bar[XB_TOPGEN]) == tg, bar);
            }
            __builtin_amdgcn_fence(__ATOMIC_ACQUIRE, "agent");
            xb_add(&bar[XB_XGEN(b.x)], 1u);
            asm volatile("s_waitcnt vmcnt(0)" ::: "memory");
        } else {
            XB_SPIN(xb_ld(&bar[XB_XGEN(b.x)]) == gen, bar);
            __builtin_amdgcn_fence(__ATOMIC_ACQUIRE, "agent");
            asm volatile("s_waitcnt vmcnt(0)" ::: "memory");
        }
    }
    __syncthreads();
}

struct Frame {
    LAS unsigned char* lds;
    volatile LAS unsigned* MISC;
    gu32* ctl;
    int tid, lane, wave;
    int vcu, G;
    float* out;
    unsigned char* ws;
    float *MOD, *BIAS1, *BIAS2, *SSQ1, *SSQ2;
    bf16 *HA, *XB, *PROJ, *MIX, *HID;
    unsigned long long tacc, tt0;
};
__device__ __forceinline__ const float* inp(const Frame& F, int k) {
    const unsigned long long v = *(const volatile LAS unsigned long long*)(F.lds + PTR_OFF + 8 * k);
    const unsigned lo = __builtin_amdgcn_readfirstlane((unsigned)v), hi = __builtin_amdgcn_readfirstlane((unsigned)(v >> 32));
    return (const float*)(((unsigned long long)hi << 32) | lo);
}
__device__ __forceinline__ bf16* wt_ptr(const Frame& F, int l, size_t off) { return (bf16*)(F.ws + WS_WT + (size_t)l * WT_LAYER + off); }

__device__ __forceinline__ void mod_item(Frame& F, int l, int strip) {
    const int j0 = strip * 256, tid = F.tid, lane = F.lane, wv = F.wave;
    LAS float* cact = (LAS float*)(F.lds);
    LAS float* red = (LAS float*)(F.lds + 32768);
    for (int i = tid; i < 8192; i += NWAVES * 64) { const int b = i >> 10, k = i & 1023; const float v = inp(F, 1)[b * 1024 + k]; cact[k * 8 + b] = v * sigmoidf_(v); }
    __syncthreads();
    {
        const __amdgpu_buffer_rsrc_t rw = __builtin_amdgcn_make_buffer_rsrc((void*)(inp(F, 2) + (size_t)l * 1024 * NMOD), 0, 1024 * NMOD * 4, 0x00020000);
        const int vo = (j0 + 4 * lane) * 4, so0 = 16 * wv * NMOD * 4;
        f32x4 acc[8];
#pragma unroll
        for (int b = 0; b < 8; ++b) acc[b] = (f32x4){0.f, 0.f, 0.f, 0.f};
#pragma unroll 1
        for (int ch = 0; ch < 8; ++ch) {
            f32x4 w[16];
#pragma unroll
            for (int k = 0; k < 16; ++k) { typedef unsigned u4_ __attribute__((ext_vector_type(4))); const u4_ t_ = __builtin_amdgcn_raw_buffer_load_b128(rw, vo, so0 + (ch * 128 + k) * NMOD * 4, 0); w[k] = __builtin_bit_cast(f32x4, t_); }
#pragma unroll
            for (int k = 0; k < 16; ++k) { const LAS f32x4* ca = (const LAS f32x4*)(cact + (ch * 128 + 16 * wv + k) * 8); const f32x4 c0 = ca[0], c1 = ca[1];
                acc[0] += w[k] * c0[0]; acc[1] += w[k] * c0[1]; acc[2] += w[k] * c0[2]; acc[3] += w[k] * c0[3]; acc[4] += w[k] * c1[0]; acc[5] += w[k] * c1[1]; acc[6] += w[k] * c1[2]; acc[7] += w[k] * c1[3]; }
        }
#pragma unroll
        for (int b = 0; b < 8; ++b) *(LAS f32x4*)(red + (wv * 8 + b) * 256 + 4 * lane) = acc[b];
    }
    LDS_WAIT(); __syncthreads();
#pragma unroll
    for (int q = 0; q < 4; ++q) { const int o = tid + 512 * q, b = o >> 8, cc = o & 255; float s = inp(F, 3)[l * NMOD + j0 + cc];
#pragma unroll
        for (int w = 0; w < 8; ++w) s += red[(w * 8 + b) * 256 + cc];
        F.MOD[((size_t)l * 8 + b) * NMOD + j0 + cc] = s; }
    __syncthreads();
}
constexpr int TS = 132;
struct TItem { const float* W; bf16* WT; const float* Wp; const float* psc; int K, N, k0, n0, perm; };
__device__ __forceinline__ int win_perm(int n) {
    if (n >= 768 && n < 1280) { const int g = n >= 1024, c = n - (g ? 1024 : 768); return 768 + (c >> 7) * 256 + g * 128 + (c & 127); }
    if (n >= 1536 && n < 2048) { const int g = n >= 1792, c = n - (g ? 1792 : 1536); return 1536 + (c >> 7) * 256 + g * 128 + (c & 127); }
    return n;
}
__device__ __forceinline__ void titem_load(const Frame& F, const TItem& t, f32x4 (&v)[8]) {
#pragma unroll
    for (int i = 0; i < 8; ++i) v[i] = *(const f32x4*)(t.W + (size_t)(t.k0 + 16 * F.wave + 2 * i + (F.lane >> 5)) * t.N + t.n0 + 4 * (F.lane & 31));
}
__device__ __forceinline__ void titem_process(Frame& F, const TItem& t, const f32x4 (&v)[8], int mode) {
    const int lane = F.lane, wv = F.wave;
    LAS float* tile = (LAS float*)(F.lds);
#pragma unroll
    for (int i = 0; i < 8; ++i) { const int kr = 16 * wv + 2 * i + (lane >> 5); f32x4 x = v[i]; if (t.psc) x = x * t.psc[kr]; if (mode < 3) *(LAS f32x4*)(tile + kr * TS + 4 * (lane & 31)) = x; else asm volatile("" :: "v"(x)); }
    LDS_WAIT(); __syncthreads();
    if (mode >= 2) return;
    if (t.Wp) {
        const int li = lane & 15, lk = lane >> 4;
        f32x4 acc[2][4];
#pragma unroll
        for (int gg = 0; gg < 2; ++gg)
#pragma unroll
            for (int ct = 0; ct < 4; ++ct) acc[gg][ct] = (f32x4){0.f, 0.f, 0.f, 0.f};
#pragma unroll 2
        for (int d0 = 0; d0 < 64; d0 += 4) {
#pragma unroll
            for (int gg = 0; gg < 2; ++gg) { const float bq = tile[(64 * gg + d0 + lk) * TS + 16 * wv + li];
#pragma unroll
                for (int ct = 0; ct < 4; ++ct) { const float a = t.Wp[gg * 4096 + (16 * ct + li) * 64 + d0 + lk]; acc[gg][ct] = __builtin_amdgcn_mfma_f32_16x16x4f32(a, bq, acc[gg][ct], 0, 0, 0); } }
        }
        LDS_WAIT(); __syncthreads();
#pragma unroll
        for (int gg = 0; gg < 2; ++gg)
#pragma unroll
            for (int ct = 0; ct < 4; ++ct)
#pragma unroll
                for (int r = 0; r < 4; ++r) tile[(64 * gg + 16 * ct + 4 * lk + r) * TS + 16 * wv + li] = acc[gg][ct][r];
        LDS_WAIT(); __syncthreads();
    }
    {
        const int n = F.tid & 127, cb = 4 * (F.tid >> 7);
        const int nr = t.perm ? win_perm(t.n0 + n) : t.n0 + n;
#pragma unroll
        for (int j = 0; j < 4; ++j) { const int c = cb + j; const LAS float* s = tile + (8 * c) * TS + n;
            v4u o; o.x = pk2(s[0 * TS], s[1 * TS]); o.y = pk2(s[2 * TS], s[3 * TS]); o.z = pk2(s[4 * TS], s[5 * TS]); o.w = pk2(s[6 * TS], s[7 * TS]);
            if (mode == 0) *(GAS v4u*)(t.WT + (size_t)nr * t.K + t.k0 + 8 * c) = o; else asm volatile("" :: "v"(o)); }
    }
    LDS_WAIT(); __syncthreads();
}
constexpr int TI_IN = (DM / 128) * (NIN / 128), TI_OUT = (DM / 128) * (DM / 128), TI_1 = (DM / 128) * (FF / 128), TI_2 = (FF / 128) * (DM / 128);
__device__ __forceinline__ bool titem_decode(const Frame& F, int it, int L0, int nl, TItem& t) {
    t.Wp = nullptr; t.psc = nullptr; t.perm = 0;
    if (it < 0) return false;
    int r = it;
    if (r < nl * TI_IN) { const int l = L0 + r / TI_IN; r %= TI_IN; t.W = inp(F, 6) + (size_t)l * DM * NIN; t.WT = wt_ptr(F, l, WT_IN); t.K = DM; t.N = NIN; t.k0 = 128 * (r / (NIN / 128)); t.n0 = 128 * (r % (NIN / 128)); t.perm = 1; return true; } r -= nl * TI_IN;
    if (r < nl * TI_OUT) { const int l = L0 + r / TI_OUT; r %= TI_OUT; const int kb = r / 8; t.W = inp(F, 7) + (size_t)l * DM * DM; t.WT = wt_ptr(F, l, WT_OUT); t.K = DM; t.N = DM; t.k0 = 128 * kb; t.n0 = 128 * (r % 8);
        if (kb >= 6) { t.Wp = inp(F, 17) + ((size_t)l * 4 + 2 * (kb - 6)) * 4096; t.psc = inp(F, 18) + l * 256 + 128 * (kb - 6); } return true; } r -= nl * TI_OUT;
    if (r < nl * TI_1) { const int l = L0 + r / TI_1; r %= TI_1; t.W = inp(F, 19) + (size_t)l * DM * FF; t.WT = wt_ptr(F, l, WT_FF1); t.K = DM; t.N = FF; t.k0 = 128 * (r / (FF / 128)); t.n0 = 128 * (r % (FF / 128)); return true; } r -= nl * TI_1;
    if (r < nl * TI_2) { const int l = L0 + r / TI_2; r %= TI_2; t.W = inp(F, 20) + (size_t)l * FF * DM; t.WT = wt_ptr(F, l, WT_FF2); t.K = FF; t.N = DM; t.k0 = 128 * (r / 8); t.n0 = 128 * (r % 8); return true; }
    return false;
}
__device__ __forceinline__ int draw_item(Frame& F, gu32* ctr, int slot) {
    volatile LAS unsigned* box = (volatile LAS unsigned*)(F.lds + LDSCTL_OFF + 64) + slot;
    if (F.tid == 0) *box = __hip_atomic_fetch_add(ctr, 1u, __ATOMIC_RELAXED, __HIP_MEMORY_SCOPE_AGENT);
    LDS_WAIT(); __syncthreads();
    const int it = (int)*box;
    return it;
}
__device__ __forceinline__ void prep_layers(Frame& F, int L0, int nl, int what = 3) {
    constexpr int I_MOD = NMOD / 256;
    gu32* ctr = F.ctl + 2048 + 128 * L0;
    T0(13);
    if (what & 1) {
#pragma unroll 1
        for (int k = 0;; ++k) { const int it = draw_item(F, ctr, k & 1); if (it >= nl * I_MOD) break; mod_item(F, L0 + it / I_MOD, it % I_MOD); }
    }
    T1(13); T0(14);
    if (!(what & 2)) return;
    const int mode = what >> 2;
    TItem cur, nxt; f32x4 v[8], vn[8];
    int k = 0;
    bool have = titem_decode(F, draw_item(F, ctr + 64, 2 + (k++ & 1)), L0, nl, cur);
    if (have) titem_load(F, cur, v);
#pragma unroll 1
    while (have) {
        const bool hn = titem_decode(F, draw_item(F, ctr + 64, 2 + (k++ & 1)), L0, nl, nxt);
        if (hn) titem_load(F, nxt, vn);
        titem_process(F, cur, v, mode);
        cur = nxt; have = hn;
#pragma unroll
        for (int i = 0; i < 8; ++i) v[i] = vn[i];
    }
}
__device__ __forceinline__ void bias_layers(Frame& F, int L0, int nl) {
    const int gw = F.vcu * NWAVES + F.wave, NGW = F.G * NWAVES, lane = F.lane;
    const int ncombo = 2 * nl, combo = gw % ncombo, wsub = gw / ncombo, nsub = NGW / ncombo;
    if (wsub >= nsub) return;
    const int l = L0 + (combo >> 1), kind = combo & 1, N = kind ? FF : NIN;
    const bf16* Wt = wt_ptr(F, l, kind ? WT_FF1 : WT_IN);
    const float* sh = F.MOD + (size_t)l * 8 * NMOD + (kind ? 3072 : 0);
    float* outp = kind ? F.BIAS2 + (size_t)l * 8 * FF : F.BIAS1 + (size_t)l * 8 * NIN;
    f32x4 shr[8][4];
#pragma unroll
    for (int b = 0; b < 8; ++b)
#pragma unroll
        for (int j = 0; j < 4; ++j) shr[b][j] = *(const f32x4*)(sh + (size_t)b * NMOD + 16 * lane + 4 * j);
#pragma unroll 1
    for (int n0 = wsub; n0 < N; n0 += 4 * nsub) {
        v4u w0[4], w1[4];
#pragma unroll
        for (int q = 0; q < 4; ++q) { const int n = (n0 + q * nsub < N) ? n0 + q * nsub : n0; w0[q] = *(const v4u*)(Wt + (size_t)n * DM + 16 * lane); w1[q] = *(const v4u*)(Wt + (size_t)n * DM + 16 * lane + 8); }
#pragma unroll
        for (int q = 0; q < 4; ++q) { const int n = n0 + q * nsub;
            const f32x4 wv0 = (f32x4){bflo(w0[q].x), bfhi(w0[q].x), bflo(w0[q].y), bfhi(w0[q].y)}, wv1 = (f32x4){bflo(w0[q].z), bfhi(w0[q].z), bflo(w0[q].w), bfhi(w0[q].w)};
            const f32x4 wv2 = (f32x4){bflo(w1[q].x), bfhi(w1[q].x), bflo(w1[q].y), bfhi(w1[q].y)}, wv3 = (f32x4){bflo(w1[q].z), bfhi(w1[q].z), bflo(w1[q].w), bfhi(w1[q].w)};
            float a[8];
#pragma unroll
            for (int b = 0; b < 8; ++b) { const f32x4 t = shr[b][0] * wv0 + shr[b][1] * wv1 + shr[b][2] * wv2 + shr[b][3] * wv3; a[b] = wave_sum((t[0] + t[1]) + (t[2] + t[3])); }
            if (lane == 0 && n < N) {
#pragma unroll
                for (int b = 0; b < 8; ++b) outp[(size_t)b * N + n] = a[b]; } }
    }
}
__device__ __forceinline__ void p0b(Frame& F) {
    bias_layers(F, 0, PREP_UPFRONT ? DEPTH : 1);
    const int gw = F.vcu * NWAVES + F.wave, NGW = F.G * NWAVES, lane = F.lane;
    for (int m0 = gw; m0 < M; m0 += 4 * NGW) {
        f32x4 v[4][4];
#pragma unroll
        for (int q = 0; q < 4; ++q) { const int mr = (m0 + q * NGW < M) ? m0 + q * NGW : m0; const GAS f32x4* xr = (const GAS f32x4*)(inp(F, 0) + (size_t)mr * DM) + lane;
#pragma unroll
            for (int j = 0; j < 4; ++j) v[q][j] = xr[64 * j]; }
#pragma unroll
        for (int q = 0; q < 4; ++q) { const int m = m0 + q * NGW, b = m >> 11; if (m >= M) break;
            const f32x4* gr = (const f32x4*)(inp(F, 4)) + lane; const f32x4* sr = (const f32x4*)(F.MOD + (size_t)b * NMOD + 1024) + lane;
            float ss = 0.f; GAS v2u* o8 = (GAS v2u*)(F.HA + (size_t)m * DM) + lane;
#pragma unroll
            for (int j = 0; j < 4; ++j) { const f32x4 vv = v[q][j]; ss += (vv[0] * vv[0] + vv[1] * vv[1]) + (vv[2] * vv[2] + vv[3] * vv[3]);
                const f32x4 h = vv * gr[64 * j] * (sr[64 * j] + 1.0f); v2u w; w.x = pk2(h[0], h[1]); w.y = pk2(h[2], h[3]); o8[64 * j] = w; }
            ss = wave_sum(ss);
            if (lane < 16) F.SSQ1[(size_t)lane * M + m] = lane == 0 ? ss : 0.f; }
    }
}
__device__ __forceinline__ void rstd_table(Frame& F, const pg8::StaticOrder& S, const float* ssq) {
    LAS float* tab = (LAS float*)(F.lds + RT_OFF);
    pg8::Unit u;
    for (int ui = 0; ui < 8 && S.next(ui, u); ++ui) {
        if (F.tid < 256) { const int row = u.pm * 256 + F.tid; float s = 0.f;
#pragma unroll
            for (int p = 0; p < 16; ++p) s += ssq[(size_t)p * M + row];
            tab[ui * 256 + F.tid] = __builtin_amdgcn_rsqf(s * (1.0f / DM) + EPS); }
    }
    LDS_WAIT(); __syncthreads();
}

__device__ __forceinline__ s16x4 vtr(const LAS unsigned char* p) { typedef short v4i16_t __attribute__((ext_vector_type(4))); return __builtin_bit_cast(s16x4, __builtin_amdgcn_ds_read_tr16_b64_v4i16((LAS v4i16_t*)p)); }
__device__ __forceinline__ void glds16(const void* gsrc, LAS unsigned char* dst) { __builtin_amdgcn_global_load_lds((const unsigned*)gsrc, (LAS unsigned*)dst, 16, 0, 0); }
__device__ __forceinline__ void attn_qk(f32x4 (&s)[2][4], const LAS unsigned char* kb_, bf16x8 q0, bf16x8 q1, f32x4 negM) {
    bf16x8 kf[8];
#pragma unroll
    for (int kb = 0; kb < 4; ++kb) { kf[2 * kb] = *(const LAS bf16x8*)(kb_ + kb * 256); kf[2 * kb + 1] = *(const LAS bf16x8*)(kb_ + 4096 + kb * 256); }
    asm volatile("s_waitcnt lgkmcnt(0)" : "+v"(kf[0]), "+v"(kf[1]), "+v"(kf[2]), "+v"(kf[3]), "+v"(kf[4]), "+v"(kf[5]), "+v"(kf[6]), "+v"(kf[7]) :: "memory");
    __builtin_amdgcn_sched_barrier(0);
#pragma unroll
    for (int kb = 0; kb < 4; ++kb) { s[0][kb] = __builtin_amdgcn_mfma_f32_16x16x32_bf16(kf[2 * kb], q0, negM, 0, 0, 0); s[1][kb] = __builtin_amdgcn_mfma_f32_16x16x32_bf16(kf[2 * kb + 1], q1, negM, 0, 0, 0); }
}
__device__ __forceinline__ void attn_exp(f32x4 (&s)[2][4], bf16x8 (&pw)[2][2], bool band, int key0, int qrow) {
    if (band) {
#pragma unroll
        for (int kb = 0; kb < 4; ++kb)
#pragma unroll
            for (int r = 0; r < 4; ++r) { const int key = key0 + 16 * kb + r; if (key > qrow) { s[0][kb][r] = -INFINITY; s[1][kb][r] = -INFINITY; } }
    }
#pragma unroll
    for (int kb = 0; kb < 4; ++kb)
#pragma unroll
        for (int r = 0; r < 4; ++r) { s[0][kb][r] = __builtin_amdgcn_exp2f(s[0][kb][r]); s[1][kb][r] = __builtin_amdgcn_exp2f(s[1][kb][r]); }
#pragma unroll
    for (int m = 0; m < 2; ++m)
#pragma unroll
        for (int ks = 0; ks < 2; ++ks) { v4u w; w.x = pg8::cvt_pk_bf16(s[m][2 * ks][0], s[m][2 * ks][1]); w.y = pg8::cvt_pk_bf16(s[m][2 * ks][2], s[m][2 * ks][3]);
            w.z = pg8::cvt_pk_bf16(s[m][2 * ks + 1][0], s[m][2 * ks + 1][1]); w.w = pg8::cvt_pk_bf16(s[m][2 * ks + 1][2], s[m][2 * ks + 1][3]); pw[m][ks] = __builtin_bit_cast(bf16x8, w); }
}
__device__ __forceinline__ void attn_pv(const bf16x8 (&pw)[2][2], f32x4 (&o)[2][4], f32x4 (&ol)[2], const LAS unsigned char* vb_, int vE, int vO) {
    const bf16x8 ones = (bf16x8){0x3F80, 0x3F80, 0x3F80, 0x3F80, 0x3F80, 0x3F80, 0x3F80, 0x3F80};
    const unsigned va0 = (unsigned)(size_t)(vb_ + vE), va1 = (unsigned)(size_t)(vb_ + vO);
    s16x4 lo[8], hi[8];
#define ATT_TR(dst, addr, off) asm volatile("ds_read_b64_tr_b16 %0, %1 offset:%c2" : "=&v"(dst) : "v"(addr), "i"(off) : "memory")
    ATT_TR(lo[0], va0, 0); ATT_TR(hi[0], va0, 1024); ATT_TR(lo[1], va1, 0); ATT_TR(hi[1], va1, 1024);
    ATT_TR(lo[2], va0, 4096); ATT_TR(hi[2], va0, 4096 + 1024); ATT_TR(lo[3], va1, 4096); ATT_TR(hi[3], va1, 4096 + 1024);
    ATT_TR(lo[4], va0, 2048); ATT_TR(hi[4], va0, 2048 + 1024); ATT_TR(lo[5], va1, 2048); ATT_TR(hi[5], va1, 2048 + 1024);
    ATT_TR(lo[6], va0, 4096 + 2048); ATT_TR(hi[6], va0, 4096 + 2048 + 1024); ATT_TR(lo[7], va1, 4096 + 2048); ATT_TR(hi[7], va1, 4096 + 2048 + 1024);
#undef ATT_TR
    asm volatile("s_waitcnt lgkmcnt(0)" : "+v"(lo[0]), "+v"(hi[0]), "+v"(lo[1]), "+v"(hi[1]), "+v"(lo[2]), "+v"(hi[2]), "+v"(lo[3]), "+v"(hi[3]), "+v"(lo[4]), "+v"(hi[4]), "+v"(lo[5]), "+v"(hi[5]), "+v"(lo[6]), "+v"(hi[6]), "+v"(lo[7]), "+v"(hi[7]) :: "memory");
    __builtin_amdgcn_sched_barrier(0);
#pragma unroll
    for (int ks = 0; ks < 2; ++ks) {
#pragma unroll
        for (int d0 = 0; d0 < 4; ++d0) { const int i = 4 * ks + d0;
            const bf16x8 vf = (bf16x8){lo[i][0], lo[i][1], lo[i][2], lo[i][3], hi[i][0], hi[i][1], hi[i][2], hi[i][3]};
            o[0][d0] = __builtin_amdgcn_mfma_f32_16x16x32_bf16(pw[0][ks], vf, o[0][d0], 0, 0, 0);
            o[1][d0] = __builtin_amdgcn_mfma_f32_16x16x32_bf16(pw[1][ks], vf, o[1][d0], 0, 0, 0); }
        ol[0] = __builtin_amdgcn_mfma_f32_16x16x32_bf16(pw[0][ks], ones, ol[0], 0, 0, 0);
        ol[1] = __builtin_amdgcn_mfma_f32_16x16x32_bf16(pw[1][ks], ones, ol[1], 0, 0, 0); }
}
__device__ __forceinline__ void attn_epilogue(Frame& F, const f32x4 (&o)[2][4], const f32x4 (&ol)[2], const float (&sgv)[4], float lam, bf16* op) {
    const int lane = F.lane;
#pragma unroll
    for (int r = 0; r < 4; ++r) {
        const float a0 = 1.0f / ol[0][r], a1 = lam / ol[1][r];
        float ov[4], ss = 0.f;
#pragma unroll
        for (int d0 = 0; d0 < 4; ++d0) { ov[d0] = o[0][d0][r] * a0 - o[1][d0][r] * a1; ss += ov[d0] * ov[d0]; }
        ss += __shfl_xor(ss, 1); ss += __shfl_xor(ss, 2); ss += __shfl_xor(ss, 4); ss += __shfl_xor(ss, 8);
        const float rn = __builtin_amdgcn_rsqf(ss * (1.0f / 64.0f) + EPS);
#pragma unroll
        for (int d0 = 0; d0 < 4; ++d0) op[(size_t)r * DM + 16 * d0] = (bf16)f2bf(ov[d0] * rn * sgv[d0]);
    }
    (void)lane;
}
__device__ __forceinline__ void attn_pair(Frame& F, int l, int b, int h, int sidx, int mode = 0) {
    const int lane = F.lane, wid = F.wave, fr = lane & 15, fq = lane >> 4;
    LAS unsigned char* lds = F.lds;
    const size_t rowbase = 0;
    const bf16* proj = F.PROJ + (size_t)b * (ACT_BSTRIDE / 2);
    bf16* mixb = F.MIX + (size_t)b * (ACT_BSTRIDE / 2);
    const int qbA = 15 - sidx, qbB = sidx, NTa = 2 * (qbA + 1), NTb = 2 * (qbB + 1), S = NTa + NTb;
    const bf16* qpA = proj + (rowbase + qbA * 128 + 16 * wid + fr) * NIN + h * 64 + 8 * fq;
    const bf16* qpB = proj + (rowbase + qbB * 128 + 16 * wid + fr) * NIN + h * 64 + 8 * fq;
    const bf16x8 qa0 = *(const bf16x8*)qpA, qa1 = *(const bf16x8*)(qpA + 32), qb0 = *(const bf16x8*)qpB, qb1 = *(const bf16x8*)(qpB + 32);
    const bf16* ksrc = proj + (rowbase + lane) * NIN + 256 + h * 64 + wid * 8;
    const bf16* vsrc = proj + (rowbase + 16 * (wid & 3) + (lane >> 2)) * NIN + 512 + h * 64 + (wid >> 2) * 32 + 8 * ((lane & 3) ^ (2 * ((lane >> 4) & 1)));
    LAS unsigned char* kdst = lds + wid * 1024;
    LAS unsigned char* vdst = lds + 65536 + wid * 1024;
    f32x4 o[2][4], ol[2];
#pragma unroll
    for (int m = 0; m < 2; ++m) { ol[m] = (f32x4){0.f, 0.f, 0.f, 0.f};
#pragma unroll
        for (int d = 0; d < 4; ++d) o[m][d] = (f32x4){0.f, 0.f, 0.f, 0.f}; }
    const int koff = fq * 1024 + fr * 16;
    const int prow = fr >> 2, pp = fr & 3;
    const int vrow = (4 * fq + prow) * 64 + (pp & 1) * 8 + (pp >> 1) * 16;
    const int vE = vrow + 32 * (fq & 1), vO = vrow + 32 * (1 - (fq & 1));
#define ATT_TILE(s) ((s) < NTa ? (s) : (s) - NTa)
#define ATT_SRC(s) ((size_t)ATT_TILE((s) < S ? (s) : S - 1) * 64 * NIN)
#define ATT_BAR(N) do { __builtin_amdgcn_sched_barrier(0); asm volatile("s_waitcnt vmcnt(" #N ") lgkmcnt(0)" ::: "memory"); __builtin_amdgcn_s_barrier(); asm volatile("" ::: "memory"); __builtin_amdgcn_sched_barrier(0); } while (0)
#define ATT_BARL() do { asm volatile("s_waitcnt lgkmcnt(0)" ::: "memory"); __builtin_amdgcn_s_barrier(); asm volatile("" ::: "memory"); } while (0)
    T0(10);
    glds16(ksrc + ATT_SRC(0), kdst);
    glds16(ksrc + ATT_SRC(1), kdst + 8192); glds16(vsrc + ATT_SRC(0), vdst);
    glds16(ksrc + ATT_SRC(2), kdst + 2 * 8192); glds16(vsrc + ATT_SRC(1), vdst + 8192);
    glds16(ksrc + ATT_SRC(3), kdst + 3 * 8192); glds16(vsrc + ATT_SRC(2), vdst + 2 * 8192);
    float lam, negMv, sgv[4];
    { const float* lp = inp(F, 10) + l * 128;
      float pa = lane < 32 ? lp[lane] * lp[32 + lane] : 0.f, pb = lane < 32 ? lp[64 + lane] * lp[96 + lane] : 0.f;
      pa = wave_sum(pa); pb = wave_sum(pb);
      const float lam_init = 0.8f - 0.6f * __expf(-0.3f * (float)l);
      lam = __expf(pa) - __expf(pb) + lam_init;
      const float gq = wave_max(fabsf(inp(F, 8)[l * 32 + (lane & 31)])), gk = wave_max(fabsf(inp(F, 9)[l * 32 + (lane & 31)]));
      negMv = -(QSCALE * 32.0f * gq * gk);
#pragma unroll
      for (int d0 = 0; d0 < 4; ++d0) sgv[d0] = inp(F, 11)[l * 64 + 16 * d0 + fr] * (1.0f - lam_init); }
    const f32x4 negM = (f32x4){negMv, negMv, negMv, negMv};
    ATT_BAR(0);
    f32x4 sA[2][4], sB[2][4]; bf16x8 pw[2][2];
#pragma unroll
    for (int m = 0; m < 2; ++m) { pw[m][0] = (bf16x8){0, 0, 0, 0, 0, 0, 0, 0}; pw[m][1] = pw[m][0]; sB[m][0] = negM; sB[m][1] = negM; sB[m][2] = negM; sB[m][3] = negM; }
    attn_qk(sA, lds + koff, qa0, qa1, negM);
    const bool late = wid >= 4;
    T1(10); T0(11);
#define ATT_A(s, CUR, NXT) do { \
        if (!(mode & 1)) { glds16(ksrc + ATT_SRC((s) + 4), kdst + (((s) + 4) & 7) * 8192); glds16(vsrc + ATT_SRC((s) + 3), vdst + (((s) + 3) & 7) * 8192); } \
        if ((s) + 1 < S && !(mode & 8)) { const bool nb_ = ((s) + 1 >= NTa); attn_qk(NXT, lds + (((s) + 1) & 7) * 8192 + koff, nb_ ? qb0 : qa0, nb_ ? qb1 : qa1, negM); } \
        { const bool inB_ = (s) >= NTa; const int tile_ = ATT_TILE(s), NTu_ = inB_ ? NTb : NTa, q0_ = (inB_ ? qbB : qbA) * 128; \
          if (!(mode & 2)) attn_exp(CUR, pw, tile_ >= NTu_ - 2, 64 * tile_ + 4 * fq, q0_ + 16 * wid + fr); } \
    } while (0)
#define ATT_B(s) do { \
        const bool inB_ = (s) >= NTa; const int tile_ = ATT_TILE(s), NTu_ = inB_ ? NTb : NTa, q0_ = (inB_ ? qbB : qbA) * 128; \
        if (!(mode & 4)) attn_pv(pw, o, ol, lds + 65536 + ((s) & 7) * 8192, vE, vO); \
        if (tile_ == NTu_ - 1) { attn_epilogue(F, o, ol, sgv, lam, mixb + (rowbase + q0_ + 16 * wid + 4 * fq) * DM + h * 64 + fr); \
            asm volatile("s_waitcnt vmcnt(0)" ::: "memory");      \
            _Pragma("unroll") for (int m_ = 0; m_ < 2; ++m_) { ol[m_] = (f32x4){0.f, 0.f, 0.f, 0.f}; _Pragma("unroll") for (int d_ = 0; d_ < 4; ++d_) o[m_][d_] = (f32x4){0.f, 0.f, 0.f, 0.f}; } } \
    } while (0)
#ifndef ATT_STAGGER
#define ATT_STAGGER 0
#endif
#if ATT_STAGGER
#define ATT_STEP(s, CUR, NXT) do { ATT_BAR(4); ATT_A(s, CUR, NXT); ATT_BAR(4); ATT_B(s); } while (0)
    if (late) ATT_BAR(4);
#else
#define ATT_STEP(s, CUR, NXT) do { ATT_BAR(4); ATT_A(s, CUR, NXT); ATT_B(s); } while (0)
#endif
#pragma unroll 1
    for (int s = 0; s < S; s += 2) { ATT_STEP(s, sA, sB); ATT_STEP(s + 1, sB, sA); }
#if ATT_STAGGER
    if (!late) ATT_BAR(4);
#endif
    (void)late;
    T1(11); T0(12);
#undef ATT_STEP
#undef ATT_A
#undef ATT_B
#undef ATT_TILE
#undef ATT_SRC
    ATT_BAR(0);
    T1(12);
#undef ATT_BAR
#undef ATT_BARL
}
__device__ __forceinline__ void attn_phase(Frame& F, int l, int mode = 0) {
    for (int pi = F.vcu; pi < 256; pi += F.G) {
        const int bh = pi >> 3, s = pi & 7;
        attn_pair(F, l, bh >> 2, bh & 3, s, mode);
    }
}
__device__ __forceinline__ unsigned bld(__amdgpu_buffer_rsrc_t r, int voff, int soff) { return __builtin_amdgcn_raw_buffer_load_b32(r, voff, soff, 0); }
__device__ __forceinline__ f32x2 bld2(__amdgpu_buffer_rsrc_t r, int voff, int soff) { typedef unsigned u2 __attribute__((ext_vector_type(2))); const u2 v = __builtin_amdgcn_raw_buffer_load_b64(r, voff, soff, 0); return __builtin_bit_cast(f32x2, v); }
__device__ __forceinline__ void mixer_tile(Frame& F, int l, int tt) {
    const int tid = F.tid, lane = F.lane; const int b = tt >> 5, s0 = (tt & 31) * 64; const int rowbase = 0;
    LAS float* cbuf = (LAS float*)F.lds;
    const int c2 = (tid & 127) * 2, tq = F.wave >> 1, sb = s0 + 16 * tq;
    bf16* projb = F.PROJ + (size_t)b * (ACT_BSTRIDE / 2); bf16* mixb = F.MIX + (size_t)b * (ACT_BSTRIDE / 2);
    const __amdgpu_buffer_rsrc_t rp = __builtin_amdgcn_make_buffer_rsrc((void*)projb, 0, (int)((size_t)SEQ * NIN * 2), 0x00020000);
    const __amdgpu_buffer_rsrc_t rm = __builtin_amdgcn_make_buffer_rsrc((void*)mixb, 0, (int)((size_t)SEQ * DM * 2), 0x00020000);
    const int vo = c2 * 2;
    unsigned hr[46];
    {
        unsigned prr[18], bgr[16], udr[31];
#pragma unroll
        for (int j = 0; j < 18; ++j) { const int s = sb - 2 + j, sc = s < 0 ? 0 : s; prr[j] = bld(rp, vo, (rowbase + sc) * (NIN * 2) + 1536 * 2); }
#pragma unroll
        for (int j = 0; j < 16; ++j) bgr[j] = bld(rp, vo, (rowbase + sb + j) * (NIN * 2) + 1280 * 2);
#pragma unroll
        for (int j = 0; j < 31; ++j) { const int s = sb - 15 + j, sc = s < 0 ? 0 : s; udr[j] = bld(rp, vo, (rowbase + sc) * (NIN * 2) + 2048 * 2); }
#pragma unroll
        for (int j = 0; j < 46; ++j) { const int s = sb - 30 + j, sc = s < 0 ? 0 : s; hr[j] = bld(rp, vo, (rowbase + sc) * (NIN * 2) + 768 * 2); }
        const __amdgpu_buffer_rsrc_t rw = __builtin_amdgcn_make_buffer_rsrc((void*)(inp(F, 16) + (size_t)l * 3 * 256), 0, 3 * 256 * 4, 0x00020000);
        f32x2 w3[3];
#pragma unroll
        for (int k = 0; k < 3; ++k) w3[k] = bld2(rw, c2 * 4, k * 1024);
        f32x2 pr[18];
#pragma unroll
        for (int j = 0; j < 18; ++j) { const float ok = (sb - 2 + j) >= 0 ? 1.f : 0.f; pr[j] = (f32x2){bflo(prr[j]) * ok, bfhi(prr[j]) * ok}; }
#pragma unroll
        for (int i = 0; i < 16; ++i) { const f32x2 cv = w3[0] * pr[i] + w3[1] * pr[i + 1] + w3[2] * pr[i + 2];
            __builtin_amdgcn_raw_buffer_store_b32(pk2(bflo(bgr[i]) * cv[0], bfhi(bgr[i]) * cv[1]), rm, vo, (rowbase + sb + i) * (DM * 2) + 512 * 2, 0); }
        const int grp = c2 >> 6;
        const float m1 = grp >= 1 ? 1.f : 0.f, m2 = grp >= 2 ? 1.f : 0.f, m3 = grp >= 3 ? 1.f : 0.f;
        f32x2 t[31], ut[16];
#pragma unroll
        for (int j = 0; j < 31; ++j) { const float ok = (sb - 15 + j) >= 0 ? 1.f : 0.f; t[j] = (f32x2){bflo(udr[j]) * ok, bfhi(udr[j]) * ok}; }
#pragma unroll
        for (int i = 0; i < 16; ++i) ut[i] = t[15 + i];
#pragma unroll
        for (int j = 30; j >= 1; --j) t[j] += t[j - 1];
#pragma unroll
        for (int j = 30; j >= 3; --j) t[j] += t[j - 2] * m1;
#pragma unroll
        for (int j = 30; j >= 7; --j) t[j] += t[j - 4] * m2;
#pragma unroll
        for (int j = 30; j >= 15; --j) t[j] += t[j - 8] * m3;
#pragma unroll
        for (int i = 0; i < 16; ++i) { const int win = 2 << grp, s = sb + i; const float rc = 1.0f / (float)((s + 1 < win) ? (s + 1) : win); const f32x2 y = t[15 + i] * rc - ut[i];
            __builtin_amdgcn_raw_buffer_store_b32(pk2(y[0], y[1]), rm, vo, (rowbase + s) * (DM * 2) + 768 * 2, 0); }
    }
    {
        const __amdgpu_buffer_rsrc_t rw = __builtin_amdgcn_make_buffer_rsrc((void*)(inp(F, 12) + (size_t)l * 31 * 256), 0, 31 * 256 * 4, 0x00020000);
        f32x2 w[31];
#pragma unroll
        for (int k = 0; k < 31; ++k) w[k] = bld2(rw, c2 * 4, k * 1024);
        f32x2 acc[16];
        const f32x2 bias = *(const f32x2*)(inp(F, 13) + l * 256 + c2);
#pragma unroll
        for (int i = 0; i < 16; ++i) acc[i] = bias;
#pragma unroll
        for (int j = 0; j < 46; ++j) { const float ok = (sb - 30 + j) >= 0 ? 1.f : 0.f;
            const f32x2 hv = (f32x2){bflo(hr[j]) * ok, bfhi(hr[j]) * ok};
#pragma unroll
            for (int i = 0; i < 16; ++i) { if (j - i >= 0 && j - i <= 30) acc[i] += w[j - i] * hv; } }
#pragma unroll
        for (int i = 0; i < 16; ++i) *(LAS f32x2*)(cbuf + (16 * tq + i) * 256 + c2) = acc[i];
    }
    LDS_WAIT(); __syncthreads();
    {
        const f32x4 g = *(const f32x4*)(inp(F, 14) + l * 256 + 4 * lane), bb = *(const f32x4*)(inp(F, 15) + l * 256 + 4 * lane);
#pragma unroll 2
        for (int i = 0; i < 8; ++i) { const int t = 8 * F.wave + i; const f32x4 v = *(const LAS f32x4*)(cbuf + t * 256 + 4 * lane);
            const float mu = wave_sum((v[0] + v[1]) + (v[2] + v[3])) * (1.0f / 256.0f); const f32x4 d = v - mu;
            const float var = wave_sum((d[0] * d[0] + d[1] * d[1]) + (d[2] * d[2] + d[3] * d[3])) * (1.0f / 256.0f);
            const float rs = __builtin_amdgcn_rsqf(var + EPS); f32x4 y = d * rs * g + bb;
            y[0] *= sigmoidf_(y[0]); y[1] *= sigmoidf_(y[1]); y[2] *= sigmoidf_(y[2]); y[3] *= sigmoidf_(y[3]);
            v2u w; w.x = pk2(y[0], y[1]); w.y = pk2(y[2], y[3]);
            *(v2u*)(mixb + ((size_t)rowbase + s0 + t) * DM + 256 + 4 * lane) = w; }
    }
    __syncthreads();
}

struct Args { const float* in[21]; float* out; unsigned char* ws; int ph_lo, ph_hi, li, pad; };
__global__ void __launch_bounds__(NWAVES * 64, 2) trunk_fwd(Args args) {
    extern __shared__ __attribute__((aligned(16))) unsigned char lds[];
    Frame F;
    F.lds = (LAS unsigned char*)lds;
    F.MISC = (volatile LAS unsigned*)(F.lds + MISC_OFF);
    F.tid = threadIdx.x; F.lane = F.tid & 63; F.wave = __builtin_amdgcn_readfirstlane(F.tid >> 6);
    const int wave0 = F.wave;
    F.G = gridDim.x; { const int bx = blockIdx.x; F.vcu = (F.G % 8 == 0) ? (bx % 8) * (F.G / 8) + bx / 8 : bx; }
    unsigned char* ws = args.ws; F.ws = ws;
    F.ctl = (gu32*)(ws + WS_CTL);
    F.out = args.out;
    F.MOD = (float*)(ws + WS_MOD); F.BIAS1 = (float*)(ws + WS_BIAS1); F.BIAS2 = (float*)(ws + WS_BIAS2); F.SSQ1 = (float*)(ws + WS_SSQ1); F.SSQ2 = (float*)(ws + WS_SSQ2);
    F.HA = (bf16*)(ws + WS_HA); F.XB = (bf16*)(ws + WS_XB); F.PROJ = (bf16*)(ws + WS_PROJ); F.MIX = (bf16*)(ws + WS_MIX); F.HID = (bf16*)(ws + WS_HID);
    for (int u = F.tid; u < (LDS_BYTES - LDSCTL_OFF) / 4; u += NWAVES * 64) ((LAS unsigned*)(F.lds + LDSCTL_OFF))[u] = 0u;
    __syncthreads();
    if (F.tid == 0) {
#pragma unroll
        for (int k = 0; k < 21; ++k) *(LAS unsigned long long*)(F.lds + PTR_OFF + 8 * k) = (unsigned long long)args.in[k]; }
    __syncthreads();
    XcdBarrier bar; bar.bar = (unsigned*)(F.ctl + CW_BAR); bar.x = 0; bar.st = nullptr; bar.gsize = 0;
    if (!MK_PER_PHASE) bar = xcd_barrier_post((unsigned*)(F.ctl + CW_BAR), F.MISC + 8, (unsigned)F.G);
    const bool grp = !MK_PER_PHASE && F.G == 256;
    XcdBarrier gbar = bar;
    if (grp) gbar = xcd_barrier_post((unsigned*)(F.ctl + CW_BAR) + (1 + (blockIdx.x & 7)) * XCD_BAR_WORDS, F.MISC + 10, (unsigned)(F.G / 8));
    const int lo = args.ph_lo, hi = args.ph_hi;
    F.tacc = 0ull; F.tt0 = 0ull;
#define IN(k) (lo <= (k) && (k) < hi)
#define SEAM(k) do { if (IN((k) + 1)) { if ((k) >= 2 && grp) xcd_barrier(gbar); else xcd_barrier(bar); } } while (0)
#define SEAMT(k, kind) do { T0((kind) + 16); SEAM(k); T1((kind) + 16); } while (0)

#ifndef PROBE_DUP
#define PROBE_DUP 0
#endif
#ifndef PROBE_N
#define PROBE_N 2
#endif
#define REPS(k) (((PROBE_DUP >> (k)) & 1) ? PROBE_N : 1)
    if (IN(0)) { T0(1); for (int rep = 0; rep < REPS(0); ++rep) { if (rep) xcd_barrier(bar);
        prep_layers(F, 0, PREP_UPFRONT ? DEPTH : 1, rep ? ((PROBE_DUP >> 8) & 15) : 3); } T1(1); SEAMT(0, 1); }
    if (IN(1)) { T0(2); for (int rep = 0; rep < REPS(1); ++rep) { if (rep) xcd_barrier(bar); p0b(F); } T1(2); SEAMT(1, 2); }
#pragma unroll 1
    for (int l = 0; l < DEPTH; ++l) {
        const int p = 2 + 5 * l;
        { int tl; asm volatile("v_mbcnt_lo_u32_b32 %0, -1, 0\n\tv_mbcnt_hi_u32_b32 %0, -1, %0\n\tv_lshl_or_b32 %0, %1, 6, %0" : "=&v"(tl) : "s"(wave0)); F.tid = tl; F.lane = tl & 63; F.wave = __builtin_amdgcn_readfirstlane(tl >> 6); }
        int bxl = blockIdx.x; asm volatile("" : "+s"(bxl));
        const float* modl = F.MOD + (size_t)l * 8 * NMOD;
        if (IN(p)) {
            T0(3);
            for (int rep = 0; rep < REPS(2); ++rep) { if (rep) { xcd_barrier(bar); int tl; asm volatile("v_mbcnt_lo_u32_b32 %0, -1, 0\n\tv_mbcnt_hi_u32_b32 %0, -1, %0\n\tv_lshl_or_b32 %0, %1, 6, %0" : "=&v"(tl) : "s"(wave0)); F.tid = tl; F.lane = tl & 63; F.wave = __builtin_amdgcn_readfirstlane(tl >> 6); asm volatile("" : "+s"(bxl)); }
            pg8::Gemm g{F.HA, wt_ptr(F, l, WT_IN), M, NIN, DM, 0}; pg8::StaticOrder S; S.init(M, NIN, F.G, bxl);
            rstd_table(F, S, F.SSQ1);
            pg8::EpiProj E{F.PROJ, F.BIAS1 + (size_t)l * 8 * NIN, (const LAS float*)(F.lds + RT_OFF), inp(F, 8) + l * 32, inp(F, 9) + l * 32, QSCALE, ACT_BSTRIDE / 2};
            pg8::gemm_phase<pg8::EpiProj, pg8::StaticOrder, true, true>(F.lds + RING_OFF, g, S, E, F.tid);
            }
            if (!PREP_UPFRONT && l + 1 < DEPTH) {
                { int tl; asm volatile("v_mbcnt_lo_u32_b32 %0, -1, 0\n\tv_mbcnt_hi_u32_b32 %0, -1, %0\n\tv_lshl_or_b32 %0, %1, 6, %0" : "=&v"(tl) : "s"(wave0)); F.tid = tl; F.lane = tl & 63; F.wave = __builtin_amdgcn_readfirstlane(tl >> 6); }
                prep_layers(F, l + 1, 1); }
            T1(3); SEAMT(p, 3);
        }
        if (IN(p + 1)) {
            T0(4);
            for (int rep = 0; rep < REPS(3); ++rep) { if (rep) xcd_barrier(bar); attn_phase(F, l, rep + 1 < REPS(3) ? ((PROBE_DUP >> 12) & 15) : 0); }
            T1(4); T0(5);
            for (int rep = 0; rep < REPS(4); ++rep) { if (rep) xcd_barrier(bar); for (int tt = F.vcu; tt < 256; tt += F.G) mixer_tile(F, l, tt); }
            if (!PREP_UPFRONT && l + 1 < DEPTH) bias_layers(F, l + 1, 1);
            T1(5); SEAMT(p + 1, 5);
        }
        if (IN(p + 2)) {
            T0(6);
            for (int rep = 0; rep < REPS(5); ++rep) { if (rep) { xcd_barrier(bar); int tl; asm volatile("v_mbcnt_lo_u32_b32 %0, -1, 0\n\tv_mbcnt_hi_u32_b32 %0, -1, %0\n\tv_lshl_or_b32 %0, %1, 6, %0" : "=&v"(tl) : "s"(wave0)); F.tid = tl; F.lane = tl & 63; F.wave = __builtin_amdgcn_readfirstlane(tl >> 6); asm volatile("" : "+s"(bxl)); }
            pg8::Gemm g{F.MIX, wt_ptr(F, l, WT_OUT), M, DM, DM, ACT_BSTRIDE - (size_t)SEQ * DM * 2}; pg8::StaticOrder S; S.init(M, DM, F.G, bxl);
            pg8::EpiRes E{(l == 0 || rep) ? inp(F, 0) : nullptr, F.XB, nullptr, rep ? F.PROJ : F.XB, modl + 2048, modl + 4096, inp(F, 5) + l * DM, rep ? (bf16*)((unsigned char*)F.PROJ + 32 * MiB) : F.HA, rep ? (float*)((unsigned char*)F.PROJ + 64 * MiB) : F.SSQ2, 1};
            pg8::gemm_phase<pg8::EpiRes, pg8::StaticOrder, true, true>(F.lds + RING_OFF, g, S, E, F.tid); }
            T1(6); SEAMT(p + 2, 6);
        }
        if (IN(p + 3)) {
            T0(7);
            for (int rep = 0; rep < REPS(6); ++rep) { if (rep) { xcd_barrier(bar); int tl; asm volatile("v_mbcnt_lo_u32_b32 %0, -1, 0\n\tv_mbcnt_hi_u32_b32 %0, -1, %0\n\tv_lshl_or_b32 %0, %1, 6, %0" : "=&v"(tl) : "s"(wave0)); F.tid = tl; F.lane = tl & 63; F.wave = __builtin_amdgcn_readfirstlane(tl >> 6); asm volatile("" : "+s"(bxl)); }
            pg8::Gemm g{F.HA, wt_ptr(F, l, WT_FF1), M, FF, DM, 0}; pg8::StaticOrder S; S.init(M, FF, F.G, bxl);
            rstd_table(F, S, F.SSQ2);
            pg8::EpiFF1 E{F.HID, F.BIAS2 + (size_t)l * 8 * FF, (const LAS float*)(F.lds + RT_OFF)};
            pg8::gemm_phase<pg8::EpiFF1, pg8::StaticOrder, true, true>(F.lds + RING_OFF, g, S, E, F.tid); }
            T1(7); SEAMT(p + 3, 7);
        }
        if (IN(p + 4)) {
            T0(8);
            for (int rep = 0; rep < REPS(7); ++rep) { if (rep) { xcd_barrier(bar); int tl; asm volatile("v_mbcnt_lo_u32_b32 %0, -1, 0\n\tv_mbcnt_hi_u32_b32 %0, -1, %0\n\tv_lshl_or_b32 %0, %1, 6, %0" : "=&v"(tl) : "s"(wave0)); F.tid = tl; F.lane = tl & 63; F.wave = __builtin_amdgcn_readfirstlane(tl >> 6); asm volatile("" : "+s"(bxl)); }
            pg8::Gemm g{F.HID, wt_ptr(F, l, WT_FF2), M, DM, FF, 0}; pg8::StaticOrder S; S.init(M, DM, F.G, bxl);
            const int nl = l + 1 < DEPTH ? l + 1 : l;
            if (rep && l + 1 == DEPTH) break;
            pg8::EpiRes E{rep ? inp(F, 0) : nullptr, F.XB, (l + 1 == DEPTH && !rep) ? F.out : nullptr, rep ? (bf16*)F.out : F.XB, modl + 5120, F.MOD + (size_t)nl * 8 * NMOD + 1024, inp(F, 4) + nl * DM, rep ? (bf16*)((unsigned char*)F.out + 32 * MiB) : F.HA, rep ? (float*)(F.ws + WS_SSQ2) : F.SSQ1, (l + 1 < DEPTH || rep) ? 1 : 0};
            pg8::gemm_phase<pg8::EpiRes, pg8::StaticOrder, true, true>(F.lds + RING_OFF, g, S, E, F.tid); }
            T1(8); if (l + 1 < DEPTH) SEAMT(p + 4, 8);
        }
    }
    if (PROBE_T != 0 && blockIdx.x == 0 && threadIdx.x == 0) { const unsigned long long tend = __builtin_amdgcn_s_memrealtime() + 10ull * F.tacc; while (__builtin_amdgcn_s_memrealtime() < tend) __builtin_amdgcn_s_sleep(16); }
#undef IN
#undef SEAM
}

extern "C" void kernel_launch(void* const* d_in, const int* in_sizes, int n_in, void* d_out, int out_size, void* d_ws, size_t ws_size, hipStream_t stream) {
    static int grid = 0;
    if (grid == 0) {
        if (n_in != 21 || in_sizes[0] != M * DM || out_size != M * DM || ws_size < WS_END) { fprintf(stderr, "kernel_launch: unexpected problem shape (n_in %d, in0 %d, out %d, ws %zu, need %zu); nothing launched\n", n_in, n_in > 0 ? in_sizes[0] : -1, out_size, ws_size, (size_t)WS_END); grid = -1; return; }
        int dev = 0, cus = 0, per_cu = 0;
        if (hipGetDevice(&dev) != hipSuccess || hipDeviceGetAttribute(&cus, hipDeviceAttributeMultiprocessorCount, dev) != hipSuccess) { fprintf(stderr, "kernel_launch: device query failed\n"); grid = -1; return; }
        if (hipFuncSetAttribute((const void*)trunk_fwd, hipFuncAttributeMaxDynamicSharedMemorySize, LDS_BYTES) != hipSuccess) { fprintf(stderr, "kernel_launch: hipFuncSetAttribute failed\n"); grid = -1; return; }
        if (hipOccupancyMaxActiveBlocksPerMultiprocessor(&per_cu, (const void*)trunk_fwd, NWAVES * 64, LDS_BYTES) != hipSuccess || per_cu < 1) { fprintf(stderr, "kernel_launch: occupancy query reports %d workgroups per CU\n", per_cu); }
        (void)hipGetLastError();
        grid = cus;
    }
    if (grid < 0) return;
    if (hipMemsetAsync((char*)d_ws + WS_CTL, 0, CTL_ZERO_BYTES, stream) != hipSuccess) { fprintf(stderr, "kernel_launch: hipMemsetAsync failed\n"); return; }
    Args a{};
    for (int i = 0; i < 21; ++i) a.in[i] = (const float*)d_in[i];
    a.out = (float*)d_out; a.ws = (unsigned char*)d_ws;
#if MK_PER_PHASE
    for (int li = 0; li < N_PHASES; ++li) { a.ph_lo = li; a.ph_hi = li + 1; a.li = li;
        hipLaunchKernelGGL(trunk_fwd, dim3(grid), dim3(NWAVES * 64), LDS_BYTES, stream, a); }
#else
    a.ph_lo = 0; a.ph_hi = N_PHASES; a.li = 0;
    hipLaunchKernelGGL(trunk_fwd, dim3(grid), dim3(NWAVES * 64), LDS_BYTES, stream, a);
#endif
    const hipError_t le = hipPeekAtLastError();
    if (le != hipSuccess) fprintf(stderr, "kernel_launch: launch failed: %s\n", hipGetErrorName(le));
}
```

```cpp
#include <hip/hip_runtime.h>
#include <cstdio>
#include <cstdint>
#include <cmath>
namespace pg8 {
#define PG8_LAS __attribute__((address_space(3)))
typedef unsigned short bf16_t;
typedef short bf16x8 __attribute__((ext_vector_type(8)));
typedef float f32x4 __attribute__((ext_vector_type(4)));
typedef unsigned u32x4 __attribute__((ext_vector_type(4)));
constexpr int BM = 256, BK = 64, HALF = 128, HTB = HALF * BK * 2  , STAGE_BYTES = 8 * HTB, NXCD = 8, WGM = 8;

__host__ __device__ __forceinline__ int lds_byte(int r, int c) { const int st = (r >> 4) * 2 + (c >> 5), rr = r & 15, cc = c & 31, ob = rr * 64 + cc * 2; return st * 1024 + (ob ^ (((ob >> 9) & 1) << 5)); }
__host__ __device__ __forceinline__ void stage_rc(int b, int& R, int& C) { const int st = b / 1024, sb = b % 1024, swz = sb ^ (((sb >> 9) & 1) << 5); R = (st >> 1) * 16 + swz / 64; C = (st & 1) * 32 + (swz % 64) / 2; }
__host__ __device__ __forceinline__ int perm32(int rho) { const int n = rho >> 4, i = rho & 15; return 8 * (i >> 2) + 4 * n + (i & 3); }

struct Unit { int pm, pn; };
struct Gemm { const bf16_t* A; const bf16_t* Bt; int M, N, K; size_t gapA; };

struct StaticOrder {
    int nM, nN, nwg, G, c;
    __host__ __device__ void init(int M, int N, int G_, int c_) { nM = M / BM; nN = N / BM; nwg = nM * nN; G = G_; c = c_; }
    __host__ __device__ bool next(int i, Unit& u) const {
        const long L = (long)i * G + c; if (L >= nwg) return false;
        int wgid = (int)L; { const int q = nwg / NXCD, r = nwg % NXCD, xcd = wgid % NXCD, off = wgid / NXCD; wgid = (xcd < r ? xcd * (q + 1) : r * (q + 1) + (xcd - r) * q) + off; }
        const int nig = WGM * nN, gid = wgid / nig, fm = gid * WGM, gsz = (nM - fm) < WGM ? (nM - fm) : WGM;
        u.pm = fm + ((wgid % nig) % gsz); u.pn = (wgid % nig) / gsz; return true;
    }
    __device__ __forceinline__ void a_ready(const Unit&) const {}
    __device__ __forceinline__ void done(const Unit&) const {}
};


__device__ __forceinline__ unsigned cvt_pk_bf16(float lo, float hi) { unsigned r; asm volatile("v_cvt_pk_bf16_f32 %0, %1, %2" : "=v"(r) : "v"(lo), "v"(hi)); return r; }
typedef unsigned u32x2 __attribute__((ext_vector_type(2)));
__device__ __forceinline__ float dot4(f32x4 a) { return (a[0] * a[0] + a[1] * a[1]) + (a[2] * a[2] + a[3] * a[3]); }

struct EpiProj {
    static constexpr bool PERM = true, AFTER_DRAIN = false;
    bf16_t* O; const float* bias; const PG8_LAS float* rtab; const float* qg; const float* kg; float qscale; size_t obs;
    __device__ __forceinline__ void operator()(const f32x4 (&acc)[2][2][4][2], const Unit& u, int ui, int wr, int wc, int fr, int fq) const {
        const int b = u.pm >> 3;
        const int row0 = (u.pm & 7) * BM + wr * 64 + fr, col0 = u.pn * BM + wc * 32 + 8 * fq;
        bf16_t* Ob = O + (size_t)b * obs;
        const float* bp = bias + b * 2304 + col0;
        f32x4 bv[2][2];
#pragma unroll
        for (int bj = 0; bj < 2; ++bj)
#pragma unroll
            for (int n = 0; n < 2; ++n) bv[bj][n] = *(const f32x4*)(bp + bj * HALF + 4 * n);
        const PG8_LAS float* rt = rtab + ui * 256 + wr * 64 + fr;
        const int kind = (u.pn == 3 || u.pn == 4) ? 1 : ((u.pn == 6 || u.pn == 7) ? 2 : 0);
        if (kind) {
            const int ocol = (kind == 1 ? 768 + (u.pn - 3) * 128 : 1536 + (u.pn - 6) * 128) + wc * 32 + 8 * fq;
#pragma unroll
            for (int ai = 0; ai < 2; ++ai)
#pragma unroll
                for (int m = 0; m < 4; ++m) { const float rs = rt[ai * HALF + m * 16];
                    const f32x4 a0 = acc[ai][0][m][0] * rs + bv[0][0], a1 = acc[ai][0][m][1] * rs + bv[0][1], g0 = acc[ai][1][m][0] * rs + bv[1][0], g1 = acc[ai][1][m][1] * rs + bv[1][1];
                    f32x4 v0, v1;
                    if (kind == 1) {
#pragma unroll
                        for (int i = 0; i < 4; ++i) { v0[i] = a0[i] * __builtin_amdgcn_rcpf(1.0f + __expf(-g0[i])); v1[i] = a1[i] * __builtin_amdgcn_rcpf(1.0f + __expf(-g1[i])); }
                    } else { v0 = a0 * g0; v1 = a1 * g1; }
                    u32x4 w; w.x = cvt_pk_bf16(v0[0], v0[1]); w.y = cvt_pk_bf16(v0[2], v0[3]); w.z = cvt_pk_bf16(v1[0], v1[1]); w.w = cvt_pk_bf16(v1[2], v1[3]);
                    *(u32x4*)(Ob + (size_t)(row0 + ai * HALF + m * 16) * 2304 + ocol) = w; }
            return;
        }
        const bool isqk = u.pn < 2;
        f32x4 g0 = (f32x4){1.f, 1.f, 1.f, 1.f}, g1 = g0;
        if (isqk) { const float* gp = (u.pn == 0 ? qg : kg) + 8 * fq; g0 = *(const f32x4*)gp; g1 = *(const f32x4*)(gp + 4); if (u.pn == 0) { g0 = g0 * qscale; g1 = g1 * qscale; } }
#pragma unroll
        for (int ai = 0; ai < 2; ++ai)
#pragma unroll
            for (int m = 0; m < 4; ++m) { const float rs = rt[ai * HALF + m * 16]; bf16_t* rowp = Ob + (size_t)(row0 + ai * HALF + m * 16) * 2304 + col0;
#pragma unroll
                for (int bj = 0; bj < 2; ++bj) { f32x4 v0 = acc[ai][bj][m][0] * rs + bv[bj][0], v1 = acc[ai][bj][m][1] * rs + bv[bj][1];
                    if (isqk) { float ss = dot4(v0) + dot4(v1); ss += __shfl_xor(ss, 16); ss += __shfl_xor(ss, 32);
                        const float r = __builtin_amdgcn_rsqf(ss * (1.0f / 32.0f) + 1e-6f); v0 = v0 * r * g0; v1 = v1 * r * g1; }
                    u32x4 w; w.x = cvt_pk_bf16(v0[0], v0[1]); w.y = cvt_pk_bf16(v0[2], v0[3]); w.z = cvt_pk_bf16(v1[0], v1[1]); w.w = cvt_pk_bf16(v1[2], v1[3]);
                    *(u32x4*)(rowp + bj * HALF) = w; } }
    }
};
struct EpiFF1 {
    static constexpr bool PERM = true, AFTER_DRAIN = false;
    bf16_t* O; const float* bias; const PG8_LAS float* rtab;
    __device__ __forceinline__ void operator()(const f32x4 (&acc)[2][2][4][2], const Unit& u, int ui, int wr, int wc, int fr, int fq) const {
        const int b = u.pm >> 3;
        const int row0 = u.pm * BM + wr * 64 + fr, col0 = u.pn * BM + wc * 32 + 8 * fq;
        const float* bp = bias + b * 4096 + col0;
        f32x4 bv[2][2];
#pragma unroll
        for (int bj = 0; bj < 2; ++bj)
#pragma unroll
            for (int n = 0; n < 2; ++n) bv[bj][n] = *(const f32x4*)(bp + bj * HALF + 4 * n);
        const PG8_LAS float* rt = rtab + ui * 256 + wr * 64 + fr;
        const f32x4 z = (f32x4){0.f, 0.f, 0.f, 0.f};
#pragma unroll
        for (int ai = 0; ai < 2; ++ai)
#pragma unroll
            for (int m = 0; m < 4; ++m) {
#ifdef EXP_A
 const float rs = 1.0f;
#else
 const float rs = rt[ai * HALF + m * 16];
#endif
 bf16_t* rowp = O + (size_t)(row0 + ai * HALF + m * 16) * 4096 + col0;
#pragma unroll
                for (int bj = 0; bj < 2; ++bj) { f32x4 v0 = acc[ai][bj][m][0] * rs + bv[bj][0], v1 = acc[ai][bj][m][1] * rs + bv[bj][1];
                    v0 = __builtin_elementwise_max(v0, z); v1 = __builtin_elementwise_max(v1, z); v0 = v0 * v0; v1 = v1 * v1;
                    u32x4 w; w.x = cvt_pk_bf16(v0[0], v0[1]); w.y = cvt_pk_bf16(v0[2], v0[3]); w.z = cvt_pk_bf16(v1[0], v1[1]); w.w = cvt_pk_bf16(v1[2], v1[3]);
                    *(u32x4*)(rowp + bj * HALF) = w; } }
    }
};
struct EpiRes {
    static constexpr bool PERM = true, AFTER_DRAIN = false;
    const float* xin_f; const bf16_t* xin_h; float* xout_f; bf16_t* xout_h; const float* gate; const float* nsc; const float* ng; bf16_t* hA; float* ssq; int write_next;
    __device__ __forceinline__ void operator()(const f32x4 (&acc)[2][2][4][2], const Unit& u, int ui, int wr, int wc, int fr, int fq) const {
        const int b = u.pm >> 3;
        const int col0 = u.pn * BM + wc * 32 + 8 * fq;
        f32x4 gv[2][2], gm[2][2];
#pragma unroll
        for (int bj = 0; bj < 2; ++bj)
#pragma unroll
            for (int n = 0; n < 2; ++n) { const int c = col0 + bj * HALF + 4 * n; gv[bj][n] = *(const f32x4*)(gate + b * 6144 + c);
                if (write_next) gm[bj][n] = *(const f32x4*)(ng + c) * (*(const f32x4*)(nsc + b * 6144 + c) + 1.0f); else gm[bj][n] = (f32x4){0.f, 0.f, 0.f, 0.f}; }
#pragma unroll
        for (int ai = 0; ai < 2; ++ai) {
            u32x4 xr[4][2];
            if (!xin_f) {
#pragma unroll
                for (int m = 0; m < 4; ++m) { const size_t rbase = (size_t)(u.pm * BM + ai * HALF + wr * 64 + m * 16 + fr) * 1024 + col0;
#pragma unroll
                    for (int bj = 0; bj < 2; ++bj) xr[m][bj] = *(const u32x4*)(xin_h + rbase + bj * HALF); }
            }
#pragma unroll
            for (int m = 0; m < 4; ++m) { const int row = u.pm * BM + ai * HALF + wr * 64 + m * 16 + fr; float ss = 0.f;
#pragma unroll
                for (int bj = 0; bj < 2; ++bj) { const size_t off = (size_t)row * 1024 + col0 + bj * HALF;
                    f32x4 xi0, xi1;
                    if (xin_f) { xi0 = *(const f32x4*)(xin_f + off); xi1 = *(const f32x4*)(xin_f + off + 4); }
                    else { const u32x4 t = xr[m][bj];
                        xi0 = (f32x4){__builtin_bit_cast(float, t.x << 16), __builtin_bit_cast(float, t.x & 0xffff0000u), __builtin_bit_cast(float, t.y << 16), __builtin_bit_cast(float, t.y & 0xffff0000u)};
                        xi1 = (f32x4){__builtin_bit_cast(float, t.z << 16), __builtin_bit_cast(float, t.z & 0xffff0000u), __builtin_bit_cast(float, t.w << 16), __builtin_bit_cast(float, t.w & 0xffff0000u)}; }
                    const f32x4 xo0 = xi0 + gv[bj][0] * acc[ai][bj][m][0], xo1 = xi1 + gv[bj][1] * acc[ai][bj][m][1]; ss += dot4(xo0) + dot4(xo1);
                    if (xout_f) { *(f32x4*)(xout_f + off) = xo0; *(f32x4*)(xout_f + off + 4) = xo1; }
                    else { u32x4 w; w.x = cvt_pk_bf16(xo0[0], xo0[1]); w.y = cvt_pk_bf16(xo0[2], xo0[3]); w.z = cvt_pk_bf16(xo1[0], xo1[1]); w.w = cvt_pk_bf16(xo1[2], xo1[3]); *(u32x4*)(xout_h + off) = w; }
                    if (write_next) { const f32x4 h0 = xo0 * gm[bj][0], h1 = xo1 * gm[bj][1]; u32x4 w; w.x = cvt_pk_bf16(h0[0], h0[1]); w.y = cvt_pk_bf16(h0[2], h0[3]); w.z = cvt_pk_bf16(h1[0], h1[1]); w.w = cvt_pk_bf16(h1[2], h1[3]); *(u32x4*)(hA + off) = w; } }
                ss += __shfl_xor(ss, 16); ss += __shfl_xor(ss, 32);
                if (write_next && fq == 0) ssq[(size_t)(u.pn * 4 + wc) * 16384 + row] = ss;
                if ((m & 1) && xin_f) asm volatile("" ::: "memory"); }
            asm volatile("" ::: "memory"); }
    }
};

template <class Epi, class Sched, bool ALIGN_EPI = false, bool SP2 = false>
__device__ __forceinline__ void gemm_phase(PG8_LAS unsigned char* lds, const Gemm g, const Sched& S, const Epi& E, const int tid_in) {
    const int tid = tid_in, wid = __builtin_amdgcn_readfirstlane(tid >> 6), lane = tid & 63, wr = wid >> 2, wc = wid & 3, fr = lane & 15, fq = lane >> 4;
    const int K = g.K, nt = K / BK;
    unsigned voffA[2], voffB[2];
#pragma unroll
    for (int i = 0; i < 2; ++i) { int R, C; stage_rc(tid * 16 + i * 8192, R, C); const int Rb = Epi::PERM ? ((R & ~31) + perm32(R & 31)) : R;
        voffA[i] = (unsigned)(R * K + C) * 2u; voffB[i] = (unsigned)(Rb * K + C) * 2u; }
    const size_t kstep = (size_t)(BK * 2);
    const size_t hstep = (size_t)HALF * K * 2;
    const size_t tstep = 2 * hstep;
    const unsigned ldsw = (unsigned)wid * 1024u;
    const int aoff = lds_byte(wr * 64 + fr, fq * 8), boff = lds_byte(wc * 32 + fr, fq * 8);
#define PG8_SA(b, h) (((b) * 2 + (h)) * HTB)
#define PG8_SB(b, h) ((4 + (b) * 2 + (h)) * HTB)
#define PG8_STAGE(bufoff, gbase, voff) do { _Pragma("unroll") for (int _i = 0; _i < 2; ++_i) \
        __builtin_amdgcn_global_load_lds((const unsigned*)((const char*)(gbase) + (voff)[_i]), (PG8_LAS unsigned*)(lds + (bufoff) + ldsw + _i * 8192), 16, 0, 0); } while (0)
#define PG8_LDA(dst, b, h) do { _Pragma("unroll") for (int m = 0; m < 4; ++m) _Pragma("unroll") for (int k = 0; k < 2; ++k) dst[m][k] = *(const PG8_LAS bf16x8*)(lds + PG8_SA(b, h) + aoff + m * 2048 + k * 1024); } while (0)
#define PG8_LDB(dst, b, h) do { _Pragma("unroll") for (int n = 0; n < 2; ++n) _Pragma("unroll") for (int k = 0; k < 2; ++k) dst[n][k] = *(const PG8_LAS bf16x8*)(lds + PG8_SB(b, h) + boff + n * 2048 + k * 1024); } while (0)
#define PG8_MMA(ai, bj, At, Bt) do { __builtin_amdgcn_s_setprio(1); _Pragma("unroll") for (int m = 0; m < 4; ++m) _Pragma("unroll") for (int n = 0; n < 2; ++n) _Pragma("unroll") for (int k = 0; k < 2; ++k) \
        acc[ai][bj][m][n] = __builtin_amdgcn_mfma_f32_16x16x32_bf16(Bt[n][k], At[m][k], acc[ai][bj][m][n], 0, 0, 0); __builtin_amdgcn_s_setprio(0); } while (0)
#define PG8_WAIT_V(n) asm volatile("s_waitcnt vmcnt(" #n ")" ::: "memory")
#define PG8_WAIT_L(n) asm volatile("s_waitcnt lgkmcnt(" #n ")" ::: "memory")
#define PG8_BAR __builtin_amdgcn_s_barrier()
#define PG8_SCHED __builtin_amdgcn_sched_barrier(0)
    Unit cur, nxt; int ui = 0;
    if (!S.next(0, cur)) return;
    f32x4 acc[2][2][4][2];
#pragma unroll
    for (int a = 0; a < 2; ++a)
#pragma unroll
        for (int b = 0; b < 2; ++b)
#pragma unroll
            for (int m = 0; m < 4; ++m)
#pragma unroll
                for (int n = 0; n < 2; ++n) acc[a][b][m][n] = (f32x4){0.f, 0.f, 0.f, 0.f};
    bf16x8 At[4][2], B0[2][2], B1[2][2];
    const char* cA = (const char*)g.A + (size_t)cur.pm * tstep + (size_t)(cur.pm >> 3) * g.gapA; const char* cB = (const char*)g.Bt + (size_t)cur.pn * tstep;
    S.a_ready(cur);
    if constexpr (SP2) {
        PG8_STAGE(PG8_SB(0, 0), cB, voffB); PG8_STAGE(PG8_SB(0, 1), cB + hstep, voffB); PG8_STAGE(PG8_SA(0, 0), cA, voffA); PG8_STAGE(PG8_SA(0, 1), cA + hstep, voffA);
        if (wr == 1) PG8_BAR;
        PG8_WAIT_V(2); PG8_BAR;
        PG8_STAGE(PG8_SB(1, 0), cB + kstep, voffB); PG8_STAGE(PG8_SA(1, 0), cA + kstep, voffA); PG8_STAGE(PG8_SB(1, 1), cB + hstep + kstep, voffB);
        PG8_WAIT_V(6); PG8_BAR;
    } else {
        PG8_STAGE(PG8_SB(0, 0), cB, voffB); PG8_STAGE(PG8_SA(0, 0), cA, voffA); PG8_STAGE(PG8_SB(0, 1), cB + hstep, voffB); PG8_STAGE(PG8_SA(0, 1), cA + hstep, voffA);
        if (wr == 1) PG8_BAR;
        PG8_WAIT_V(4); PG8_BAR;
        PG8_STAGE(PG8_SB(1, 0), cB + kstep, voffB); PG8_STAGE(PG8_SA(1, 0), cA + kstep, voffA); PG8_STAGE(PG8_SB(1, 1), cB + hstep + kstep, voffB);
        PG8_WAIT_V(6); PG8_BAR;
    }
    for (;;) {
        const bool has_next = S.next(ui + 1, nxt);
        const char* nA = has_next ? (const char*)g.A + (size_t)nxt.pm * tstep + (size_t)(nxt.pm >> 3) * g.gapA : cA; const char* nB = has_next ? (const char*)g.Bt + (size_t)nxt.pn * tstep : cB;
        for (int t = 0; t < nt; t += 2) {
            const bool last = (t == nt - 2);
            const char* a1 = cA + (size_t)(t + 1) * kstep;
            const char* a2 = last ? nA : cA + (size_t)(t + 2) * kstep; const char* b2 = last ? nB : cB + (size_t)(t + 2) * kstep;
            const char* a3 = a2 + kstep; const char* b3 = b2 + kstep;
            if (last && has_next) S.a_ready(nxt);
            if constexpr (SP2) {
            PG8_LDB(B0, 0, 0); PG8_LDB(B1, 0, 1); PG8_SCHED; PG8_LDA(At, 0, 0); PG8_STAGE(PG8_SA(1, 1), a1 + hstep, voffA);
            PG8_WAIT_V(8); PG8_WAIT_L(0); PG8_BAR; PG8_MMA(0, 0, At, B0); PG8_MMA(0, 1, At, B1); PG8_BAR; PG8_SCHED;
            PG8_LDA(At, 0, 1); PG8_STAGE(PG8_SB(0, 0), b2, voffB); PG8_STAGE(PG8_SB(0, 1), b2 + hstep, voffB); PG8_STAGE(PG8_SA(0, 0), a2, voffA);
            PG8_WAIT_V(8); PG8_WAIT_L(0); PG8_BAR; PG8_MMA(1, 0, At, B0); PG8_MMA(1, 1, At, B1); PG8_BAR; PG8_SCHED;
            PG8_LDB(B0, 1, 0); PG8_LDB(B1, 1, 1); PG8_SCHED; PG8_LDA(At, 1, 0); PG8_STAGE(PG8_SA(0, 1), a2 + hstep, voffA);
            PG8_WAIT_V(8); PG8_WAIT_L(0); PG8_BAR; PG8_MMA(0, 0, At, B0); PG8_MMA(0, 1, At, B1); PG8_BAR; PG8_SCHED;
            PG8_LDA(At, 1, 1); PG8_STAGE(PG8_SB(1, 0), b3, voffB); PG8_STAGE(PG8_SB(1, 1), b3 + hstep, voffB); PG8_STAGE(PG8_SA(1, 0), a3, voffA);
            PG8_WAIT_V(8); PG8_WAIT_L(0); PG8_BAR; PG8_MMA(1, 0, At, B0); PG8_MMA(1, 1, At, B1); PG8_BAR; PG8_SCHED;
            } else {
            PG8_LDB(B0, 0, 0); PG8_SCHED; PG8_LDA(At, 0, 0); PG8_STAGE(PG8_SA(1, 1), a1 + hstep, voffA);
            PG8_WAIT_L(8); PG8_BAR; PG8_WAIT_L(0); PG8_MMA(0, 0, At, B0); PG8_BAR; PG8_SCHED;
            PG8_LDB(B1, 0, 1); PG8_STAGE(PG8_SB(0, 0), b2, voffB);
            PG8_BAR; PG8_WAIT_L(0); PG8_MMA(0, 1, At, B1); PG8_BAR;
            PG8_LDA(At, 0, 1); PG8_STAGE(PG8_SA(0, 0), a2, voffA);
            PG8_BAR; PG8_WAIT_L(0); PG8_MMA(1, 0, At, B0); PG8_BAR; PG8_SCHED;
            PG8_STAGE(PG8_SB(0, 1), b2 + hstep, voffB);
            PG8_WAIT_V(6); PG8_BAR; PG8_MMA(1, 1, At, B1); PG8_BAR;
            PG8_LDB(B0, 1, 0); PG8_SCHED; PG8_LDA(At, 1, 0); PG8_STAGE(PG8_SA(0, 1), a2 + hstep, voffA);
            PG8_WAIT_L(8); PG8_BAR; PG8_WAIT_L(0); PG8_MMA(0, 0, At, B0); PG8_BAR; PG8_SCHED;
            PG8_LDB(B1, 1, 1); PG8_STAGE(PG8_SB(1, 0), b3, voffB);
            PG8_BAR; PG8_WAIT_L(0); PG8_MMA(0, 1, At, B1); PG8_BAR;
            PG8_LDA(At, 1, 1); PG8_STAGE(PG8_SA(1, 0), a3, voffA);
            PG8_BAR; PG8_WAIT_L(0); PG8_MMA(1, 0, At, B0); PG8_BAR; PG8_SCHED;
            PG8_STAGE(PG8_SB(1, 1), b3 + hstep, voffB);
            PG8_WAIT_V(6); PG8_BAR; PG8_MMA(1, 1, At, B1); PG8_BAR;
            }
        }
        if constexpr (ALIGN_EPI) { if (wr == 0) PG8_BAR; }
        if constexpr (!Epi::AFTER_DRAIN) { E(acc, cur, ui, wr, wc, fr, fq); S.done(cur); }
        if (!has_next) break;
#pragma unroll
        for (int a = 0; a < 2; ++a)
#pragma unroll
            for (int b = 0; b < 2; ++b)
#pragma unroll
                for (int m = 0; m < 4; ++m)
#pragma unroll
                    for (int n = 0; n < 2; ++n) acc[a][b][m][n] = (f32x4){0.f, 0.f, 0.f, 0.f};
        cur = nxt; cA = nA; cB = nB; ++ui;
        if constexpr (ALIGN_EPI) { if (wr == 1) PG8_BAR; }
    }
    PG8_WAIT_V(0);
    if constexpr (!ALIGN_EPI) { if (wr == 0) PG8_BAR; }
    PG8_BAR;
    if constexpr (Epi::AFTER_DRAIN) { E.fused(acc, cur, wr, wc, fr, fq, lds, wid, lane); S.done(cur); }
#undef PG8_SA
#undef PG8_SB
#undef PG8_STAGE
#undef PG8_LDA
#undef PG8_LDB
#undef PG8_MMA
#undef PG8_WAIT_V
#undef PG8_WAIT_L
#undef PG8_BAR
#undef PG8_SCHED
}
}

constexpr int NWAVES = 8;
constexpr int DM = 1024, BATCH = 8, SEQ = 2048, M = BATCH * SEQ, DEPTH = 4, NIN = 2304, FF = 4096, NMOD = 6144;
constexpr float EPS = 1e-6f;
constexpr float QSCALE = 0.17677669529663687f * 1.4426950408889634f;

#ifndef MK_PER_PHASE
#define MK_PER_PHASE 0
#endif
constexpr int N_PHASES = 2 + 5 * DEPTH;
#ifndef PROBE_T
#define PROBE_T 0
#endif
#define T0(k) do { if (PROBE_T == (k)) F.tt0 = __builtin_amdgcn_s_memrealtime(); } while (0)
#define T1(k) do { if (PROBE_T == (k)) F.tacc += __builtin_amdgcn_s_memrealtime() - F.tt0; } while (0)
#ifndef PREP_UPFRONT
#define PREP_UPFRONT 1
#endif

constexpr size_t MiB = 1u << 20;
constexpr size_t WS_CTL = 0, CTL_ZERO_BYTES = 256 * 1024;
constexpr size_t WS_MOD = 1 * MiB;
constexpr size_t WS_BIAS1 = 2 * MiB;
constexpr size_t WS_BIAS2 = 3 * MiB;
constexpr size_t WS_SSQ1 = 4 * MiB, WS_SSQ2 = 5 * MiB;
constexpr size_t WS_WT = 8 * MiB;
constexpr size_t WT_IN = 0, WT_OUT = (size_t)NIN * DM * 2, WT_FF1 = WT_OUT + (size_t)DM * DM * 2, WT_FF2 = WT_FF1 + (size_t)FF * DM * 2, WT_LAYER = WT_FF2 + (size_t)FF * DM * 2;
constexpr size_t WS_HA = WS_WT + DEPTH * WT_LAYER;
constexpr size_t WS_XB = WS_HA + (size_t)M * DM * 2;
constexpr size_t ACT_BSTRIDE = (size_t)SEQ * FF * 2;
constexpr size_t ACT_MIXOFF = (size_t)SEQ * NIN * 2;
constexpr size_t WS_PROJ = WS_XB + (size_t)M * DM * 2;
constexpr size_t WS_MIX = WS_PROJ + ACT_MIXOFF;
constexpr size_t WS_HID = WS_PROJ;
constexpr size_t WS_END = WS_HID + (size_t)M * FF * 2;
static_assert(WT_LAYER == (size_t)(NIN + DM + FF + FF) * DM * 2 && WS_HA % 256 == 0 && WS_PROJ % 256 == 0 && ACT_MIXOFF % 256 == 0 && ACT_MIXOFF + (size_t)SEQ * DM * 2 <= ACT_BSTRIDE && ACT_BSTRIDE * BATCH == (size_t)M * FF * 2, "ws map");
constexpr int CW_BAR = 4096;

constexpr int RING_OFF = 0, RING_BYTES = 131072;
constexpr int LDSCTL_OFF = RING_BYTES, MISC_OFF = LDSCTL_OFF + 320;
constexpr int PTR_OFF = LDSCTL_OFF + 128;
constexpr int RT_OFF = LDSCTL_OFF + 512;
constexpr int LDS_BYTES = 147456;
static_assert(RT_OFF + 8 * 256 * 4 <= LDS_BYTES, "LDS map");

#define GAS __attribute__((address_space(1)))
#define LAS __attribute__((address_space(3)))
typedef unsigned short bf16;
typedef unsigned v4u __attribute__((ext_vector_type(4)));
typedef unsigned v2u __attribute__((ext_vector_type(2)));
typedef float f32x4 __attribute__((ext_vector_type(4)));
typedef float f32x2 __attribute__((ext_vector_type(2)));
typedef short bf16x8 __attribute__((ext_vector_type(8)));
typedef short s16x4 __attribute__((ext_vector_type(4)));
typedef GAS unsigned gu32;
#define RLX_AGENT __ATOMIC_RELAXED, __HIP_MEMORY_SCOPE_AGENT
#define LDS_WAIT() asm volatile("s_waitcnt lgkmcnt(0)" ::: "memory")
#define VM_WAIT() asm volatile("s_waitcnt vmcnt(0)" ::: "memory")
__device__ __forceinline__ unsigned f2bf(float f) { unsigned u = __builtin_bit_cast(unsigned, f); return (u + 0x7fffu + ((u >> 16) & 1u)) >> 16; }
__device__ __forceinline__ unsigned pk2(float lo, float hi) { return f2bf(lo) | (f2bf(hi) << 16); }
__device__ __forceinline__ float bflo(unsigned v) { return __builtin_bit_cast(float, v << 16); }
__device__ __forceinline__ float bfhi(unsigned v) { return __builtin_bit_cast(float, v & 0xffff0000u); }
__device__ __forceinline__ float wave_sum(float v) {
#pragma unroll
    for (int o = 1; o < 64; o <<= 1) v += __shfl_xor(v, o);
    return v;
}
__device__ __forceinline__ float wave_max(float v) {
#pragma unroll
    for (int o = 1; o < 64; o <<= 1) v = fmaxf(v, __shfl_xor(v, o));
    return v;
}
__device__ __forceinline__ float sigmoidf_(float v) { return 1.0f / (1.0f + __expf(-v)); }

#define XB_TMO      128
#define XB_XCNT(j)  (256  + 64 * (j))
#define XB_XSUB(j)  (1280 + 64 * (j))
#define XB_XGEN(j)  (2304 + 64 * (j))
#define XB_TOP      3328
#define XB_TOPGEN   3392
#define XCD_BAR_WORDS 3456
#define XB_SPIN_CAP (1u << 18)

__device__ __forceinline__ unsigned xb_ld(unsigned* p)              { return __hip_atomic_load(p, __ATOMIC_RELAXED, __HIP_MEMORY_SCOPE_AGENT); }
__device__ __forceinline__ unsigned xb_add(unsigned* p, unsigned v) { return __hip_atomic_fetch_add(p, v, __ATOMIC_RELAXED, __HIP_MEMORY_SCOPE_AGENT); }
__device__ __forceinline__ unsigned xb_xcc_id() { return (unsigned)__builtin_amdgcn_s_getreg((3 << 11) | 20) & 0xFu; }
#define XB_SPIN(cond, bar) do { unsigned _sp = 0; while (cond) { __builtin_amdgcn_s_sleep(1); \
    if ((++_sp & 255u) == 0u) { if (xb_ld(&(bar)[XB_TMO])) break; if (_sp > XB_SPIN_CAP) { atomicAdd(&(bar)[XB_TMO], 1u); break; } } } } while (0)

struct XcdBarrier { unsigned* bar; unsigned x; volatile LAS unsigned* st; unsigned gsize; };

__device__ __forceinline__ XcdBarrier xcd_barrier_post(unsigned* bar, volatile LAS unsigned* st, unsigned gsize) {
    XcdBarrier b; b.bar = bar; b.x = xb_xcc_id(); b.st = st; b.gsize = gsize;
    if (threadIdx.x == 0) (void)xb_add(&bar[XB_XCNT(b.x)], 1u);
    return b;
}
__device__ __forceinline__ void xcd_barrier_complete(unsigned* bar, unsigned x, unsigned G, unsigned& nloc, unsigned& nx) {
    unsigned sum, cnt, mine, sp = 0u;
    for (;;) {
        sum = 0u; cnt = 0u; mine = 0u;
#pragma unroll
        for (unsigned j = 0; j < 16; ++j) { const unsigned c = xb_ld(&bar[XB_XCNT(j)]); sum += c; cnt += (c > 0u) ? 1u : 0u; mine = (j == x) ? c : mine; }
        if (sum == G) break;
        __builtin_amdgcn_s_sleep(1);
        if ((++sp & 255u) == 0u) { if (xb_ld(&bar[XB_TMO])) break; if (sp > XB_SPIN_CAP) { atomicAdd(&bar[XB_TMO], 1u); break; } }
    }
    nloc = mine > 0u ? mine : 1u; nx = cnt > 0u ? cnt : 1u;
}
__device__ __forceinline__ void xcd_barrier(const XcdBarrier& b) {
    asm volatile("s_waitcnt vmcnt(0)" ::: "memory");
    __syncthreads();
    if (threadIdx.x == 0) {
        unsigned* bar = b.bar;
        __builtin_amdgcn_s_waitcnt(0);
        unsigned nloc = b.st[0], nx = b.st[1];
        if (nloc == 0u) { xcd_barrier_complete(bar, b.x, b.gsize, nloc, nx); b.st[0] = nloc; b.st[1] = nx; }
        const unsigned old = xb_add(&bar[XB_XSUB(b.x)], 1u);
        const unsigned gen = old / nloc;
        if (old + 1u == (gen + 1u) * nloc) {
            if (nx > 1u) {
                __builtin_amdgcn_fence(__ATOMIC_RELEASE, "agent");
                asm volatile("s_waitcnt vmcnt(0)" ::: "memory");
            }
            if (nx > 1u) {
                const unsigned og = xb_add(&bar[XB_TOP], 1u);
                const unsigned tg = og / nx;
                if (og + 1u == (tg + 1u) * nx) xb_add(&bar[XB_TOPGEN], 1u);
                else XB_SPIN(xb_ld(&bar[XB_TOPGEN]) == tg, bar);
            }
            __builtin_amdgcn_fence(__ATOMIC_ACQUIRE, "agent");
            xb_add(&bar[XB_XGEN(b.x)], 1u);
            asm volatile("s_waitcnt vmcnt(0)" ::: "memory");
        } else {
            XB_SPIN(xb_ld(&bar[XB_XGEN(b.x)]) == gen, bar);
            __builtin_amdgcn_fence(__ATOMIC_ACQUIRE, "agent");
            asm volatile("s_waitcnt vmcnt(0)" ::: "memory");
        }
    }
    __syncthreads();
}

struct Frame {
    LAS unsigned char* lds;
    volatile LAS unsigned* MISC;
    gu32* ctl;
    int tid, lane, wave;
    int vcu, G;
    float* out;
    unsigned char* ws;
    float *MOD, *BIAS1, *BIAS2, *SSQ1, *SSQ2;
    bf16 *HA, *XB, *PROJ, *MIX, *HID;
    unsigned long long tacc, tt0;
};
__device__ __forceinline__ const float* inp(const Frame& F, int k) {
    const unsigned long long v = *(const volatile LAS unsigned long long*)(F.lds + PTR_OFF + 8 * k);
    const unsigned lo = __builtin_amdgcn_readfirstlane((unsigned)v), hi = __builtin_amdgcn_readfirstlane((unsigned)(v >> 32));
    return (const float*)(((unsigned long long)hi << 32) | lo);
}
__device__ __forceinline__ bf16* wt_ptr(const Frame& F, int l, size_t off) { return (bf16*)(F.ws + WS_WT + (size_t)l * WT_LAYER + off); }

__device__ __forceinline__ void mod_item(Frame& F, int l, int strip) {
    const int j0 = strip * 256, tid = F.tid, lane = F.lane, wv = F.wave;
    LAS float* cact = (LAS float*)(F.lds);
    LAS float* red = (LAS float*)(F.lds + 32768);
    for (int i = tid; i < 8192; i += NWAVES * 64) { const int b = i >> 10, k = i & 1023; const float v = inp(F, 1)[b * 1024 + k]; cact[k * 8 + b] = v * sigmoidf_(v); }
    __syncthreads();
    {
        const __amdgpu_buffer_rsrc_t rw = __builtin_amdgcn_make_buffer_rsrc((void*)(inp(F, 2) + (size_t)l * 1024 * NMOD), 0, 1024 * NMOD * 4, 0x00020000);
        const int vo = (j0 + 4 * lane) * 4, so0 = 16 * wv * NMOD * 4;
        f32x4 acc[8];
#pragma unroll
        for (int b = 0; b < 8; ++b) acc[b] = (f32x4){0.f, 0.f, 0.f, 0.f};
#pragma unroll 1
        for (int ch = 0; ch < 8; ++ch) {
            f32x4 w[16];
#pragma unroll
            for (int k = 0; k < 16; ++k) { typedef unsigned u4_ __attribute__((ext_vector_type(4))); const u4_ t_ = __builtin_amdgcn_raw_buffer_load_b128(rw, vo, so0 + (ch * 128 + k) * NMOD * 4, 0); w[k] = __builtin_bit_cast(f32x4, t_); }
#pragma unroll
            for (int k = 0; k < 16; ++k) { const LAS f32x4* ca = (const LAS f32x4*)(cact + (ch * 128 + 16 * wv + k) * 8); const f32x4 c0 = ca[0], c1 = ca[1];
                acc[0] += w[k] * c0[0]; acc[1] += w[k] * c0[1]; acc[2] += w[k] * c0[2]; acc[3] += w[k] * c0[3]; acc[4] += w[k] * c1[0]; acc[5] += w[k] * c1[1]; acc[6] += w[k] * c1[2]; acc[7] += w[k] * c1[3]; }
        }
#pragma unroll
        for (int b = 0; b < 8; ++b) *(LAS f32x4*)(red + (wv * 8 + b) * 256 + 4 * lane) = acc[b];
    }
    LDS_WAIT(); __syncthreads();
#pragma unroll
    for (int q = 0; q < 4; ++q) { const int o = tid + 512 * q, b = o >> 8, cc = o & 255; float s = inp(F, 3)[l * NMOD + j0 + cc];
#pragma unroll
        for (int w = 0; w < 8; ++w) s += red[(w * 8 + b) * 256 + cc];
        F.MOD[((size_t)l * 8 + b) * NMOD + j0 + cc] = s; }
    __syncthreads();
}
constexpr int TS = 132;
struct TItem { const float* W; bf16* WT; const float* Wp; const float* psc; int K, N, k0, n0, perm; };
__device__ __forceinline__ int win_perm(int n) {
    if (n >= 768 && n < 1280) { const int g = n >= 1024, c = n - (g ? 1024 : 768); return 768 + (c >> 7) * 256 + g * 128 + (c & 127); }
    if (n >= 1536 && n < 2048) { const int g = n >= 1792, c = n - (g ? 1792 : 1536); return 1536 + (c >> 7) * 256 + g * 128 + (c & 127); }
    return n;
}
__device__ __forceinline__ void titem_load(const Frame& F, const TItem& t, f32x4 (&v)[8]) {
#pragma unroll
    for (int i = 0; i < 8; ++i) v[i] = *(const f32x4*)(t.W + (size_t)(t.k0 + 16 * F.wave + 2 * i + (F.lane >> 5)) * t.N + t.n0 + 4 * (F.lane & 31));
}
__device__ __forceinline__ void titem_process(Frame& F, const TItem& t, const f32x4 (&v)[8], int mode) {
    const int lane = F.lane, wv = F.wave;
    LAS float* tile = (LAS float*)(F.lds);
#pragma unroll
    for (int i = 0; i < 8; ++i) { const int kr = 16 * wv + 2 * i + (lane >> 5); f32x4 x = v[i]; if (t.psc) x = x * t.psc[kr]; if (mode < 3) *(LAS f32x4*)(tile + kr * TS + 4 * (lane & 31)) = x; else asm volatile("" :: "v"(x)); }
    LDS_WAIT(); __syncthreads();
    if (mode >= 2) return;
    if (t.Wp) {
        const int li = lane & 15, lk = lane >> 4;
        f32x4 acc[2][4];
#pragma unroll
        for (int gg = 0; gg < 2; ++gg)
#pragma unroll
            for (int ct = 0; ct < 4; ++ct) acc[gg][ct] = (f32x4){0.f, 0.f, 0.f, 0.f};
#pragma unroll 2
        for (int d0 = 0; d0 < 64; d0 += 4) {
#pragma unroll
            for (int gg = 0; gg < 2; ++gg) { const float bq = tile[(64 * gg + d0 + lk) * TS + 16 * wv + li];
#pragma unroll
                for (int ct = 0; ct < 4; ++ct) { const float a = t.Wp[gg * 4096 + (16 * ct + li) * 64 + d0 + lk]; acc[gg][ct] = __builtin_amdgcn_mfma_f32_16x16x4f32(a, bq, acc[gg][ct], 0, 0, 0); } }
        }
        LDS_WAIT(); __syncthreads();
#pragma unroll
        for (int gg = 0; gg < 2; ++gg)
#pragma unroll
            for (int ct = 0; ct < 4; ++ct)
#pragma unroll
                for (int r = 0; r < 4; ++r) tile[(64 * gg + 16 * ct + 4 * lk + r) * TS + 16 * wv + li] = acc[gg][ct][r];
        LDS_WAIT(); __syncthreads();
    }
    {
        const int n = F.tid & 127, cb = 4 * (F.tid >> 7);
        const int nr = t.perm ? win_perm(t.n0 + n) : t.n0 + n;
#pragma unroll
        for (int j = 0; j < 4; ++j) { const int c = cb + j; const LAS float* s = tile + (8 * c) * TS + n;
            v4u o; o.x = pk2(s[0 * TS], s[1 * TS]); o.y = pk2(s[2 * TS], s[3 * TS]); o.z = pk2(s[4 * TS], s[5 * TS]); o.w = pk2(s[6 * TS], s[7 * TS]);
            if (mode == 0) *(GAS v4u*)(t.WT + (size_t)nr * t.K + t.k0 + 8 * c) = o; else asm volatile("" :: "v"(o)); }
    }
    LDS_WAIT(); __syncthreads();
}
constexpr int TI_IN = (DM / 128) * (NIN / 128), TI_OUT = (DM / 128) * (DM / 128), TI_1 = (DM / 128) * (FF / 128), TI_2 = (FF / 128) * (DM / 128);
__device__ __forceinline__ bool titem_decode(const Frame& F, int it, int L0, int nl, TItem& t) {
    t.Wp = nullptr; t.psc = nullptr; t.perm = 0;
    if (it < 0) return false;
    int r = it;
    if (r < nl * TI_IN) { const int l = L0 + r / TI_IN; r %= TI_IN; t.W = inp(F, 6) + (size_t)l * DM * NIN; t.WT = wt_ptr(F, l, WT_IN); t.K = DM; t.N = NIN; t.k0 = 128 * (r / (NIN / 128)); t.n0 = 128 * (r % (NIN / 128)); t.perm = 1; return true; } r -= nl * TI_IN;
    if (r < nl * TI_OUT) { const int l = L0 + r / TI_OUT; r %= TI_OUT; const int kb = r / 8; t.W = inp(F, 7) + (size_t)l * DM * DM; t.WT = wt_ptr(F, l, WT_OUT); t.K = DM; t.N = DM; t.k0 = 128 * kb; t.n0 = 128 * (r % 8);
        if (kb >= 6) { t.Wp = inp(F, 17) + ((size_t)l * 4 + 2 * (kb - 6)) * 4096; t.psc = inp(F, 18) + l * 256 + 128 * (kb - 6); } return true; } r -= nl * TI_OUT;
    if (r < nl * TI_1) { const int l = L0 + r / TI_1; r %= TI_1; t.W = inp(F, 19) + (size_t)l * DM * FF; t.WT = wt_ptr(F, l, WT_FF1); t.K = DM; t.N = FF; t.k0 = 128 * (r / (FF / 128)); t.n0 = 128 * (r % (FF / 128)); return true; } r -= nl * TI_1;
    if (r < nl * TI_2) { const int l = L0 + r / TI_2; r %= TI_2; t.W = inp(F, 20) + (size_t)l * FF * DM; t.WT = wt_ptr(F, l, WT_FF2); t.K = FF; t.N = DM; t.k0 = 128 * (r / 8); t.n0 = 128 * (r % 8); return true; }
    return false;
}
__device__ __forceinline__ int draw_item(Frame& F, gu32* ctr, int slot) {
    volatile LAS unsigned* box = (volatile LAS unsigned*)(F.lds + LDSCTL_OFF + 64) + slot;
    if (F.tid == 0) *box = __hip_atomic_fetch_add(ctr, 1u, __ATOMIC_RELAXED, __HIP_MEMORY_SCOPE_AGENT);
    LDS_WAIT(); __syncthreads();
    const int it = (int)*box;
    return it;
}
__device__ __forceinline__ void prep_layers(Frame& F, int L0, int nl, int what = 3) {
    constexpr int I_MOD = NMOD / 256;
    gu32* ctr = F.ctl + 2048 + 128 * L0;
    T0(13);
    if (what & 1) {
#pragma unroll 1
        for (int k = 0;; ++k) { const int it = draw_item(F, ctr, k & 1); if (it >= nl * I_MOD) break; mod_item(F, L0 + it / I_MOD, it % I_MOD); }
    }
    T1(13); T0(14);
    if (!(what & 2)) return;
    const int mode = what >> 2;
    TItem cur, nxt; f32x4 v[8], vn[8];
    int k = 0;
    bool have = titem_decode(F, draw_item(F, ctr + 64, 2 + (k++ & 1)), L0, nl, cur);
    if (have) titem_load(F, cur, v);
#pragma unroll 1
    while (have) {
        const bool hn = titem_decode(F, draw_item(F, ctr + 64, 2 + (k++ & 1)), L0, nl, nxt);
        if (hn) titem_load(F, nxt, vn);
        titem_process(F, cur, v, mode);
        cur = nxt; have = hn;
#pragma unroll
        for (int i = 0; i < 8; ++i) v[i] = vn[i];
    }
}
__device__ __forceinline__ void bias_layers(Frame& F, int L0, int nl) {
    const int gw = F.vcu * NWAVES + F.wave, NGW = F.G * NWAVES, lane = F.lane;
    const int ncombo = 2 * nl, combo = gw % ncombo, wsub = gw / ncombo, nsub = NGW / ncombo;
    if (wsub >= nsub) return;
    const int l = L0 + (combo >> 1), kind = combo & 1, N = kind ? FF : NIN;
    const bf16* Wt = wt_ptr(F, l, kind ? WT_FF1 : WT_IN);
    const float* sh = F.MOD + (size_t)l * 8 * NMOD + (kind ? 3072 : 0);
    float* outp = kind ? F.BIAS2 + (size_t)l * 8 * FF : F.BIAS1 + (size_t)l * 8 * NIN;
    f32x4 shr[8][4];
#pragma unroll
    for (int b = 0; b < 8; ++b)
#pragma unroll
        for (int j = 0; j < 4; ++j) shr[b][j] = *(const f32x4*)(sh + (size_t)b * NMOD + 16 * lane + 4 * j);
#pragma unroll 1
    for (int n0 = wsub; n0 < N; n0 += 4 * nsub) {
        v4u w0[4], w1[4];
#pragma unroll
        for (int q = 0; q < 4; ++q) { const int n = (n0 + q * nsub < N) ? n0 + q * nsub : n0; w0[q] = *(const v4u*)(Wt + (size_t)n * DM + 16 * lane); w1[q] = *(const v4u*)(Wt + (size_t)n * DM + 16 * lane + 8); }
#pragma unroll
        for (int q = 0; q < 4; ++q) { const int n = n0 + q * nsub;
            const f32x4 wv0 = (f32x4){bflo(w0[q].x), bfhi(w0[q].x), bflo(w0[q].y), bfhi(w0[q].y)}, wv1 = (f32x4){bflo(w0[q].z), bfhi(w0[q].z), bflo(w0[q].w), bfhi(w0[q].w)};
            const f32x4 wv2 = (f32x4){bflo(w1[q].x), bfhi(w1[q].x), bflo(w1[q].y), bfhi(w1[q].y)}, wv3 = (f32x4){bflo(w1[q].z), bfhi(w1[q].z), bflo(w1[q].w), bfhi(w1[q].w)};
            float a[8];
#pragma unroll
            for (int b = 0; b < 8; ++b) { const f32x4 t = shr[b][0] * wv0 + shr[b][1] * wv1 + shr[b][2] * wv2 + shr[b][3] * wv3; a[b] = wave_sum((t[0] + t[1]) + (t[2] + t[3])); }
            if (lane == 0 && n < N) {
#pragma unroll
                for (int b = 0; b < 8; ++b) outp[(size_t)b * N + n] = a[b]; } }
    }
}
__device__ __forceinline__ void p0b(Frame& F) {
    bias_layers(F, 0, PREP_UPFRONT ? DEPTH : 1);
    const int gw = F.vcu * NWAVES + F.wave, NGW = F.G * NWAVES, lane = F.lane;
    for (int m0 = gw; m0 < M; m0 += 4 * NGW) {
        f32x4 v[4][4];
#pragma unroll
        for (int q = 0; q < 4; ++q) { const int mr = (m0 + q * NGW < M) ? m0 + q * NGW : m0; const GAS f32x4* xr = (const GAS f32x4*)(inp(F, 0) + (size_t)mr * DM) + lane;
#pragma unroll
            for (int j = 0; j < 4; ++j) v[q][j] = xr[64 * j]; }
#pragma unroll
        for (int q = 0; q < 4; ++q) { const int m = m0 + q * NGW, b = m >> 11; if (m >= M) break;
            const f32x4* gr = (const f32x4*)(inp(F, 4)) + lane; const f32x4* sr = (const f32x4*)(F.MOD + (size_t)b * NMOD + 1024) + lane;
            float ss = 0.f; GAS v2u* o8 = (GAS v2u*)(F.HA + (size_t)m * DM) + lane;
#pragma unroll
            for (int j = 0; j < 4; ++j) { const f32x4 vv = v[q][j]; ss += (vv[0] * vv[0] + vv[1] * vv[1]) + (vv[2] * vv[2] + vv[3] * vv[3]);
                const f32x4 h = vv * gr[64 * j] * (sr[64 * j] + 1.0f); v2u w; w.x = pk2(h[0], h[1]); w.y = pk2(h[2], h[3]); o8[64 * j] = w; }
            ss = wave_sum(ss);
            if (lane < 16) F.SSQ1[(size_t)lane * M + m] = lane == 0 ? ss : 0.f; }
    }
}
__device__ __forceinline__ void rstd_table(Frame& F, const pg8::StaticOrder& S, const float* ssq) {
    LAS float* tab = (LAS float*)(F.lds + RT_OFF);
    pg8::Unit u;
    for (int ui = 0; ui < 8 && S.next(ui, u); ++ui) {
        if (F.tid < 256) { const int row = u.pm * 256 + F.tid; float s = 0.f;
#pragma unroll
            for (int p = 0; p < 16; ++p) s += ssq[(size_t)p * M + row];
            tab[ui * 256 + F.tid] = __builtin_amdgcn_rsqf(s * (1.0f / DM) + EPS); }
    }
    LDS_WAIT(); __syncthreads();
}

__device__ __forceinline__ s16x4 vtr(const LAS unsigned char* p) { typedef short v4i16_t __attribute__((ext_vector_type(4))); return __builtin_bit_cast(s16x4, __builtin_amdgcn_ds_read_tr16_b64_v4i16((LAS v4i16_t*)p)); }
__device__ __forceinline__ void glds16(const void* gsrc, LAS unsigned char* dst) { __builtin_amdgcn_global_load_lds((const unsigned*)gsrc, (LAS unsigned*)dst, 16, 0, 0); }
__device__ __forceinline__ void attn_qk(f32x4 (&s)[2][4], const LAS unsigned char* kb_, bf16x8 q0, bf16x8 q1, f32x4 negM) {
    bf16x8 kf[8];
#pragma unroll
    for (int kb = 0; kb < 4; ++kb) { kf[2 * kb] = *(const LAS bf16x8*)(kb_ + kb * 256); kf[2 * kb + 1] = *(const LAS bf16x8*)(kb_ + 4096 + kb * 256); }
    asm volatile("s_waitcnt lgkmcnt(0)" : "+v"(kf[0]), "+v"(kf[1]), "+v"(kf[2]), "+v"(kf[3]), "+v"(kf[4]), "+v"(kf[5]), "+v"(kf[6]), "+v"(kf[7]) :: "memory");
    __builtin_amdgcn_sched_barrier(0);
#pragma unroll
    for (int kb = 0; kb < 4; ++kb) { s[0][kb] = __builtin_amdgcn_mfma_f32_16x16x32_bf16(kf[2 * kb], q0, negM, 0, 0, 0); s[1][kb] = __builtin_amdgcn_mfma_f32_16x16x32_bf16(kf[2 * kb + 1], q1, negM, 0, 0, 0); }
}
__device__ __forceinline__ void attn_exp(f32x4 (&s)[2][4], bf16x8 (&pw)[2][2], bool band, int key0, int qrow) {
    if (band) {
#pragma unroll
        for (int kb = 0; kb < 4; ++kb)
#pragma unroll
            for (int r = 0; r < 4; ++r) { const int key = key0 + 16 * kb + r; if (key > qrow) { s[0][kb][r] = -INFINITY; s[1][kb][r] = -INFINITY; } }
    }
#pragma unroll
    for (int kb = 0; kb < 4; ++kb)
#pragma unroll
        for (int r = 0; r < 4; ++r) { s[0][kb][r] = __builtin_amdgcn_exp2f(s[0][kb][r]); s[1][kb][r] = __builtin_amdgcn_exp2f(s[1][kb][r]); }
#pragma unroll
    for (int m = 0; m < 2; ++m)
#pragma unroll
        for (int ks = 0; ks < 2; ++ks) { v4u w; w.x = pg8::cvt_pk_bf16(s[m][2 * ks][0], s[m][2 * ks][1]); w.y = pg8::cvt_pk_bf16(s[m][2 * ks][2], s[m][2 * ks][3]);
            w.z = pg8::cvt_pk_bf16(s[m][2 * ks + 1][0], s[m][2 * ks + 1][1]); w.w = pg8::cvt_pk_bf16(s[m][2 * ks + 1][2], s[m][2 * ks + 1][3]); pw[m][ks] = __builtin_bit_cast(bf16x8, w); }
}
__device__ __forceinline__ void attn_pv(const bf16x8 (&pw)[2][2], f32x4 (&o)[2][4], f32x4 (&ol)[2], const LAS unsigned char* vb_, int vE, int vO) {
    const bf16x8 ones = (bf16x8){0x3F80, 0x3F80, 0x3F80, 0x3F80, 0x3F80, 0x3F80, 0x3F80, 0x3F80};
    const unsigned va0 = (unsigned)(size_t)(vb_ + vE), va1 = (unsigned)(size_t)(vb_ + vO);
    s16x4 lo[8], hi[8];
#define ATT_TR(dst, addr, off) asm volatile("ds_read_b64_tr_b16 %0, %1 offset:%c2" : "=&v"(dst) : "v"(addr), "i"(off) : "memory")
    ATT_TR(lo[0], va0, 0); ATT_TR(hi[0], va0, 1024); ATT_TR(lo[1], va1, 0); ATT_TR(hi[1], va1, 1024);
    ATT_TR(lo[2], va0, 4096); ATT_TR(hi[2], va0, 4096 + 1024); ATT_TR(lo[3], va1, 4096); ATT_TR(hi[3], va1, 4096 + 1024);
    ATT_TR(lo[4], va0, 2048); ATT_TR(hi[4], va0, 2048 + 1024); ATT_TR(lo[5], va1, 2048); ATT_TR(hi[5], va1, 2048 + 1024);
    ATT_TR(lo[6], va0, 4096 + 2048); ATT_TR(hi[6], va0, 4096 + 2048 + 1024); ATT_TR(lo[7], va1, 4096 + 2048); ATT_TR(hi[7], va1, 4096 + 2048 + 1024);
#undef ATT_TR
    asm volatile("s_waitcnt lgkmcnt(0)" : "+v"(lo[0]), "+v"(hi[0]), "+v"(lo[1]), "+v"(hi[1]), "+v"(lo[2]), "+v"(hi[2]), "+v"(lo[3]), "+v"(hi[3]), "+v"(lo[4]), "+v"(hi[4]), "+v"(lo[5]), "+v"(hi[5]), "+v"(lo[6]), "+v"(hi[6]), "+v"(lo[7]), "+v"(hi[7]) :: "memory");
    __builtin_amdgcn_sched_barrier(0);
#pragma unroll
    for (int ks = 0; ks < 2; ++ks) {
#pragma unroll
        for (int d0 = 0; d0 < 4; ++d0) { const int i = 4 * ks + d0;
            const bf16x8 vf = (bf16x8){lo[i][0], lo[i][1], lo[i][2], lo[i][3], hi[i][0], hi[i][1], hi[i][2], hi[i][3]};
            o[0][d0] = __builtin_amdgcn_mfma_f32_16x16x32_bf16(pw[0][ks], vf, o[0][d0], 0, 0, 0);
            o[1][d0] = __builtin_amdgcn_mfma_f32_16x16x32_bf16(pw[1][ks], vf, o[1][d0], 0, 0, 0); }
        ol[0] = __builtin_amdgcn_mfma_f32_16x16x32_bf16(pw[0][ks], ones, ol[0], 0, 0, 0);
        ol[1] = __builtin_amdgcn_mfma_f32_16x16x32_bf16(pw[1][ks], ones, ol[1], 0, 0, 0); }
}
__device__ __forceinline__ void attn_epilogue(Frame& F, const f32x4 (&o)[2][4], const f32x4 (&ol)[2], const float (&sgv)[4], float lam, bf16* op) {
    const int lane = F.lane;
#pragma unroll
    for (int r = 0; r < 4; ++r) {
        const float a0 = 1.0f / ol[0][r], a1 = lam / ol[1][r];
        float ov[4], ss = 0.f;
#pragma unroll
        for (int d0 = 0; d0 < 4; ++d0) { ov[d0] = o[0][d0][r] * a0 - o[1][d0][r] * a1; ss += ov[d0] * ov[d0]; }
        ss += __shfl_xor(ss, 1); ss += __shfl_xor(ss, 2); ss += __shfl_xor(ss, 4); ss += __shfl_xor(ss, 8);
        const float rn = __builtin_amdgcn_rsqf(ss * (1.0f / 64.0f) + EPS);
#pragma unroll
        for (int d0 = 0; d0 < 4; ++d0) op[(size_t)r * DM + 16 * d0] = (bf16)f2bf(ov[d0] * rn * sgv[d0]);
    }
    (void)lane;
}
__device__ __forceinline__ void attn_pair(Frame& F, int l, int b, int h, int sidx, int mode = 0) {
    const int lane = F.lane, wid = F.wave, fr = lane & 15, fq = lane >> 4;
    LAS unsigned char* lds = F.lds;
    const size_t rowbase = 0;
    const bf16* proj = F.PROJ + (size_t)b * (ACT_BSTRIDE / 2);
    bf16* mixb = F.MIX + (size_t)b * (ACT_BSTRIDE / 2);
    const int qbA = 15 - sidx, qbB = sidx, NTa = 2 * (qbA + 1), NTb = 2 * (qbB + 1), S = NTa + NTb;
    const bf16* qpA = proj + (rowbase + qbA * 128 + 16 * wid + fr) * NIN + h * 64 + 8 * fq;
    const bf16* qpB = proj + (rowbase + qbB * 128 + 16 * wid + fr) * NIN + h * 64 + 8 * fq;
    const bf16x8 qa0 = *(const bf16x8*)qpA, qa1 = *(const bf16x8*)(qpA + 32), qb0 = *(const bf16x8*)qpB, qb1 = *(const bf16x8*)(qpB + 32);
    const bf16* ksrc = proj + (rowbase + lane) * NIN + 256 + h * 64 + wid * 8;
    const bf16* vsrc = proj + (rowbase + 16 * (wid & 3) + (lane >> 2)) * NIN + 512 + h * 64 + (wid >> 2) * 32 + 8 * ((lane & 3) ^ (2 * ((lane >> 4) & 1)));
    LAS unsigned char* kdst = lds + wid * 1024;
    LAS unsigned char* vdst = lds + 65536 + wid * 1024;
    f32x4 o[2][4], ol[2];
#pragma unroll
    for (int m = 0; m < 2; ++m) { ol[m] = (f32x4){0.f, 0.f, 0.f, 0.f};
#pragma unroll
        for (int d = 0; d < 4; ++d) o[m][d] = (f32x4){0.f, 0.f, 0.f, 0.f}; }
    const int koff = fq * 1024 + fr * 16;
    const int prow = fr >> 2, pp = fr & 3;
    const int vrow = (4 * fq + prow) * 64 + (pp & 1) * 8 + (pp >> 1) * 16;
    const int vE = vrow + 32 * (fq & 1), vO = vrow + 32 * (1 - (fq & 1));
#define ATT_TILE(s) ((s) < NTa ? (s) : (s) - NTa)
#define ATT_SRC(s) ((size_t)ATT_TILE((s) < S ? (s) : S - 1) * 64 * NIN)
#define ATT_BAR(N) do { __builtin_amdgcn_sched_barrier(0); asm volatile("s_waitcnt vmcnt(" #N ") lgkmcnt(0)" ::: "memory"); __builtin_amdgcn_s_barrier(); asm volatile("" ::: "memory"); __builtin_amdgcn_sched_barrier(0); } while (0)
#define ATT_BARL() do { asm volatile("s_waitcnt lgkmcnt(0)" ::: "memory"); __builtin_amdgcn_s_barrier(); asm volatile("" ::: "memory"); } while (0)
    T0(10);
    glds16(ksrc + ATT_SRC(0), kdst);
    glds16(ksrc + ATT_SRC(1), kdst + 8192); glds16(vsrc + ATT_SRC(0), vdst);
    glds16(ksrc + ATT_SRC(2), kdst + 2 * 8192); glds16(vsrc + ATT_SRC(1), vdst + 8192);
    glds16(ksrc + ATT_SRC(3), kdst + 3 * 8192); glds16(vsrc + ATT_SRC(2), vdst + 2 * 8192);
    float lam, negMv, sgv[4];
    { const float* lp = inp(F, 10) + l * 128;
      float pa = lane < 32 ? lp[lane] * lp[32 + lane] : 0.f, pb = lane < 32 ? lp[64 + lane] * lp[96 + lane] : 0.f;
      pa = wave_sum(pa); pb = wave_sum(pb);
      const float lam_init = 0.8f - 0.6f * __expf(-0.3f * (float)l);
      lam = __expf(pa) - __expf(pb) + lam_init;
      const float gq = wave_max(fabsf(inp(F, 8)[l * 32 + (lane & 31)])), gk = wave_max(fabsf(inp(F, 9)[l * 32 + (lane & 31)]));
      negMv = -(QSCALE * 32.0f * gq * gk);
#pragma unroll
      for (int d0 = 0; d0 < 4; ++d0) sgv[d0] = inp(F, 11)[l * 64 + 16 * d0 + fr] * (1.0f - lam_init); }
    const f32x4 negM = (f32x4){negMv, negMv, negMv, negMv};
    ATT_BAR(0);
    f32x4 sA[2][4], sB[2][4]; bf16x8 pw[2][2];
#pragma unroll
    for (int m = 0; m < 2; ++m) { pw[m][0] = (bf16x8){0, 0, 0, 0, 0, 0, 0, 0}; pw[m][1] = pw[m][0]; sB[m][0] = negM; sB[m][1] = negM; sB[m][2] = negM; sB[m][3] = negM; }
    attn_qk(sA, lds + koff, qa0, qa1, negM);
    const bool late = wid >= 4;
    T1(10); T0(11);
#define ATT_A(s, CUR, NXT) do { \
        if (!(mode & 1)) { glds16(ksrc + ATT_SRC((s) + 4), kdst + (((s) + 4) & 7) * 8192); glds16(vsrc + ATT_SRC((s) + 3), vdst + (((s) + 3) & 7) * 8192); } \
        if ((s) + 1 < S && !(mode & 8)) { const bool nb_ = ((s) + 1 >= NTa); attn_qk(NXT, lds + (((s) + 1) & 7) * 8192 + koff, nb_ ? qb0 : qa0, nb_ ? qb1 : qa1, negM); } \
        { const bool inB_ = (s) >= NTa; const int tile_ = ATT_TILE(s), NTu_ = inB_ ? NTb : NTa, q0_ = (inB_ ? qbB : qbA) * 128; \
          if (!(mode & 2)) attn_exp(CUR, pw, tile_ >= NTu_ - 2, 64 * tile_ + 4 * fq, q0_ + 16 * wid + fr); } \
    } while (0)
#define ATT_B(s) do { \
        const bool inB_ = (s) >= NTa; const int tile_ = ATT_TILE(s), NTu_ = inB_ ? NTb : NTa, q0_ = (inB_ ? qbB : qbA) * 128; \
        if (!(mode & 4)) attn_pv(pw, o, ol, lds + 65536 + ((s) & 7) * 8192, vE, vO); \
        if (tile_ == NTu_ - 1) { attn_epilogue(F, o, ol, sgv, lam, mixb + (rowbase + q0_ + 16 * wid + 4 * fq) * DM + h * 64 + fr); \
            asm volatile("s_waitcnt vmcnt(0)" ::: "memory");      \
            _Pragma("unroll") for (int m_ = 0; m_ < 2; ++m_) { ol[m_] = (f32x4){0.f, 0.f, 0.f, 0.f}; _Pragma("unroll") for (int d_ = 0; d_ < 4; ++d_) o[m_][d_] = (f32x4){0.f, 0.f, 0.f, 0.f}; } } \
    } while (0)
#ifndef ATT_STAGGER
#define ATT_STAGGER 0
#endif
#if ATT_STAGGER
#define ATT_STEP(s, CUR, NXT) do { ATT_BAR(4); ATT_A(s, CUR, NXT); ATT_BAR(4); ATT_B(s); } while (0)
    if (late) ATT_BAR(4);
#else
#define ATT_STEP(s, CUR, NXT) do { ATT_BAR(4); ATT_A(s, CUR, NXT); ATT_B(s); } while (0)
#endif
#pragma unroll 1
    for (int s = 0; s < S; s += 2) { ATT_STEP(s, sA, sB); ATT_STEP(s + 1, sB, sA); }
#if ATT_STAGGER
    if (!late) ATT_BAR(4);
#endif
    (void)late;
    T1(11); T0(12);
#undef ATT_STEP
#undef ATT_A
#undef ATT_B
#undef ATT_TILE
#undef ATT_SRC
    ATT_BAR(0);
    T1(12);
#undef ATT_BAR
#undef ATT_BARL
}
__device__ __forceinline__ void attn_phase(Frame& F, int l, int mode = 0) {
    for (int pi = F.vcu; pi < 256; pi += F.G) {
        const int bh = pi >> 3, s = pi & 7;
        attn_pair(F, l, bh >> 2, bh & 3, s, mode);
    }
}
__device__ __forceinline__ unsigned bld(__amdgpu_buffer_rsrc_t r, int voff, int soff) { return __builtin_amdgcn_raw_buffer_load_b32(r, voff, soff, 0); }
__device__ __forceinline__ f32x2 bld2(__amdgpu_buffer_rsrc_t r, int voff, int soff) { typedef unsigned u2 __attribute__((ext_vector_type(2))); const u2 v = __builtin_amdgcn_raw_buffer_load_b64(r, voff, soff, 0); return __builtin_bit_cast(f32x2, v); }
__device__ __forceinline__ void mixer_tile(Frame& F, int l, int tt) {
    const int tid = F.tid, lane = F.lane; const int b = tt >> 5, s0 = (tt & 31) * 64; const int rowbase = 0;
    LAS float* cbuf = (LAS float*)F.lds;
    const int c2 = (tid & 127) * 2, tq = F.wave >> 1, sb = s0 + 16 * tq;
    bf16* projb = F.PROJ + (size_t)b * (ACT_BSTRIDE / 2); bf16* mixb = F.MIX + (size_t)b * (ACT_BSTRIDE / 2);
    const __amdgpu_buffer_rsrc_t rp = __builtin_amdgcn_make_buffer_rsrc((void*)projb, 0, (int)((size_t)SEQ * NIN * 2), 0x00020000);
    const __amdgpu_buffer_rsrc_t rm = __builtin_amdgcn_make_buffer_rsrc((void*)mixb, 0, (int)((size_t)SEQ * DM * 2), 0x00020000);
    const int vo = c2 * 2;
    unsigned hr[46];
    {
        unsigned prr[18], bgr[16], udr[31];
#pragma unroll
        for (int j = 0; j < 18; ++j) { const int s = sb - 2 + j, sc = s < 0 ? 0 : s; prr[j] = bld(rp, vo, (rowbase + sc) * (NIN * 2) + 1536 * 2); }
#pragma unroll
        for (int j = 0; j < 16; ++j) bgr[j] = bld(rp, vo, (rowbase + sb + j) * (NIN * 2) + 1280 * 2);
#pragma unroll
        for (int j = 0; j < 31; ++j) { const int s = sb - 15 + j, sc = s < 0 ? 0 : s; udr[j] = bld(rp, vo, (rowbase + sc) * (NIN * 2) + 2048 * 2); }
#pragma unroll
        for (int j = 0; j < 46; ++j) { const int s = sb - 30 + j, sc = s < 0 ? 0 : s; hr[j] = bld(rp, vo, (rowbase + sc) * (NIN * 2) + 768 * 2); }
        const __amdgpu_buffer_rsrc_t rw = __builtin_amdgcn_make_buffer_rsrc((void*)(inp(F, 16) + (size_t)l * 3 * 256), 0, 3 * 256 * 4, 0x00020000);
        f32x2 w3[3];
#pragma unroll
        for (int k = 0; k < 3; ++k) w3[k] = bld2(rw, c2 * 4, k * 1024);
        f32x2 pr[18];
#pragma unroll
        for (int j = 0; j < 18; ++j) { const float ok = (sb - 2 + j) >= 0 ? 1.f : 0.f; pr[j] = (f32x2){bflo(prr[j]) * ok, bfhi(prr[j]) * ok}; }
#pragma unroll
        for (int i = 0; i < 16; ++i) { const f32x2 cv = w3[0] * pr[i] + w3[1] * pr[i + 1] + w3[2] * pr[i + 2];
            __builtin_amdgcn_raw_buffer_store_b32(pk2(bflo(bgr[i]) * cv[0], bfhi(bgr[i]) * cv[1]), rm, vo, (rowbase + sb + i) * (DM * 2) + 512 * 2, 0); }
        const int grp = c2 >> 6;
        const float m1 = grp >= 1 ? 1.f : 0.f, m2 = grp >= 2 ? 1.f : 0.f, m3 = grp >= 3 ? 1.f : 0.f;
        f32x2 t[31], ut[16];
#pragma unroll
        for (int j = 0; j < 31; ++j) { const float ok = (sb - 15 + j) >= 0 ? 1.f : 0.f; t[j] = (f32x2){bflo(udr[j]) * ok, bfhi(udr[j]) * ok}; }
#pragma unroll
        for (int i = 0; i < 16; ++i) ut[i] = t[15 + i];
#pragma unroll
        for (int j = 30; j >= 1; --j) t[j] += t[j - 1];
#pragma unroll
        for (int j = 30; j >= 3; --j) t[j] += t[j - 2] * m1;
#pragma unroll
        for (int j = 30; j >= 7; --j) t[j] += t[j - 4] * m2;
#pragma unroll
        for (int j = 30; j >= 15; --j) t[j] += t[j - 8] * m3;
#pragma unroll
        for (int i = 0; i < 16; ++i) { const int win = 2 << grp, s = sb + i; const float rc = 1.0f / (float)((s + 1 < win) ? (s + 1) : win); const f32x2 y = t[15 + i] * rc - ut[i];
            __builtin_amdgcn_raw_buffer_store_b32(pk2(y[0], y[1]), rm, vo, (rowbase + s) * (DM * 2) + 768 * 2, 0); }
    }
    {
        const __amdgpu_buffer_rsrc_t rw = __builtin_amdgcn_make_buffer_rsrc((void*)(inp(F, 12) + (size_t)l * 31 * 256), 0, 31 * 256 * 4, 0x00020000);
        f32x2 w[31];
#pragma unroll
        for (int k = 0; k < 31; ++k) w[k] = bld2(rw, c2 * 4, k * 1024);
        f32x2 acc[16];
        const f32x2 bias = *(const f32x2*)(inp(F, 13) + l * 256 + c2);
#pragma unroll
        for (int i = 0; i < 16; ++i) acc[i] = bias;
#pragma unroll
        for (int j = 0; j < 46; ++j) { const float ok = (sb - 30 + j) >= 0 ? 1.f : 0.f;
            const f32x2 hv = (f32x2){bflo(hr[j]) * ok, bfhi(hr[j]) * ok};
#pragma unroll
            for (int i = 0; i < 16; ++i) { if (j - i >= 0 && j - i <= 30) acc[i] += w[j - i] * hv; } }
#pragma unroll
        for (int i = 0; i < 16; ++i) *(LAS f32x2*)(cbuf + (16 * tq + i) * 256 + c2) = acc[i];
    }
    LDS_WAIT(); __syncthreads();
    {
        const f32x4 g = *(const f32x4*)(inp(F, 14) + l * 256 + 4 * lane), bb = *(const f32x4*)(inp(F, 15) + l * 256 + 4 * lane);
#pragma unroll 2
        for (int i = 0; i < 8; ++i) { const int t = 8 * F.wave + i; const f32x4 v = *(const LAS f32x4*)(cbuf + t * 256 + 4 * lane);
            const float mu = wave_sum((v[0] + v[1]) + (v[2] + v[3])) * (1.0f / 256.0f); const f32x4 d = v - mu;
            const float var = wave_sum((d[0] * d[0] + d[1] * d[1]) + (d[2] * d[2] + d[3] * d[3])) * (1.0f / 256.0f);
            const float rs = __builtin_amdgcn_rsqf(var + EPS); f32x4 y = d * rs * g + bb;
            y[0] *= sigmoidf_(y[0]); y[1] *= sigmoidf_(y[1]); y[2] *= sigmoidf_(y[2]); y[3] *= sigmoidf_(y[3]);
            v2u w; w.x = pk2(y[0], y[1]); w.y = pk2(y[2], y[3]);
            *(v2u*)(mixb + ((size_t)rowbase + s0 + t) * DM + 256 + 4 * lane) = w; }
    }
    __syncthreads();
}

struct Args { const float* in[21]; float* out; unsigned char* ws; int ph_lo, ph_hi, li, pad; };
__global__ void __launch_bounds__(NWAVES * 64, 2) trunk_fwd(Args args) {
    extern __shared__ __attribute__((aligned(16))) unsigned char lds[];
    Frame F;
    F.lds = (LAS unsigned char*)lds;
    F.MISC = (volatile LAS unsigned*)(F.lds + MISC_OFF);
    F.tid = threadIdx.x; F.lane = F.tid & 63; F.wave = __builtin_amdgcn_readfirstlane(F.tid >> 6);
    const int wave0 = F.wave;
    F.G = gridDim.x; { const int bx = blockIdx.x; F.vcu = (F.G % 8 == 0) ? (bx % 8) * (F.G / 8) + bx / 8 : bx; }
    unsigned char* ws = args.ws; F.ws = ws;
    F.ctl = (gu32*)(ws + WS_CTL);
    F.out = args.out;
    F.MOD = (float*)(ws + WS_MOD); F.BIAS1 = (float*)(ws + WS_BIAS1); F.BIAS2 = (float*)(ws + WS_BIAS2); F.SSQ1 = (float*)(ws + WS_SSQ1); F.SSQ2 = (float*)(ws + WS_SSQ2);
    F.HA = (bf16*)(ws + WS_HA); F.XB = (bf16*)(ws + WS_XB); F.PROJ = (bf16*)(ws + WS_PROJ); F.MIX = (bf16*)(ws + WS_MIX); F.HID = (bf16*)(ws + WS_HID);
    for (int u = F.tid; u < (LDS_BYTES - LDSCTL_OFF) / 4; u += NWAVES * 64) ((LAS unsigned*)(F.lds + LDSCTL_OFF))[u] = 0u;
    __syncthreads();
    if (F.tid == 0) {
#pragma unroll
        for (int k = 0; k < 21; ++k) *(LAS unsigned long long*)(F.lds + PTR_OFF + 8 * k) = (unsigned long long)args.in[k]; }
    __syncthreads();
    XcdBarrier bar; bar.bar = (unsigned*)(F.ctl + CW_BAR); bar.x = 0; bar.st = nullptr; bar.gsize = 0;
    if (!MK_PER_PHASE) bar = xcd_barrier_post((unsigned*)(F.ctl + CW_BAR), F.MISC + 8, (unsigned)F.G);
    const bool grp = !MK_PER_PHASE && F.G == 256;
    XcdBarrier gbar = bar;
    if (grp) gbar = xcd_barrier_post((unsigned*)(F.ctl + CW_BAR) + (1 + (blockIdx.x & 7)) * XCD_BAR_WORDS, F.MISC + 10, (unsigned)(F.G / 8));
    const int lo = args.ph_lo, hi = args.ph_hi;
    F.tacc = 0ull; F.tt0 = 0ull;
#define IN(k) (lo <= (k) && (k) < hi)
#define SEAM(k) do { if (IN((k) + 1)) { if ((k) >= 2 && grp) xcd_barrier(gbar); else xcd_barrier(bar); } } while (0)
#define SEAMT(k, kind) do { T0((kind) + 16); SEAM(k); T1((kind) + 16); } while (0)

#ifndef PROBE_DUP
#define PROBE_DUP 0
#endif
#ifndef PROBE_N
#define PROBE_N 2
#endif
#define REPS(k) (((PROBE_DUP >> (k)) & 1) ? PROBE_N : 1)
    if (IN(0)) { T0(1); for (int rep = 0; rep < REPS(0); ++rep) { if (rep) xcd_barrier(bar);
        prep_layers(F, 0, PREP_UPFRONT ? DEPTH : 1, rep ? ((PROBE_DUP >> 8) & 15) : 3); } T1(1); SEAMT(0, 1); }
    if (IN(1)) { T0(2); for (int rep = 0; rep < REPS(1); ++rep) { if (rep) xcd_barrier(bar); p0b(F); } T1(2); SEAMT(1, 2); }
#pragma unroll 1
    for (int l = 0; l < DEPTH; ++l) {
        const int p = 2 + 5 * l;
        { int tl; asm volatile("v_mbcnt_lo_u32_b32 %0, -1, 0\n\tv_mbcnt_hi_u32_b32 %0, -1, %0\n\tv_lshl_or_b32 %0, %1, 6, %0" : "=&v"(tl) : "s"(wave0)); F.tid = tl; F.lane = tl & 63; F.wave = __builtin_amdgcn_readfirstlane(tl >> 6); }
        int bxl = blockIdx.x; asm volatile("" : "+s"(bxl));
        const float* modl = F.MOD + (size_t)l * 8 * NMOD;
        if (IN(p)) {
            T0(3);
            for (int rep = 0; rep < REPS(2); ++rep) { if (rep) { xcd_barrier(bar); int tl; asm volatile("v_mbcnt_lo_u32_b32 %0, -1, 0\n\tv_mbcnt_hi_u32_b32 %0, -1, %0\n\tv_lshl_or_b32 %0, %1, 6, %0" : "=&v"(tl) : "s"(wave0)); F.tid = tl; F.lane = tl & 63; F.wave = __builtin_amdgcn_readfirstlane(tl >> 6); asm volatile("" : "+s"(bxl)); }
            pg8::Gemm g{F.HA, wt_ptr(F, l, WT_IN), M, NIN, DM, 0}; pg8::StaticOrder S; S.init(M, NIN, F.G, bxl);
            rstd_table(F, S, F.SSQ1);
            pg8::EpiProj E{F.PROJ, F.BIAS1 + (size_t)l * 8 * NIN, (const LAS float*)(F.lds + RT_OFF), inp(F, 8) + l * 32, inp(F, 9) + l * 32, QSCALE, ACT_BSTRIDE / 2};
            pg8::gemm_phase<pg8::EpiProj, pg8::StaticOrder, true, true>(F.lds + RING_OFF, g, S, E, F.tid);
            }
            if (!PREP_UPFRONT && l + 1 < DEPTH) {
                { int tl; asm volatile("v_mbcnt_lo_u32_b32 %0, -1, 0\n\tv_mbcnt_hi_u32_b32 %0, -1, %0\n\tv_lshl_or_b32 %0, %1, 6, %0" : "=&v"(tl) : "s"(wave0)); F.tid = tl; F.lane = tl & 63; F.wave = __builtin_amdgcn_readfirstlane(tl >> 6); }
                prep_layers(F, l + 1, 1); }
            T1(3); SEAMT(p, 3);
        }
        if (IN(p + 1)) {
            T0(4);
            for (int rep = 0; rep < REPS(3); ++rep) { if (rep) xcd_barrier(bar); attn_phase(F, l, rep + 1 < REPS(3) ? ((PROBE_DUP >> 12) & 15) : 0); }
            T1(4); T0(5);
            for (int rep = 0; rep < REPS(4); ++rep) { if (rep) xcd_barrier(bar); for (int tt = F.vcu; tt < 256; tt += F.G) mixer_tile(F, l, tt); }
            if (!PREP_UPFRONT && l + 1 < DEPTH) bias_layers(F, l + 1, 1);
            T1(5); SEAMT(p + 1, 5);
        }
        if (IN(p + 2)) {
            T0(6);
            for (int rep = 0; rep < REPS(5); ++rep) { if (rep) { xcd_barrier(bar); int tl; asm volatile("v_mbcnt_lo_u32_b32 %0, -1, 0\n\tv_mbcnt_hi_u32_b32 %0, -1, %0\n\tv_lshl_or_b32 %0, %1, 6, %0" : "=&v"(tl) : "s"(wave0)); F.tid = tl; F.lane = tl & 63; F.wave = __builtin_amdgcn_readfirstlane(tl >> 6); asm volatile("" : "+s"(bxl)); }
            pg8::Gemm g{F.MIX, wt_ptr(F, l, WT_OUT), M, DM, DM, ACT_BSTRIDE - (size_t)SEQ * DM * 2}; pg8::StaticOrder S; S.init(M, DM, F.G, bxl);
            pg8::EpiRes E{(l == 0 || rep) ? inp(F, 0) : nullptr, F.XB, nullptr, rep ? F.PROJ : F.XB, modl + 2048, modl + 4096, inp(F, 5) + l * DM, rep ? (bf16*)((unsigned char*)F.PROJ + 32 * MiB) : F.HA, rep ? (float*)((unsigned char*)F.PROJ + 64 * MiB) : F.SSQ2, 1};
            pg8::gemm_phase<pg8::EpiRes, pg8::StaticOrder, true, true>(F.lds + RING_OFF, g, S, E, F.tid); }
            T1(6); SEAMT(p + 2, 6);
        }
        if (IN(p + 3)) {
            T0(7);
            for (int rep = 0; rep < REPS(6); ++rep) { if (rep) { xcd_barrier(bar); int tl; asm volatile("v_mbcnt_lo_u32_b32 %0, -1, 0\n\tv_mbcnt_hi_u32_b32 %0, -1, %0\n\tv_lshl_or_b32 %0, %1, 6, %0" : "=&v"(tl) : "s"(wave0)); F.tid = tl; F.lane = tl & 63; F.wave = __builtin_amdgcn_readfirstlane(tl >> 6); asm volatile("" : "+s"(bxl)); }
            pg8::Gemm g{F.HA, wt_ptr(F, l, WT_FF1), M, FF, DM, 0}; pg8::StaticOrder S; S.init(M, FF, F.G, bxl);
            rstd_table(F, S, F.SSQ2);
            pg8::EpiFF1 E{F.HID, F.BIAS2 + (size_t)l * 8 * FF, (const LAS float*)(F.lds + RT_OFF)};
            pg8::gemm_phase<pg8::EpiFF1, pg8::StaticOrder, true, true>(F.lds + RING_OFF, g, S, E, F.tid); }
            T1(7); SEAMT(p + 3, 7);
        }
        if (IN(p + 4)) {
            T0(8);
            for (int rep = 0; rep < REPS(7); ++rep) { if (rep) { xcd_barrier(bar); int tl; asm volatile("v_mbcnt_lo_u32_b32 %0, -1, 0\n\tv_mbcnt_hi_u32_b32 %0, -1, %0\n\tv_lshl_or_b32 %0, %1, 6, %0" : "=&v"(tl) : "s"(wave0)); F.tid = tl; F.lane = tl & 63; F.wave = __builtin_amdgcn_readfirstlane(tl >> 6); asm volatile("" : "+s"(bxl)); }
            pg8::Gemm g{F.HID, wt_ptr(F, l, WT_FF2), M, DM, FF, 0}; pg8::StaticOrder S; S.init(M, DM, F.G, bxl);
            const int nl = l + 1 < DEPTH ? l + 1 : l;
            if (rep && l + 1 == DEPTH) break;
            pg8::EpiRes E{rep ? inp(F, 0) : nullptr, F.XB, (l + 1 == DEPTH && !rep) ? F.out : nullptr, rep ? (bf16*)F.out : F.XB, modl + 5120, F.MOD + (size_t)nl * 8 * NMOD + 1024, inp(F, 4) + nl * DM, rep ? (bf16*)((unsigned char*)F.out + 32 * MiB) : F.HA, rep ? (float*)(F.ws + WS_SSQ2) : F.SSQ1, (l + 1 < DEPTH || rep) ? 1 : 0};
            pg8::gemm_phase<pg8::EpiRes, pg8::StaticOrder, true, true>(F.lds + RING_OFF, g, S, E, F.tid); }
            T1(8); if (l + 1 < DEPTH) SEAMT(p + 4, 8);
        }
    }
    if (PROBE_T != 0 && blockIdx.x == 0 && threadIdx.x == 0) { const unsigned long long tend = __builtin_amdgcn_s_memrealtime() + 10ull * F.tacc; while (__builtin_amdgcn_s_memrealtime() < tend) __builtin_amdgcn_s_sleep(16); }
#undef IN
#undef SEAM
}

extern "C" void kernel_launch(void* const* d_in, const int* in_sizes, int n_in, void* d_out, int out_size, void* d_ws, size_t ws_size, hipStream_t stream) {
    static int grid = 0;
    if (grid == 0) {
        if (n_in != 21 || in_sizes[0] != M * DM || out_size != M * DM || ws_size < WS_END) { fprintf(stderr, "kernel_launch: unexpected problem shape (n_in %d, in0 %d, out %d, ws %zu, need %zu); nothing launched\n", n_in, n_in > 0 ? in_sizes[0] : -1, out_size, ws_size, (size_t)WS_END); grid = -1; return; }
        int dev = 0, cus = 0, per_cu = 0;
        if (hipGetDevice(&dev) != hipSuccess || hipDeviceGetAttribute(&cus, hipDeviceAttributeMultiprocessorCount, dev) != hipSuccess) { fprintf(stderr, "kernel_launch: device query failed\n"); grid = -1; return; }
        if (hipFuncSetAttribute((const void*)trunk_fwd, hipFuncAttributeMaxDynamicSharedMemorySize, LDS_BYTES) != hipSuccess) { fprintf(stderr, "kernel_launch: hipFuncSetAttribute failed\n"); grid = -1; return; }
        if (hipOccupancyMaxActiveBlocksPerMultiprocessor(&per_cu, (const void*)trunk_fwd, NWAVES * 64, LDS_BYTES) != hipSuccess || per_cu < 1) { fprintf(stderr, "kernel_launch: occupancy query reports %d workgroups per CU\n", per_cu); }
        (void)hipGetLastError();
        grid = cus;
    }
    if (grid < 0) return;
    if (hipMemsetAsync((char*)d_ws + WS_CTL, 0, CTL_ZERO_BYTES, stream) != hipSuccess) { fprintf(stderr, "kernel_launch: hipMemsetAsync failed\n"); return; }
    Args a{};
    for (int i = 0; i < 21; ++i) a.in[i] = (const float*)d_in[i];
    a.out = (float*)d_out; a.ws = (unsigned char*)d_ws;
#if MK_PER_PHASE
    for (int li = 0; li < N_PHASES; ++li) { a.ph_lo = li; a.ph_hi = li + 1; a.li = li;
        hipLaunchKernelGGL(trunk_fwd, dim3(grid), dim3(NWAVES * 64), LDS_BYTES, stream, a); }
#else
    a.ph_lo = 0; a.ph_hi = N_PHASES; a.li = 0;
    hipLaunchKernelGGL(trunk_fwd, dim3(grid), dim3(NWAVES * 64), LDS_BYTES, stream, a);
#endif
    const hipError_t le = hipPeekAtLastError();
    if (le != hipSuccess) fprintf(stderr, "kernel_launch: launch failed: %s\n", hipGetErrorName(le));
}
```

```cpp
#include <hip/hip_runtime.h>
#include <cstdio>
#include <cstdint>
#include <cmath>
namespace pg8 {
#define PG8_LAS __attribute__((address_space(3)))
typedef unsigned short bf16_t;
typedef short bf16x8 __attribute__((ext_vector_type(8)));
typedef float f32x4 __attribute__((ext_vector_type(4)));
typedef unsigned u32x4 __attribute__((ext_vector_type(4)));
constexpr int BM = 256, BK = 64, HALF = 128, HTB = HALF * BK * 2  , STAGE_BYTES = 8 * HTB, NXCD = 8, WGM = 8;

__host__ __device__ __forceinline__ int lds_byte(int r, int c) { const int st = (r >> 4) * 2 + (c >> 5), rr = r & 15, cc = c & 31, ob = rr * 64 + cc * 2; return st * 1024 + (ob ^ (((ob >> 9) & 1) << 5)); }
__host__ __device__ __forceinline__ void stage_rc(int b, int& R, int& C) { const int st = b / 1024, sb = b % 1024, swz = sb ^ (((sb >> 9) & 1) << 5); R = (st >> 1) * 16 + swz / 64; C = (st & 1) * 32 + (swz % 64) / 2; }
__host__ __device__ __forceinline__ int perm32(int rho) { const int n = rho >> 4, i = rho & 15; return 8 * (i >> 2) + 4 * n + (i & 3); }

struct Unit { int pm, pn; };
struct Gemm { const bf16_t* A; const bf16_t* Bt; int M, N, K; size_t gapA; };

struct StaticOrder {
    int nM, nN, nwg, G, c;
    __host__ __device__ void init(int M, int N, int G_, int c_) { nM = M / BM; nN = N / BM; nwg = nM * nN; G = G_; c = c_; }
    __host__ __device__ bool next(int i, Unit& u) const {
        const long L = (long)i * G + c; if (L >= nwg) return false;
        int wgid = (int)L; { const int q = nwg / NXCD, r = nwg % NXCD, xcd = wgid % NXCD, off = wgid / NXCD; wgid = (xcd < r ? xcd * (q + 1) : r * (q + 1) + (xcd - r) * q) + off; }
        const int nig = WGM * nN, gid = wgid / nig, fm = gid * WGM, gsz = (nM - fm) < WGM ? (nM - fm) : WGM;
        u.pm = fm + ((wgid % nig) % gsz); u.pn = (wgid % nig) / gsz; return true;
    }
    __device__ __forceinline__ void a_ready(const Unit&) const {}
    unsigned* sig = nullptr; unsigned sig_nx = 2;
    __device__ __forceinline__ void done(const Unit& u, int wid) const {
        if (!sig || u.pn < 4) return;
        asm volatile("s_waitcnt vmcnt(0)" ::: "memory"); __syncthreads();
        if (wid == 0 && __builtin_amdgcn_mbcnt_hi(~0u, __builtin_amdgcn_mbcnt_lo(~0u, 0u)) == 0u) {
            if (sig_nx > 1u) { __builtin_amdgcn_fence(__ATOMIC_RELEASE, "agent"); asm volatile("s_waitcnt vmcnt(0)" ::: "memory"); }
            __hip_atomic_fetch_add(sig + (u.pn >= 8 ? 1 : 0), 1u, __ATOMIC_RELAXED, __HIP_MEMORY_SCOPE_AGENT); }
    }
};


__device__ __forceinline__ unsigned cvt_pk_bf16(float lo, float hi) { unsigned r; asm volatile("v_cvt_pk_bf16_f32 %0, %1, %2" : "=v"(r) : "v"(lo), "v"(hi)); return r; }
typedef unsigned u32x2 __attribute__((ext_vector_type(2)));
__device__ __forceinline__ float dot4(f32x4 a) { return (a[0] * a[0] + a[1] * a[1]) + (a[2] * a[2] + a[3] * a[3]); }

struct EpiProj {
    static constexpr bool PERM = true, AFTER_DRAIN = false, PERM2 = false;
    bf16_t* O; const float* bias; const PG8_LAS float* rtab; const float* qg; const float* kg; float qscale; size_t obs;
    __device__ __forceinline__ void operator()(const f32x4 (&acc)[2][2][4][2], const Unit& u, int ui, int wr, int wc, int fr, int fq) const {
        const int b = u.pm >> 3;
        const int row0 = (u.pm & 7) * BM + wr * 64 + fr, col0 = u.pn * BM + wc * 32 + 8 * fq;
        bf16_t* Ob = O + (size_t)b * obs;
        const float* bp = bias + b * 2304 + col0;
        f32x4 bv[2][2];
        if (ui < 7) { const PG8_LAS float* bt = rtab + 2048 + ui * 256 + wc * 32 + 8 * fq;
#pragma unroll
            for (int bj = 0; bj < 2; ++bj)
#pragma unroll
                for (int n = 0; n < 2; ++n) bv[bj][n] = *(const PG8_LAS f32x4*)(bt + bj * HALF + 4 * n);
        } else {
#pragma unroll
            for (int bj = 0; bj < 2; ++bj)
#pragma unroll
                for (int n = 0; n < 2; ++n) bv[bj][n] = *(const f32x4*)(bp + bj * HALF + 4 * n);
        }
        const PG8_LAS float* rt = rtab + ui * 256 + wr * 64 + fr;
        const int kind = (u.pn == 3 || u.pn == 4) ? 1 : ((u.pn == 6 || u.pn == 7) ? 2 : 0);
        if (kind) {
            const int ocol = (kind == 1 ? 768 + (u.pn - 3) * 128 : 1536 + (u.pn - 6) * 128) + wc * 32 + 8 * fq;
#pragma unroll
            for (int ai = 0; ai < 2; ++ai)
#pragma unroll
                for (int m = 0; m < 4; ++m) { const float rs = rt[ai * HALF + m * 16];
                    const f32x4 a0 = acc[ai][0][m][0] * rs + bv[0][0], a1 = acc[ai][0][m][1] * rs + bv[0][1], g0 = acc[ai][1][m][0] * rs + bv[1][0], g1 = acc[ai][1][m][1] * rs + bv[1][1];
                    f32x4 v0, v1;
                    if (kind == 1) {
#pragma unroll
                        for (int i = 0; i < 4; ++i) { v0[i] = a0[i] * __builtin_amdgcn_rcpf(1.0f + __expf(-g0[i])); v1[i] = a1[i] * __builtin_amdgcn_rcpf(1.0f + __expf(-g1[i])); }
                    } else { v0 = a0 * g0; v1 = a1 * g1; }
                    u32x4 w; w.x = cvt_pk_bf16(v0[0], v0[1]); w.y = cvt_pk_bf16(v0[2], v0[3]); w.z = cvt_pk_bf16(v1[0], v1[1]); w.w = cvt_pk_bf16(v1[2], v1[3]);
                    *(u32x4*)(Ob + (size_t)(row0 + ai * HALF + m * 16) * 2304 + ocol) = w; }
            return;
        }
        const bool isqk = u.pn < 2;
        f32x4 g0 = (f32x4){1.f, 1.f, 1.f, 1.f}, g1 = g0;
        if (isqk) { const float* gp = (u.pn == 0 ? qg : kg) + 8 * fq; g0 = *(const f32x4*)gp; g1 = *(const f32x4*)(gp + 4); if (u.pn == 0) { g0 = g0 * qscale; g1 = g1 * qscale; } }
#pragma unroll
        for (int ai = 0; ai < 2; ++ai)
#pragma unroll
            for (int m = 0; m < 4; ++m) { const float rs = rt[ai * HALF + m * 16]; bf16_t* rowp = Ob + (size_t)(row0 + ai * HALF + m * 16) * 2304 + col0;
#pragma unroll
                for (int bj = 0; bj < 2; ++bj) { f32x4 v0 = acc[ai][bj][m][0] * rs + bv[bj][0], v1 = acc[ai][bj][m][1] * rs + bv[bj][1];
                    if (isqk) { float ss = dot4(v0) + dot4(v1); ss += __shfl_xor(ss, 16); ss += __shfl_xor(ss, 32);
                        const float r = __builtin_amdgcn_rsqf(ss * (1.0f / 32.0f) + 1e-6f); v0 = v0 * r * g0; v1 = v1 * r * g1; }
                    u32x4 w; w.x = cvt_pk_bf16(v0[0], v0[1]); w.y = cvt_pk_bf16(v0[2], v0[3]); w.z = cvt_pk_bf16(v1[0], v1[1]); w.w = cvt_pk_bf16(v1[2], v1[3]);
                    *(u32x4*)(rowp + bj * HALF) = w; } }
    }
};
struct EpiFF1 {
    static constexpr bool PERM = true, AFTER_DRAIN = false, PERM2 = true;
    bf16_t* O; const float* bias; const PG8_LAS float* rtab;
    __device__ __forceinline__ void operator()(const f32x4 (&acc)[2][2][4][2], const Unit& u, int ui, int wr, int wc, int fr, int fq) const {
        const int b = u.pm >> 3;
        const int row0 = u.pm * BM + wr * 64 + fr, col0 = u.pn * BM + wc * 64 + 8 * fq;
        const float* bp = bias + b * 4096 + col0;
        f32x4 bv[2][2];
        if (ui < 7) { const PG8_LAS float* bt = rtab + 2048 + ui * 256 + wc * 64 + 8 * fq;
#pragma unroll
            for (int bj = 0; bj < 2; ++bj)
#pragma unroll
                for (int n = 0; n < 2; ++n) bv[bj][n] = *(const PG8_LAS f32x4*)(bt + bj * 32 + 4 * n);
        } else {
#pragma unroll
            for (int bj = 0; bj < 2; ++bj)
#pragma unroll
                for (int n = 0; n < 2; ++n) bv[bj][n] = *(const f32x4*)(bp + bj * 32 + 4 * n);
        }
        const PG8_LAS float* rt = rtab + ui * 256 + wr * 64 + fr;
        const f32x4 z = (f32x4){0.f, 0.f, 0.f, 0.f};
        const bool lo = fr < 8;
#pragma unroll
        for (int ai = 0; ai < 2; ++ai)
#pragma unroll
            for (int m = 0; m < 4; ++m) { const float rs = rt[ai * HALF + m * 16]; const int row = row0 + ai * HALF + m * 16;
                u32x4 w[2];
#pragma unroll
                for (int bj = 0; bj < 2; ++bj) { f32x4 v0 = acc[ai][bj][m][0] * rs + bv[bj][0], v1 = acc[ai][bj][m][1] * rs + bv[bj][1];
                    v0 = __builtin_elementwise_max(v0, z); v1 = __builtin_elementwise_max(v1, z); v0 = v0 * v0; v1 = v1 * v1;
                    w[bj].x = cvt_pk_bf16(v0[0], v0[1]); w[bj].y = cvt_pk_bf16(v0[2], v0[3]); w[bj].z = cvt_pk_bf16(v1[0], v1[1]); w[bj].w = cvt_pk_bf16(v1[2], v1[3]); }
                u32x4 x;
                x.x = (unsigned)__builtin_amdgcn_update_dpp(0, (int)w[1].x, 0x128, 0xf, 0xf, false); x.y = (unsigned)__builtin_amdgcn_update_dpp(0, (int)w[1].y, 0x128, 0xf, 0xf, false);
                x.z = (unsigned)__builtin_amdgcn_update_dpp(0, (int)w[1].z, 0x128, 0xf, 0xf, false); x.w = (unsigned)__builtin_amdgcn_update_dpp(0, (int)w[1].w, 0x128, 0xf, 0xf, false);
                bf16_t* pa = O + (size_t)(lo ? row : row - 8) * 4096 + (lo ? col0 : col0 + 32);
                bf16_t* pb = O + (size_t)(lo ? row + 8 : row) * 4096 + (lo ? col0 + 32 : col0);
                *(u32x4*)pa = lo ? w[0] : x;
                *(u32x4*)pb = lo ? x : w[0]; }
    }
};
struct EpiRes {
    static constexpr bool PERM = true, AFTER_DRAIN = false, PERM2 = false;
    const float* xin_f; const float* psc; const float* png; float* xout_f; const float* gate; const float* nsc; const float* ng; bf16_t* hA; float* ssq; int write_next; PG8_LAS float* ctab;
    static __device__ __forceinline__ float clamp_scale(float v) { return __builtin_fabsf(v) < 1e-20f ? 1e-20f : v; }
    __device__ __forceinline__ void operator()(const f32x4 (&acc)[2][2][4][2], const Unit& u, int ui, int wr, int wc, int fr, int fq) const {
        const int b = u.pm >> 3;
        const int col0 = u.pn * BM + wc * 32 + 8 * fq;
        PG8_LAS float* tab = ctab + (wr * 4 + wc) * 192;
        { const int i = fq * 16 + fr, c = u.pn * BM + wc * 32 + (i & 31) + (i >> 5) * HALF;
            const float gvv = gate[b * 6144 + c];
            float gmv = 0.f, ivv = 0.f;
            if (write_next) gmv = clamp_scale(ng[c] * (nsc[b * 6144 + c] + 1.0f));
            if (!xin_f) ivv = __builtin_amdgcn_rcpf(clamp_scale(png[c] * (psc[b * 6144 + c] + 1.0f)));
            tab[i] = gvv; tab[64 + i] = gmv; tab[128 + i] = ivv; }
        const __amdgpu_buffer_rsrc_t rh = __builtin_amdgcn_make_buffer_rsrc((void*)hA, 0, 16384 * 1024 * 2, 0x00020000);
        const __amdgpu_buffer_rsrc_t ri = __builtin_amdgcn_make_buffer_rsrc((void*)(xin_f ? xin_f : (const float*)hA), 0, xin_f ? 16384 * 1024 * 4 : 0, 0x00020000);
        const __amdgpu_buffer_rsrc_t ro = __builtin_amdgcn_make_buffer_rsrc((void*)(xout_f ? xout_f : (float*)hA), 0, xout_f ? 16384 * 1024 * 4 : 0, 0x00020000);
        const int vo = ((u.pm * BM + wr * 64 + fr) * 1024 + col0) * 2;
#pragma unroll
        for (int ai = 0; ai < 2; ++ai) {
            u32x4 xr[4][2];
            if (!xin_f) {
#pragma unroll
                for (int m = 0; m < 4; ++m)
#pragma unroll
                    for (int bj = 0; bj < 2; ++bj) xr[m][bj] = *(const u32x4*)((const char*)hA + (unsigned)(vo + ((ai * 128 + m * 16) * 1024 + bj * HALF) * 2));
            }
            float ssm[4] = {0.f, 0.f, 0.f, 0.f};
#pragma unroll
            for (int bj = 0; bj < 2; ++bj) {
                f32x4 gv[2], gm[2], iv[2];
#pragma unroll
                for (int n = 0; n < 2; ++n) { gv[n] = *(const PG8_LAS f32x4*)(tab + bj * 32 + 8 * fq + 4 * n); gm[n] = *(const PG8_LAS f32x4*)(tab + 64 + bj * 32 + 8 * fq + 4 * n); iv[n] = *(const PG8_LAS f32x4*)(tab + 128 + bj * 32 + 8 * fq + 4 * n); }
#define EPIRES_EMIT(m, xi0, xi1) do { const int so = ((ai * 128 + (m) * 16) * 1024 + bj * HALF) * 2; \
                    const f32x4 xo0 = (xi0) + gv[0] * acc[ai][bj][m][0], xo1 = (xi1) + gv[1] * acc[ai][bj][m][1]; ssm[m] += dot4(xo0) + dot4(xo1); \
                    if (xout_f) { *(f32x4*)((char*)xout_f + (unsigned)(vo * 2 + so * 2)) = xo0; *(f32x4*)((char*)xout_f + (unsigned)(vo * 2 + so * 2 + 16)) = xo1; } \
                    if (write_next) { const f32x4 h0 = xo0 * gm[0], h1 = xo1 * gm[1]; u32x4 w; w.x = cvt_pk_bf16(h0[0], h0[1]); w.y = cvt_pk_bf16(h0[2], h0[3]); w.z = cvt_pk_bf16(h1[0], h1[1]); w.w = cvt_pk_bf16(h1[2], h1[3]); \
                        *(u32x4*)((char*)hA + (unsigned)(vo + so)) = w; } } while (0)
                if (xin_f) {
                    f32x4 xf[4][2];
#pragma unroll
                    for (int m = 0; m < 4; ++m) { const int so = ((ai * 128 + m * 16) * 1024 + bj * HALF) * 2;
                        xf[m][0] = __builtin_nontemporal_load((const f32x4*)((const char*)xin_f + (unsigned)(vo * 2 + so * 2))); xf[m][1] = __builtin_nontemporal_load((const f32x4*)((const char*)xin_f + (unsigned)(vo * 2 + so * 2 + 16))); }
#pragma unroll
                    for (int m = 0; m < 4; ++m) EPIRES_EMIT(m, xf[m][0], xf[m][1]);
                } else {
#pragma unroll
                    for (int m = 0; m < 4; ++m) { const u32x4 t = xr[m][bj];
                        const f32x4 xi0 = (f32x4){__builtin_bit_cast(float, t.x << 16), __builtin_bit_cast(float, t.x & 0xffff0000u), __builtin_bit_cast(float, t.y << 16), __builtin_bit_cast(float, t.y & 0xffff0000u)} * iv[0];
                        const f32x4 xi1 = (f32x4){__builtin_bit_cast(float, t.z << 16), __builtin_bit_cast(float, t.z & 0xffff0000u), __builtin_bit_cast(float, t.w << 16), __builtin_bit_cast(float, t.w & 0xffff0000u)} * iv[1];
                        EPIRES_EMIT(m, xi0, xi1); }
                }
#undef EPIRES_EMIT
                asm volatile("" ::: "memory"); }
#pragma unroll
            for (int m = 0; m < 4; ++m) { const int row = u.pm * BM + ai * HALF + wr * 64 + m * 16 + fr; float ss = ssm[m];
                ss += __shfl_xor(ss, 16); ss += __shfl_xor(ss, 32);
                if (write_next && fq == 0) ssq[(size_t)(u.pn * 4 + wc) * 16384 + row] = ss; }
            asm volatile("" ::: "memory"); }
    }
};

template <class Epi, class Sched, bool ALIGN_EPI = false, bool SP2 = false>
__device__ __forceinline__ void gemm_phase(PG8_LAS unsigned char* lds, const Gemm g, const Sched& S, const Epi& E, const int tid_in) {
    const int tid = tid_in, wid = __builtin_amdgcn_readfirstlane(tid >> 6), lane = tid & 63, wr = wid >> 2, wc = wid & 3, fr = lane & 15, fq = lane >> 4;
    const int K = g.K, nt = K / BK;
#ifndef PROBE_T
#define PROBE_T 0
#endif
#define PG8_TQ ((volatile PG8_LAS unsigned long long*)(lds + 131072 + 320 + 64))
#define PG8_PH (g.N == 2304 ? 0 : (g.K == 4096 ? 3 : (g.N == 4096 ? 2 : 1)))
#define PG8_T0(part) do { if (PROBE_T >= 32 && (PROBE_T & 7) == (part) && ((PROBE_T >> 3) & 3) == PG8_PH && wid == 0) PG8_TQ[0] = __builtin_amdgcn_s_memrealtime(); } while (0)
#define PG8_T1(part) do { if (PROBE_T >= 32 && (PROBE_T & 7) == (part) && ((PROBE_T >> 3) & 3) == PG8_PH && wid == 0) PG8_TQ[1] += __builtin_amdgcn_s_memrealtime() - PG8_TQ[0]; } while (0)
    PG8_T0(0);
    unsigned voffA[2], voffB[2]; int aoff, boff;
#define PG8_LANE_SETUP() do { int t_ = tid; asm volatile("" : "+v"(t_)); const int fr_ = t_ & 15, fq_ = (t_ >> 4) & 3; \
    _Pragma("unroll") for (int i = 0; i < 2; ++i) { int R, C; stage_rc(t_ * 16 + i * 8192, R, C); const int Rb = Epi::PERM2 ? ((R >> 5) * 64 + perm32(R & 31)) : (Epi::PERM ? ((R & ~31) + perm32(R & 31)) : R); \
        voffA[i] = (unsigned)(R * K + C) * 2u; voffB[i] = (unsigned)(Rb * K + C) * 2u; } \
    aoff = lds_byte(wr * 64 + fr_, fq_ * 8); boff = lds_byte(wc * 32 + fr_, fq_ * 8); } while (0)
    PG8_LANE_SETUP();
    const size_t kstep = (size_t)(BK * 2);
    const size_t hstep = (size_t)HALF * K * 2;
    const size_t tstep = 2 * hstep;
    const size_t hstepB = Epi::PERM2 ? (size_t)32 * K * 2 : hstep;
    const unsigned ldsw = (unsigned)wid * 1024u;
#define PG8_SA(b, h) (((b) * 2 + (h)) * HTB)
#define PG8_SB(b, h) ((4 + (b) * 2 + (h)) * HTB)
#define PG8_STAGE(bufoff, gbase, voff) do { _Pragma("unroll") for (int _i = 0; _i < 2; ++_i) \
        __builtin_amdgcn_global_load_lds((const unsigned*)((const char*)(gbase) + (voff)[_i]), (PG8_LAS unsigned*)(lds + (bufoff) + ldsw + _i * 8192), 16, 0, 0); } while (0)
#define PG8_LDA(dst, b, h) do { _Pragma("unroll") for (int m = 0; m < 4; ++m) _Pragma("unroll") for (int k = 0; k < 2; ++k) dst[m][k] = *(const PG8_LAS bf16x8*)(lds + PG8_SA(b, h) + aoff + m * 2048 + k * 1024); } while (0)
#define PG8_LDB(dst, b, h) do { _Pragma("unroll") for (int n = 0; n < 2; ++n) _Pragma("unroll") for (int k = 0; k < 2; ++k) dst[n][k] = *(const PG8_LAS bf16x8*)(lds + PG8_SB(b, h) + boff + n * 2048 + k * 1024); } while (0)
#define PG8_MMA(ai, bj, At, Bt) do { __builtin_amdgcn_s_setprio(1); _Pragma("unroll") for (int m = 0; m < 4; ++m) _Pragma("unroll") for (int n = 0; n < 2; ++n) _Pragma("unroll") for (int k = 0; k < 2; ++k) \
        acc[ai][bj][m][n] = __builtin_amdgcn_mfma_f32_16x16x32_bf16(Bt[n][k], At[m][k], acc[ai][bj][m][n], 0, 0, 0); __builtin_amdgcn_s_setprio(0); } while (0)
#define PG8_WAIT_V(n) asm volatile("s_waitcnt vmcnt(" #n ")" ::: "memory")
#define PG8_WAIT_L(n) asm volatile("s_waitcnt lgkmcnt(" #n ")" ::: "memory")
#define PG8_BAR __builtin_amdgcn_s_barrier()
#define PG8_SCHED __builtin_amdgcn_sched_barrier(0)
    Unit cur, nxt; int ui = 0;
    if (!S.next(0, cur)) return;
    f32x4 acc[2][2][4][2];
#pragma unroll
    for (int a = 0; a < 2; ++a)
#pragma unroll
        for (int b = 0; b < 2; ++b)
#pragma unroll
            for (int m = 0; m < 4; ++m)
#pragma unroll
                for (int n = 0; n < 2; ++n) acc[a][b][m][n] = (f32x4){0.f, 0.f, 0.f, 0.f};
    bf16x8 At[4][2], B0[2][2], B1[2][2];
    const char* cA = (const char*)g.A + (size_t)cur.pm * tstep + (size_t)(cur.pm >> 3) * g.gapA; const char* cB = (const char*)g.Bt + (size_t)cur.pn * tstep;
    S.a_ready(cur);
    if constexpr (SP2) {
        PG8_STAGE(PG8_SB(0, 0), cB, voffB); PG8_STAGE(PG8_SB(0, 1), cB + hstepB, voffB); PG8_STAGE(PG8_SA(0, 0), cA, voffA); PG8_STAGE(PG8_SA(0, 1), cA + hstep, voffA);
        if (wr == 1) PG8_BAR;
        PG8_WAIT_V(2); PG8_BAR;
        PG8_STAGE(PG8_SB(1, 0), cB + kstep, voffB); PG8_STAGE(PG8_SA(1, 0), cA + kstep, voffA); PG8_STAGE(PG8_SB(1, 1), cB + hstepB + kstep, voffB);
        PG8_WAIT_V(6); PG8_BAR;
    } else {
        PG8_STAGE(PG8_SB(0, 0), cB, voffB); PG8_STAGE(PG8_SA(0, 0), cA, voffA); PG8_STAGE(PG8_SB(0, 1), cB + hstepB, voffB); PG8_STAGE(PG8_SA(0, 1), cA + hstep, voffA);
        if (wr == 1) PG8_BAR;
        PG8_WAIT_V(4); PG8_BAR;
        PG8_STAGE(PG8_SB(1, 0), cB + kstep, voffB); PG8_STAGE(PG8_SA(1, 0), cA + kstep, voffA); PG8_STAGE(PG8_SB(1, 1), cB + hstepB + kstep, voffB);
        PG8_WAIT_V(6); PG8_BAR;
    }
    PG8_T1(0);
    for (;;) {
        const bool has_next = S.next(ui + 1, nxt);
        const char* nA = has_next ? (const char*)g.A + (size_t)nxt.pm * tstep + (size_t)(nxt.pm >> 3) * g.gapA : cA; const char* nB = has_next ? (const char*)g.Bt + (size_t)nxt.pn * tstep : cB;
        PG8_T0(3);
        for (int t = 0; t < nt; t += 2) {
            const bool last = (t == nt - 2);
            const char* a1 = cA + (size_t)(t + 1) * kstep;
            const char* a2 = last ? nA : cA + (size_t)(t + 2) * kstep; const char* b2 = last ? nB : cB + (size_t)(t + 2) * kstep;
            const char* a3 = a2 + kstep; const char* b3 = b2 + kstep;
            if (last && has_next) S.a_ready(nxt);
            if constexpr (SP2) {
            PG8_LDB(B0, 0, 0); PG8_LDB(B1, 0, 1); PG8_SCHED; PG8_LDA(At, 0, 0); PG8_STAGE(PG8_SA(1, 1), a1 + hstep, voffA);
            PG8_WAIT_V(8); PG8_WAIT_L(0); PG8_BAR; PG8_MMA(0, 0, At, B0); PG8_MMA(0, 1, At, B1); PG8_BAR; PG8_SCHED;
            PG8_LDA(At, 0, 1); PG8_STAGE(PG8_SB(0, 0), b2, voffB); PG8_STAGE(PG8_SB(0, 1), b2 + hstepB, voffB); PG8_STAGE(PG8_SA(0, 0), a2, voffA);
            PG8_WAIT_V(8); PG8_WAIT_L(0); PG8_BAR; PG8_MMA(1, 0, At, B0); PG8_MMA(1, 1, At, B1); PG8_BAR; PG8_SCHED;
            PG8_LDB(B0, 1, 0); PG8_LDB(B1, 1, 1); PG8_SCHED; PG8_LDA(At, 1, 0); PG8_STAGE(PG8_SA(0, 1), a2 + hstep, voffA);
            PG8_WAIT_V(8); PG8_WAIT_L(0); PG8_BAR; PG8_MMA(0, 0, At, B0); PG8_MMA(0, 1, At, B1); PG8_BAR; PG8_SCHED;
            PG8_LDA(At, 1, 1); PG8_STAGE(PG8_SB(1, 0), b3, voffB); PG8_STAGE(PG8_SB(1, 1), b3 + hstepB, voffB); PG8_STAGE(PG8_SA(1, 0), a3, voffA);
            PG8_WAIT_V(8); PG8_WAIT_L(0); PG8_BAR; PG8_MMA(1, 0, At, B0); PG8_MMA(1, 1, At, B1); PG8_BAR; PG8_SCHED;
            } else {
            PG8_LDB(B0, 0, 0); PG8_SCHED; PG8_LDA(At, 0, 0); PG8_STAGE(PG8_SA(1, 1), a1 + hstep, voffA);
            PG8_WAIT_L(8); PG8_BAR; PG8_WAIT_L(0); PG8_MMA(0, 0, At, B0); PG8_BAR; PG8_SCHED;
            PG8_LDB(B1, 0, 1); PG8_STAGE(PG8_SB(0, 0), b2, voffB);
            PG8_BAR; PG8_WAIT_L(0); PG8_MMA(0, 1, At, B1); PG8_BAR;
            PG8_LDA(At, 0, 1); PG8_STAGE(PG8_SA(0, 0), a2, voffA);
            PG8_BAR; PG8_WAIT_L(0); PG8_MMA(1, 0, At, B0); PG8_BAR; PG8_SCHED;
            PG8_STAGE(PG8_SB(0, 1), b2 + hstepB, voffB);
            PG8_WAIT_V(6); PG8_BAR; PG8_MMA(1, 1, At, B1); PG8_BAR;
            PG8_LDB(B0, 1, 0); PG8_SCHED; PG8_LDA(At, 1, 0); PG8_STAGE(PG8_SA(0, 1), a2 + hstep, voffA);
            PG8_WAIT_L(8); PG8_BAR; PG8_WAIT_L(0); PG8_MMA(0, 0, At, B0); PG8_BAR; PG8_SCHED;
            PG8_LDB(B1, 1, 1); PG8_STAGE(PG8_SB(1, 0), b3, voffB);
            PG8_BAR; PG8_WAIT_L(0); PG8_MMA(0, 1, At, B1); PG8_BAR;
            PG8_LDA(At, 1, 1); PG8_STAGE(PG8_SA(1, 0), a3, voffA);
            PG8_BAR; PG8_WAIT_L(0); PG8_MMA(1, 0, At, B0); PG8_BAR; PG8_SCHED;
            PG8_STAGE(PG8_SB(1, 1), b3 + hstepB, voffB);
            PG8_WAIT_V(6); PG8_BAR; PG8_MMA(1, 1, At, B1); PG8_BAR;
            }
        }
        PG8_T1(3); PG8_T0(1);
        if constexpr (ALIGN_EPI) { if (wr == 0) PG8_BAR; }
        if constexpr (!Epi::AFTER_DRAIN) { E(acc, cur, ui, wr, wc, fr, fq); S.done(cur, wid); }
        PG8_T1(1);
        if (!has_next) break;
#pragma unroll
        for (int a = 0; a < 2; ++a)
#pragma unroll
            for (int b = 0; b < 2; ++b)
#pragma unroll
                for (int m = 0; m < 4; ++m)
#pragma unroll
                    for (int n = 0; n < 2; ++n) acc[a][b][m][n] = (f32x4){0.f, 0.f, 0.f, 0.f};
        cur = nxt; cA = nA; cB = nB; ++ui;
        PG8_LANE_SETUP();
        if constexpr (ALIGN_EPI) { if (wr == 1) PG8_BAR; }
    }
    PG8_T0(2);
    PG8_WAIT_V(0);
    if constexpr (!ALIGN_EPI) { if (wr == 0) PG8_BAR; }
    PG8_BAR;
    if constexpr (Epi::AFTER_DRAIN) { E.fused(acc, cur, wr, wc, fr, fq, lds, wid, lane); S.done(cur, wid); }
    PG8_T1(2);
#undef PG8_TQ
#undef PG8_PH
#undef PG8_T0
#undef PG8_T1
#undef PG8_LANE_SETUP
#undef PG8_SA
#undef PG8_SB
#undef PG8_STAGE
#undef PG8_LDA
#undef PG8_LDB
#undef PG8_MMA
#undef PG8_WAIT_V
#undef PG8_WAIT_L
#undef PG8_BAR
#undef PG8_SCHED
}
}

constexpr int NWAVES = 8;
constexpr int DM = 1024, BATCH = 8, SEQ = 2048, M = BATCH * SEQ, DEPTH = 4, NIN = 2304, FF = 4096, NMOD = 6144;
constexpr float EPS = 1e-6f;
constexpr float QSCALE = 0.17677669529663687f * 1.4426950408889634f;

#ifndef MK_PER_PHASE
#define MK_PER_PHASE 0
#endif
constexpr int N_PHASES = 2 + 5 * DEPTH;
#ifndef PROBE_T
#define PROBE_T 0
#endif
#define TQ ((volatile LAS unsigned long long*)(F.lds + MISC_OFF + 64))
#define T0(k) do { if (PROBE_T == (k) && F.wave == 0) TQ[0] = __builtin_amdgcn_s_memrealtime(); } while (0)
#define T1(k) do { if (PROBE_T == (k) && F.wave == 0) TQ[1] += __builtin_amdgcn_s_memrealtime() - TQ[0]; } while (0)
#ifndef PREP_UPFRONT
#define PREP_UPFRONT 1
#endif

constexpr size_t MiB = 1u << 20;
constexpr size_t WS_CTL = 0, CTL_ZERO_BYTES = 256 * 1024;
constexpr size_t WS_MOD = 1 * MiB;
constexpr size_t WS_BIAS1 = 2 * MiB;
constexpr size_t WS_BIAS2 = 3 * MiB;
constexpr size_t WS_SSQ1 = 4 * MiB, WS_SSQ2 = 5 * MiB;
constexpr size_t WS_WT = 8 * MiB;
constexpr size_t WT_IN = 0, WT_OUT = (size_t)NIN * DM * 2, WT_FF1 = WT_OUT + (size_t)DM * DM * 2, WT_FF2 = WT_FF1 + (size_t)FF * DM * 2, WT_LAYER = WT_FF2 + (size_t)FF * DM * 2;
constexpr size_t WS_HA = WS_WT + DEPTH * WT_LAYER;
constexpr size_t WS_XB = WS_HA + (size_t)M * DM * 2;
constexpr size_t ACT_BSTRIDE = (size_t)SEQ * FF * 2;
constexpr size_t ACT_MIXOFF = (size_t)SEQ * NIN * 2;
constexpr size_t WS_PROJ = WS_XB + (size_t)M * DM * 2;
constexpr size_t WS_MIX = WS_PROJ + ACT_MIXOFF;
constexpr size_t WS_HID = WS_PROJ;
constexpr size_t WS_END = WS_HID + (size_t)M * FF * 2;
static_assert(WT_LAYER == (size_t)(NIN + DM + FF + FF) * DM * 2 && WS_HA % 256 == 0 && WS_PROJ % 256 == 0 && ACT_MIXOFF % 256 == 0 && ACT_MIXOFF + (size_t)SEQ * DM * 2 <= ACT_BSTRIDE && ACT_BSTRIDE * BATCH == (size_t)M * FF * 2, "ws map");
constexpr int CW_BAR = 4096;

constexpr int RING_OFF = 0, RING_BYTES = 131072;
constexpr int LDSCTL_OFF = RING_BYTES, MISC_OFF = LDSCTL_OFF + 320;
constexpr int PTR_OFF = LDSCTL_OFF + 128;
constexpr int RT_OFF = LDSCTL_OFF + 512;
constexpr int LDS_BYTES = 147456;
static_assert(RT_OFF + 15 * 256 * 4 <= LDS_BYTES, "LDS map");

#define GAS __attribute__((address_space(1)))
#define LAS __attribute__((address_space(3)))
typedef unsigned short bf16;
typedef unsigned v4u __attribute__((ext_vector_type(4)));
typedef unsigned v2u __attribute__((ext_vector_type(2)));
typedef float f32x4 __attribute__((ext_vector_type(4)));
typedef float f32x2 __attribute__((ext_vector_type(2)));
typedef short bf16x8 __attribute__((ext_vector_type(8)));
typedef short s16x4 __attribute__((ext_vector_type(4)));
typedef GAS unsigned gu32;
#define RLX_AGENT __ATOMIC_RELAXED, __HIP_MEMORY_SCOPE_AGENT
#define LDS_WAIT() asm volatile("s_waitcnt lgkmcnt(0)" ::: "memory")
#define VM_WAIT() asm volatile("s_waitcnt vmcnt(0)" ::: "memory")
__device__ __forceinline__ unsigned f2bf(float f) { unsigned u = __builtin_bit_cast(unsigned, f); return (u + 0x7fffu + ((u >> 16) & 1u)) >> 16; }
__device__ __forceinline__ unsigned pk2(float lo, float hi) { return f2bf(lo) | (f2bf(hi) << 16); }
__device__ __forceinline__ float bflo(unsigned v) { return __builtin_bit_cast(float, v << 16); }
__device__ __forceinline__ float bfhi(unsigned v) { return __builtin_bit_cast(float, v & 0xffff0000u); }
__device__ __forceinline__ float wave_sum(float v) {
#pragma unroll
    for (int o = 1; o < 64; o <<= 1) v += __shfl_xor(v, o);
    return v;
}
__device__ __forceinline__ float wave_max(float v) {
#pragma unroll
    for (int o = 1; o < 64; o <<= 1) v = fmaxf(v, __shfl_xor(v, o));
    return v;
}
__device__ __forceinline__ float sigmoidf_(float v) { return 1.0f / (1.0f + __expf(-v)); }

#define XB_TMO      128
#define XB_XCNT(j)  (256  + 64 * (j))
#define XB_XSUB(j)  (1280 + 64 * (j))
#define XB_XGEN(j)  (2304 + 64 * (j))
#define XB_TOP      3328
#define XB_TOPGEN   3392
#define XCD_BAR_WORDS 3456
#define XB_SPIN_CAP (1u << 18)

__device__ __forceinline__ unsigned xb_ld(unsigned* p)              { return __hip_atomic_load(p, __ATOMIC_RELAXED, __HIP_MEMORY_SCOPE_AGENT); }
__device__ __forceinline__ unsigned xb_add(unsigned* p, unsigned v) { return __hip_atomic_fetch_add(p, v, __ATOMIC_RELAXED, __HIP_MEMORY_SCOPE_AGENT); }
__device__ __forceinline__ unsigned xb_xcc_id() { return (unsigned)__builtin_amdgcn_s_getreg((3 << 11) | 20) & 0xFu; }
#define XB_SPIN(cond, bar) do { unsigned _sp = 0; while (cond) { __builtin_amdgcn_s_sleep(1); \
    if ((++_sp & 255u) == 0u) { if (xb_ld(&(bar)[XB_TMO])) break; if (_sp > XB_SPIN_CAP) { atomicAdd(&(bar)[XB_TMO], 1u); break; } } } } while (0)

struct XcdBarrier { unsigned* bar; unsigned x; volatile LAS unsigned* st; unsigned gsize; };

__device__ __forceinline__ XcdBarrier xcd_barrier_post(unsigned* bar, volatile LAS unsigned* st, unsigned gsize) {
    XcdBarrier b; b.bar = bar; b.x = xb_xcc_id(); b.st = st; b.gsize = gsize;
    if (threadIdx.x == 0) (void)xb_add(&bar[XB_XCNT(b.x)], 1u);
    return b;
}
__device__ __forceinline__ void xcd_barrier_complete(unsigned* bar, unsigned x, unsigned G, unsigned& nloc, unsigned& nx) {
    unsigned sum, cnt, mine, sp = 0u;
    for (;;) {
        sum = 0u; cnt = 0u; mine = 0u;
#pragma unroll
        for (unsigned j = 0; j < 16; ++j) { const unsigned c = xb_ld(&bar[XB_XCNT(j)]); sum += c; cnt += (c > 0u) ? 1u : 0u; mine = (j == x) ? c : mine; }
        if (sum == G) break;
        __builtin_amdgcn_s_sleep(1);
        if ((++sp & 255u) == 0u) { if (xb_ld(&bar[XB_TMO])) break; if (sp > XB_SPIN_CAP) { atomicAdd(&bar[XB_TMO], 1u); break; } }
    }
    nloc = mine > 0u ? mine : 1u; nx = cnt > 0u ? cnt : 1u;
}
__device__ __forceinline__ void xcd_barrier(const XcdBarrier& b) {
    asm volatile("s_waitcnt vmcnt(0)" ::: "memory");
    __syncthreads();
    if (threadIdx.x == 0) {
        unsigned* bar = b.bar;
        __builtin_amdgcn_s_waitcnt(0);
        unsigned nloc = b.st[0], nx = b.st[1];
        if (nloc == 0u) { xcd_barrier_complete(bar, b.x, b.gsize, nloc, nx); b.st[0] = nloc; b.st[1] = nx; }
        const unsigned old = xb_add(&bar[XB_XSUB(b.x)], 1u);
        const unsigned gen = old / nloc;
        if (old + 1u == (gen + 1u) * nloc) {
            if (nx > 1u) {
                __builtin_amdgcn_fence(__ATOMIC_RELEASE, "agent");
                asm volatile("s_waitcnt vmcnt(0)" ::: "memory");
            }
            if (nx > 1u) {
                const unsigned og = xb_add(&bar[XB_TOP], 1u);
                const unsigned tg = og / nx;
                if (og + 1u == (tg + 1u) * nx) xb_add(&bar[XB_TOPGEN], 1u);
                else XB_SPIN(xb_ld(&bar[XB_TOPGEN]) == tg, bar);
            }
            __builtin_amdgcn_fence(__ATOMIC_ACQUIRE, "agent");
            xb_add(&bar[XB_XGEN(b.x)], 1u);
            asm volatile("s_waitcnt vmcnt(0)" ::: "memory");
        } else {
            XB_SPIN(xb_ld(&bar[XB_XGEN(b.x)]) == gen, bar);
            __builtin_amdgcn_fence(__ATOMIC_ACQUIRE, "agent");
            asm volatile("s_waitcnt vmcnt(0)" ::: "memory");
        }
    }
    __syncthreads();
}

struct Frame {
    LAS unsigned char* lds;
    volatile LAS unsigned* MISC;
    gu32* ctl;
    int tid, lane, wave;
    int vcu, G;
    float* out;
    unsigned char* ws;
    float *MOD, *BIAS1, *BIAS2, *SSQ1, *SSQ2;
    bf16 *HA, *XB, *PROJ, *MIX, *HID;
};
__device__ __forceinline__ const float* inp(const Frame& F, int k) {
    const unsigned long long v = *(const volatile LAS unsigned long long*)(F.lds + PTR_OFF + 8 * k);
    const unsigned lo = __builtin_amdgcn_readfirstlane((unsigned)v), hi = __builtin_amdgcn_readfirstlane((unsigned)(v >> 32));
    return (const float*)(((unsigned long long)hi << 32) | lo);
}
__device__ __forceinline__ bf16* wt_ptr(const Frame& F, int l, size_t off) { return (bf16*)(F.ws + WS_WT + (size_t)l * WT_LAYER + off); }

__device__ __forceinline__ void mod_item(Frame& F, int l, int strip) {
    const int j0 = strip * 256, tid = F.tid, lane = F.lane, wv = F.wave;
    LAS float* cact = (LAS float*)(F.lds);
    LAS float* red = (LAS float*)(F.lds + 32768);
    for (int i = tid; i < 8192; i += NWAVES * 64) { const int b = i >> 10, k = i & 1023; const float v = inp(F, 1)[b * 1024 + k]; cact[k * 8 + b] = v * sigmoidf_(v); }
    __syncthreads();
    {
        const __amdgpu_buffer_rsrc_t rw = __builtin_amdgcn_make_buffer_rsrc((void*)(inp(F, 2) + (size_t)l * 1024 * NMOD), 0, 1024 * NMOD * 4, 0x00020000);
        const int vo = (j0 + 4 * lane) * 4, so0 = 16 * wv * NMOD * 4;
        f32x4 acc[8];
#pragma unroll
        for (int b = 0; b < 8; ++b) acc[b] = (f32x4){0.f, 0.f, 0.f, 0.f};
#pragma unroll 1
        for (int ch = 0; ch < 8; ++ch) {
            f32x4 w[16];
#pragma unroll
            for (int k = 0; k < 16; ++k) { typedef unsigned u4_ __attribute__((ext_vector_type(4))); const u4_ t_ = __builtin_amdgcn_raw_buffer_load_b128(rw, vo, so0 + (ch * 128 + k) * NMOD * 4, 2); w[k] = __builtin_bit_cast(f32x4, t_); }
#pragma unroll
            for (int k = 0; k < 16; ++k) { const LAS f32x4* ca = (const LAS f32x4*)(cact + (ch * 128 + 16 * wv + k) * 8); const f32x4 c0 = ca[0], c1 = ca[1];
                acc[0] += w[k] * c0[0]; acc[1] += w[k] * c0[1]; acc[2] += w[k] * c0[2]; acc[3] += w[k] * c0[3]; acc[4] += w[k] * c1[0]; acc[5] += w[k] * c1[1]; acc[6] += w[k] * c1[2]; acc[7] += w[k] * c1[3]; }
        }
#pragma unroll
        for (int b = 0; b < 8; ++b) *(LAS f32x4*)(red + (wv * 8 + b) * 256 + 4 * lane) = acc[b];
    }
    LDS_WAIT(); __syncthreads();
#pragma unroll
    for (int q = 0; q < 4; ++q) { const int o = tid + 512 * q, b = o >> 8, cc = o & 255; float s = inp(F, 3)[l * NMOD + j0 + cc];
#pragma unroll
        for (int w = 0; w < 8; ++w) s += red[(w * 8 + b) * 256 + cc];
        F.MOD[((size_t)l * 8 + b) * NMOD + j0 + cc] = s; }
    __syncthreads();
}
constexpr int TS = 132;
struct TItem { const float* W; bf16* WT; const float* Wp; const float* psc; int K, N, k0, n0, perm; };
__device__ __forceinline__ int win_perm(int n) {
    if (n >= 768 && n < 1280) { const int g = n >= 1024, c = n - (g ? 1024 : 768); return 768 + (c >> 7) * 256 + g * 128 + (c & 127); }
    if (n >= 1536 && n < 2048) { const int g = n >= 1792, c = n - (g ? 1792 : 1536); return 1536 + (c >> 7) * 256 + g * 128 + (c & 127); }
    return n;
}
__device__ __forceinline__ void titem_load(const Frame& F, const TItem& t, f32x4 (&v)[8]) {
#pragma unroll
    for (int i = 0; i < 8; ++i) v[i] = __builtin_nontemporal_load((const f32x4*)(t.W + (size_t)(t.k0 + 16 * F.wave + 2 * i + (F.lane >> 5)) * t.N + t.n0 + 4 * (F.lane & 31)));
}
__device__ __forceinline__ void titem_process(Frame& F, const TItem& t, const f32x4 (&v)[8], int mode) {
    const int lane = F.lane, wv = F.wave;
    LAS float* tile = (LAS float*)(F.lds);
#pragma unroll
    for (int i = 0; i < 8; ++i) { const int kr = 16 * wv + 2 * i + (lane >> 5); f32x4 x = v[i]; if (t.psc) x = x * t.psc[kr]; if (mode < 3) *(LAS f32x4*)(tile + kr * TS + 4 * (lane & 31)) = x; else asm volatile("" :: "v"(x)); }
    LDS_WAIT(); __syncthreads();
    if (mode >= 2) return;
    if (t.Wp) {
        const int li = lane & 15, lk = lane >> 4;
        f32x4 acc[2][4];
#pragma unroll
        for (int gg = 0; gg < 2; ++gg)
#pragma unroll
            for (int ct = 0; ct < 4; ++ct) acc[gg][ct] = (f32x4){0.f, 0.f, 0.f, 0.f};
#pragma unroll 2
        for (int d0 = 0; d0 < 64; d0 += 4) {
#pragma unroll
            for (int gg = 0; gg < 2; ++gg) { const float bq = tile[(64 * gg + d0 + lk) * TS + 16 * wv + li];
#pragma unroll
                for (int ct = 0; ct < 4; ++ct) { const float a = t.Wp[gg * 4096 + (16 * ct + li) * 64 + d0 + lk]; acc[gg][ct] = __builtin_amdgcn_mfma_f32_16x16x4f32(a, bq, acc[gg][ct], 0, 0, 0); } }
        }
        LDS_WAIT(); __syncthreads();
#pragma unroll
        for (int gg = 0; gg < 2; ++gg)
#pragma unroll
            for (int ct = 0; ct < 4; ++ct)
#pragma unroll
                for (int r = 0; r < 4; ++r) tile[(64 * gg + 16 * ct + 4 * lk + r) * TS + 16 * wv + li] = acc[gg][ct][r];
        LDS_WAIT(); __syncthreads();
    }
    {
        const int n = F.tid & 127, cb = 4 * (F.tid >> 7);
        const int nr = t.perm ? win_perm(t.n0 + n) : t.n0 + n;
#pragma unroll
        for (int j = 0; j < 4; ++j) { const int c = cb + j; const LAS float* s = tile + (8 * c) * TS + n;
            v4u o; o.x = pk2(s[0 * TS], s[1 * TS]); o.y = pk2(s[2 * TS], s[3 * TS]); o.z = pk2(s[4 * TS], s[5 * TS]); o.w = pk2(s[6 * TS], s[7 * TS]);
            if (mode == 0) *(GAS v4u*)(t.WT + (size_t)nr * t.K + t.k0 + 8 * c) = o; else asm volatile("" :: "v"(o)); }
    }
    LDS_WAIT(); __syncthreads();
}
constexpr int TI_IN = (DM / 128) * (NIN / 128), TI_OUT = (DM / 128) * (DM / 128), TI_1 = (DM / 128) * (FF / 128), TI_2 = (FF / 128) * (DM / 128);
__device__ __forceinline__ bool titem_decode(const Frame& F, int it, int L0, int nl, TItem& t) {
    t.Wp = nullptr; t.psc = nullptr; t.perm = 0;
    if (it < 0) return false;
    int r = it;
    if (r < nl * TI_IN) { const int l = L0 + r / TI_IN; r %= TI_IN; t.W = inp(F, 6) + (size_t)l * DM * NIN; t.WT = wt_ptr(F, l, WT_IN); t.K = DM; t.N = NIN; t.k0 = 128 * (r / (NIN / 128)); t.n0 = 128 * (r % (NIN / 128)); t.perm = 1; return true; } r -= nl * TI_IN;
    if (r < nl * TI_OUT) { const int l = L0 + r / TI_OUT; r %= TI_OUT; const int kb = r / 8; t.W = inp(F, 7) + (size_t)l * DM * DM; t.WT = wt_ptr(F, l, WT_OUT); t.K = DM; t.N = DM; t.k0 = 128 * kb; t.n0 = 128 * (r % 8);
        if (kb >= 6) { t.Wp = inp(F, 17) + ((size_t)l * 4 + 2 * (kb - 6)) * 4096; t.psc = inp(F, 18) + l * 256 + 128 * (kb - 6); } return true; } r -= nl * TI_OUT;
    if (r < nl * TI_1) { const int l = L0 + r / TI_1; r %= TI_1; t.W = inp(F, 19) + (size_t)l * DM * FF; t.WT = wt_ptr(F, l, WT_FF1); t.K = DM; t.N = FF; t.k0 = 128 * (r / (FF / 128)); t.n0 = 128 * (r % (FF / 128)); return true; } r -= nl * TI_1;
    if (r < nl * TI_2) { const int l = L0 + r / TI_2; r %= TI_2; t.W = inp(F, 20) + (size_t)l * FF * DM; t.WT = wt_ptr(F, l, WT_FF2); t.K = FF; t.N = DM; t.k0 = 128 * (r / 8); t.n0 = 128 * (r % 8); return true; }
    return false;
}
__device__ __forceinline__ int draw_item(Frame& F, gu32* ctr, int slot) {
    volatile LAS unsigned* box = (volatile LAS unsigned*)(F.lds + LDSCTL_OFF + 64) + slot;
    if (F.tid == 0) *box = __hip_atomic_fetch_add(ctr, 1u, __ATOMIC_RELAXED, __HIP_MEMORY_SCOPE_AGENT);
    LDS_WAIT(); __syncthreads();
    const int it = (int)*box;
    return it;
}
__device__ __forceinline__ void prep_layers(Frame& F, int L0, int nl, int what = 3) {
    constexpr int I_MOD = NMOD / 256;
    gu32* ctr = F.ctl + 2048 + 128 * L0;
    T0(13);
    if (what & 1) {
#pragma unroll 1
        for (int k = 0;; ++k) { const int it = draw_item(F, ctr, k & 1); if (it >= nl * I_MOD) break; mod_item(F, L0 + it / I_MOD, it % I_MOD); }
    }
    T1(13); T0(14);
    if (!(what & 2)) return;
    const int mode = what >> 2;
    TItem cur, nxt; f32x4 v[8], vn[8];
    int k = 0;
    bool have = titem_decode(F, draw_item(F, ctr + 64, 2 + (k++ & 1)), L0, nl, cur);
    if (have) titem_load(F, cur, v);
#pragma unroll 1
    while (have) {
        const bool hn = titem_decode(F, draw_item(F, ctr + 64, 2 + (k++ & 1)), L0, nl, nxt);
        if (hn) titem_load(F, nxt, vn);
        titem_process(F, cur, v, mode);
        cur = nxt; have = hn;
#pragma unroll
        for (int i = 0; i < 8; ++i) v[i] = vn[i];
    }
}
__device__ __forceinline__ void bias_layers(Frame& F, int L0, int nl) {
    const int gw = F.vcu * NWAVES + F.wave, NGW = F.G * NWAVES, lane = F.lane;
    const int ncombo = 2 * nl, combo = gw % ncombo, wsub = gw / ncombo, nsub = NGW / ncombo;
    if (wsub >= nsub) return;
    const int l = L0 + (combo >> 1), kind = combo & 1, N = kind ? FF : NIN;
    const bf16* Wt = wt_ptr(F, l, kind ? WT_FF1 : WT_IN);
    const float* sh = F.MOD + (size_t)l * 8 * NMOD + (kind ? 3072 : 0);
    float* outp = kind ? F.BIAS2 + (size_t)l * 8 * FF : F.BIAS1 + (size_t)l * 8 * NIN;
    f32x4 shr[8][4];
#pragma unroll
    for (int b = 0; b < 8; ++b)
#pragma unroll
        for (int j = 0; j < 4; ++j) shr[b][j] = *(const f32x4*)(sh + (size_t)b * NMOD + 16 * lane + 4 * j);
#pragma unroll 1
    for (int n0 = wsub; n0 < N; n0 += 4 * nsub) {
        v4u w0[4], w1[4];
#pragma unroll
        for (int q = 0; q < 4; ++q) { const int n = (n0 + q * nsub < N) ? n0 + q * nsub : n0; w0[q] = *(const v4u*)(Wt + (size_t)n * DM + 16 * lane); w1[q] = *(const v4u*)(Wt + (size_t)n * DM + 16 * lane + 8); }
        float pr[32];
#pragma unroll
        for (int q = 0; q < 4; ++q) {
            const f32x4 wv0 = (f32x4){bflo(w0[q].x), bfhi(w0[q].x), bflo(w0[q].y), bfhi(w0[q].y)}, wv1 = (f32x4){bflo(w0[q].z), bfhi(w0[q].z), bflo(w0[q].w), bfhi(w0[q].w)};
            const f32x4 wv2 = (f32x4){bflo(w1[q].x), bfhi(w1[q].x), bflo(w1[q].y), bfhi(w1[q].y)}, wv3 = (f32x4){bflo(w1[q].z), bfhi(w1[q].z), bflo(w1[q].w), bfhi(w1[q].w)};
#pragma unroll
            for (int b = 0; b < 8; ++b) { const f32x4 t = shr[b][0] * wv0 + shr[b][1] * wv1 + shr[b][2] * wv2 + shr[b][3] * wv3; pr[8 * q + b] = (t[0] + t[1]) + (t[2] + t[3]); } }
#define BIAS_BFLY(half, off) do { const bool up = (lane & (off)) != 0; _Pragma("unroll") for (int i = 0; i < (half); ++i) { const float mine = up ? pr[i + (half)] : pr[i], other = up ? pr[i] : pr[i + (half)]; \
            pr[i] = mine + __shfl_xor(other, (off)); } } while (0)
        BIAS_BFLY(16, 32); BIAS_BFLY(8, 16); BIAS_BFLY(4, 8); BIAS_BFLY(2, 4); BIAS_BFLY(1, 2);
#undef BIAS_BFLY
        const float tot = pr[0] + __shfl_xor(pr[0], 1);
        { const int i = lane >> 1, q = i >> 3, b = i & 7, n = n0 + q * nsub;
            if (!(lane & 1) && n < N) outp[(size_t)b * N + n] = tot; }
    }
}
__device__ __forceinline__ void attn_scalars(Frame& F) {
    if (F.vcu != 0 || F.wave >= DEPTH) return;
    const int l = F.wave, lane = F.lane;
    const float* lp = inp(F, 10) + l * 128;
    float pa = lane < 32 ? lp[lane] * lp[32 + lane] : 0.f, pb = lane < 32 ? lp[64 + lane] * lp[96 + lane] : 0.f;
    pa = wave_sum(pa); pb = wave_sum(pb);
    const float lam_init = 0.8f - 0.6f * __expf(-0.3f * (float)l);
    const float lam = __expf(pa) - __expf(pb) + lam_init;
    const float gq = wave_max(fabsf(inp(F, 8)[l * 32 + (lane & 31)])), gk = wave_max(fabsf(inp(F, 9)[l * 32 + (lane & 31)]));
    float* tab = (float*)(F.ctl + 3200 + 80 * l);
    if (lane == 0) { tab[0] = lam; tab[1] = -(QSCALE * 32.0f * gq * gk); }
    tab[2 + lane] = inp(F, 11)[l * 64 + lane] * (1.0f - lam_init);
}
__device__ __forceinline__ void p0b(Frame& F) {
    attn_scalars(F);
    bias_layers(F, 0, PREP_UPFRONT ? DEPTH : 1);
    const int gw = F.vcu * NWAVES + F.wave, NGW = F.G * NWAVES, lane = F.lane;
    for (int m0 = gw; m0 < M; m0 += 4 * NGW) {
        f32x4 v[4][4];
#pragma unroll
        for (int q = 0; q < 4; ++q) { const int mr = (m0 + q * NGW < M) ? m0 + q * NGW : m0; const GAS f32x4* xr = (const GAS f32x4*)(inp(F, 0) + (size_t)mr * DM) + lane;
#pragma unroll
            for (int j = 0; j < 4; ++j) v[q][j] = __builtin_nontemporal_load(xr + 64 * j); }
#pragma unroll
        for (int q = 0; q < 4; ++q) { const int m = m0 + q * NGW, b = m >> 11; if (m >= M) break;
            const f32x4* gr = (const f32x4*)(inp(F, 4)) + lane; const f32x4* sr = (const f32x4*)(F.MOD + (size_t)b * NMOD + 1024) + lane;
            float ss = 0.f; GAS v2u* o8 = (GAS v2u*)(F.HA + (size_t)m * DM) + lane;
#pragma unroll
            for (int j = 0; j < 4; ++j) { const f32x4 vv = v[q][j]; ss += (vv[0] * vv[0] + vv[1] * vv[1]) + (vv[2] * vv[2] + vv[3] * vv[3]);
                const f32x4 h = vv * gr[64 * j] * (sr[64 * j] + 1.0f); v2u w; w.x = pk2(h[0], h[1]); w.y = pk2(h[2], h[3]); o8[64 * j] = w; }
            ss = wave_sum(ss);
            if (lane < 16) F.SSQ1[(size_t)lane * M + m] = lane == 0 ? ss : 0.f; }
    }
}
__device__ __forceinline__ void rstd_table(Frame& F, const pg8::StaticOrder& S, const float* ssq, const float* bias, int N) {
    LAS float* tab = (LAS float*)(F.lds + RT_OFF);
    pg8::Unit u; int prev = -1; float val = 0.f;
    for (int ui = 0; ui < 8 && S.next(ui, u); ++ui) {
        if (F.tid < 256) {
            if (u.pm != prev) { const int row = u.pm * 256 + F.tid; float s = 0.f;
#pragma unroll
                for (int p = 0; p < 16; ++p) s += ssq[(size_t)p * M + row];
                val = __builtin_amdgcn_rsqf(s * (1.0f / DM) + EPS); }
            tab[ui * 256 + F.tid] = val; }
        else if (ui < 7) tab[2048 + ui * 256 + (F.tid - 256)] = bias[(size_t)(u.pm >> 3) * N + u.pn * 256 + (F.tid - 256)];
        prev = u.pm;
    }
    LDS_WAIT(); __syncthreads();
}

__device__ __forceinline__ s16x4 vtr(const LAS unsigned char* p) { typedef short v4i16_t __attribute__((ext_vector_type(4))); return __builtin_bit_cast(s16x4, __builtin_amdgcn_ds_read_tr16_b64_v4i16((LAS v4i16_t*)p)); }
__device__ __forceinline__ void glds16(const void* gsrc, LAS unsigned char* dst) { __builtin_amdgcn_global_load_lds((const unsigned*)gsrc, (LAS unsigned*)dst, 16, 0, 0); }
__device__ __forceinline__ void attn_qk(f32x4 (&s)[2][4], const LAS unsigned char* kb_, bf16x8 q0, bf16x8 q1, f32x4 negM) {
    bf16x8 kf[8];
#pragma unroll
    for (int kb = 0; kb < 4; ++kb) { kf[2 * kb] = *(const LAS bf16x8*)(kb_ + kb * 256); kf[2 * kb + 1] = *(const LAS bf16x8*)(kb_ + 4096 + kb * 256); }
    asm volatile("s_waitcnt lgkmcnt(0)" : "+v"(kf[0]), "+v"(kf[1]), "+v"(kf[2]), "+v"(kf[3]), "+v"(kf[4]), "+v"(kf[5]), "+v"(kf[6]), "+v"(kf[7]) :: "memory");
    __builtin_amdgcn_sched_barrier(0);
#pragma unroll
    for (int kb = 0; kb < 4; ++kb) { s[0][kb] = __builtin_amdgcn_mfma_f32_16x16x32_bf16(kf[2 * kb], q0, negM, 0, 0, 0); s[1][kb] = __builtin_amdgcn_mfma_f32_16x16x32_bf16(kf[2 * kb + 1], q1, negM, 0, 0, 0); }
}
__device__ __forceinline__ void attn_exp(f32x4 (&s)[2][4], bf16x8 (&pw)[2][2], bool band, int key0, int qrow) {
    if (band) {
#pragma unroll
        for (int kb = 0; kb < 4; ++kb)
#pragma unroll
            for (int r = 0; r < 4; ++r) { const int key = key0 + 16 * kb + r; if (key > qrow) { s[0][kb][r] = -INFINITY; s[1][kb][r] = -INFINITY; } }
    }
#pragma unroll
    for (int kb = 0; kb < 4; ++kb)
#pragma unroll
        for (int r = 0; r < 4; ++r) { s[0][kb][r] = __builtin_amdgcn_exp2f(s[0][kb][r]); s[1][kb][r] = __builtin_amdgcn_exp2f(s[1][kb][r]); }
#pragma unroll
    for (int m = 0; m < 2; ++m)
#pragma unroll
        for (int ks = 0; ks < 2; ++ks) { v4u w; w.x = pg8::cvt_pk_bf16(s[m][2 * ks][0], s[m][2 * ks][1]); w.y = pg8::cvt_pk_bf16(s[m][2 * ks][2], s[m][2 * ks][3]);
            w.z = pg8::cvt_pk_bf16(s[m][2 * ks + 1][0], s[m][2 * ks + 1][1]); w.w = pg8::cvt_pk_bf16(s[m][2 * ks + 1][2], s[m][2 * ks + 1][3]); pw[m][ks] = __builtin_bit_cast(bf16x8, w); }
}
__device__ __forceinline__ void attn_pv(const bf16x8 (&pw)[2][2], f32x4 (&o)[2][4], f32x4 (&ol)[2], const LAS unsigned char* vb_, int vE, int vO) {
    const bf16x8 ones = (bf16x8){0x3F80, 0x3F80, 0x3F80, 0x3F80, 0x3F80, 0x3F80, 0x3F80, 0x3F80};
    const unsigned va0 = (unsigned)(size_t)(vb_ + vE), va1 = (unsigned)(size_t)(vb_ + vO);
    s16x4 lo[8], hi[8];
#define ATT_TR(dst, addr, off) asm volatile("ds_read_b64_tr_b16 %0, %1 offset:%c2" : "=&v"(dst) : "v"(addr), "i"(off) : "memory")
    ATT_TR(lo[0], va0, 0); ATT_TR(hi[0], va0, 1024); ATT_TR(lo[1], va1, 0); ATT_TR(hi[1], va1, 1024);
    ATT_TR(lo[2], va0, 4096); ATT_TR(hi[2], va0, 4096 + 1024); ATT_TR(lo[3], va1, 4096); ATT_TR(hi[3], va1, 4096 + 1024);
    ATT_TR(lo[4], va0, 2048); ATT_TR(hi[4], va0, 2048 + 1024); ATT_TR(lo[5], va1, 2048); ATT_TR(hi[5], va1, 2048 + 1024);
    ATT_TR(lo[6], va0, 4096 + 2048); ATT_TR(hi[6], va0, 4096 + 2048 + 1024); ATT_TR(lo[7], va1, 4096 + 2048); ATT_TR(hi[7], va1, 4096 + 2048 + 1024);
#undef ATT_TR
    asm volatile("s_waitcnt lgkmcnt(0)" : "+v"(lo[0]), "+v"(hi[0]), "+v"(lo[1]), "+v"(hi[1]), "+v"(lo[2]), "+v"(hi[2]), "+v"(lo[3]), "+v"(hi[3]), "+v"(lo[4]), "+v"(hi[4]), "+v"(lo[5]), "+v"(hi[5]), "+v"(lo[6]), "+v"(hi[6]), "+v"(lo[7]), "+v"(hi[7]) :: "memory");
    __builtin_amdgcn_sched_barrier(0);
#pragma unroll
    for (int ks = 0; ks < 2; ++ks) {
#pragma unroll
        for (int d0 = 0; d0 < 4; ++d0) { const int i = 4 * ks + d0;
            const bf16x8 vf = (bf16x8){lo[i][0], lo[i][1], lo[i][2], lo[i][3], hi[i][0], hi[i][1], hi[i][2], hi[i][3]};
            o[0][d0] = __builtin_amdgcn_mfma_f32_16x16x32_bf16(pw[0][ks], vf, o[0][d0], 0, 0, 0);
            o[1][d0] = __builtin_amdgcn_mfma_f32_16x16x32_bf16(pw[1][ks], vf, o[1][d0], 0, 0, 0); }
        ol[0] = __builtin_amdgcn_mfma_f32_16x16x32_bf16(pw[0][ks], ones, ol[0], 0, 0, 0);
        ol[1] = __builtin_amdgcn_mfma_f32_16x16x32_bf16(pw[1][ks], ones, ol[1], 0, 0, 0); }
}
__device__ __forceinline__ void attn_epilogue(Frame& F, const f32x4 (&o)[2][4], const f32x4 (&ol)[2], const float (&sgv)[4], float lam, bf16* op) {
    const int lane = F.lane;
#pragma unroll
    for (int r = 0; r < 4; ++r) {
        const float a0 = 1.0f / ol[0][r], a1 = lam / ol[1][r];
        float ov[4], ss = 0.f;
#pragma unroll
        for (int d0 = 0; d0 < 4; ++d0) { ov[d0] = o[0][d0][r] * a0 - o[1][d0][r] * a1; ss += ov[d0] * ov[d0]; }
        ss += __shfl_xor(ss, 1); ss += __shfl_xor(ss, 2); ss += __shfl_xor(ss, 4); ss += __shfl_xor(ss, 8);
        const float rn = __builtin_amdgcn_rsqf(ss * (1.0f / 64.0f) + EPS);
#pragma unroll
        for (int d0 = 0; d0 < 4; ++d0) op[(size_t)r * DM + 16 * d0] = (bf16)f2bf(ov[d0] * rn * sgv[d0]);
    }
    (void)lane;
}
__device__ __forceinline__ void attn_pair(Frame& F, int l, int b, int h, int sidx, int mode = 0) {
    const int lane = F.lane, wid = F.wave, fr = lane & 15, fq = lane >> 4;
    LAS unsigned char* lds = F.lds;
    const size_t rowbase = 0;
    const bf16* proj = F.PROJ + (size_t)b * (ACT_BSTRIDE / 2);
    bf16* mixb = F.MIX + (size_t)b * (ACT_BSTRIDE / 2);
    const int qbA = 15 - sidx, qbB = sidx, NTa = 2 * (qbA + 1), NTb = 2 * (qbB + 1), S = NTa + NTb;
    const bf16* qpA = proj + (rowbase + qbA * 128 + 16 * wid + fr) * NIN + h * 64 + 8 * fq;
    const bf16* qpB = proj + (rowbase + qbB * 128 + 16 * wid + fr) * NIN + h * 64 + 8 * fq;
    const bf16x8 qa0 = *(const bf16x8*)qpA, qa1 = *(const bf16x8*)(qpA + 32), qb0 = *(const bf16x8*)qpB, qb1 = *(const bf16x8*)(qpB + 32);
    const bf16* ksrc = proj + (rowbase + lane) * NIN + 256 + h * 64 + wid * 8;
    const bf16* vsrc = proj + (rowbase + 16 * (wid & 3) + (lane >> 2)) * NIN + 512 + h * 64 + (wid >> 2) * 32 + 8 * ((lane & 3) ^ (2 * ((lane >> 4) & 1)));
    LAS unsigned char* kdst = lds + wid * 1024;
    LAS unsigned char* vdst = lds + 65536 + wid * 1024;
    f32x4 o[2][4], ol[2];
#pragma unroll
    for (int m = 0; m < 2; ++m) { ol[m] = (f32x4){0.f, 0.f, 0.f, 0.f};
#pragma unroll
        for (int d = 0; d < 4; ++d) o[m][d] = (f32x4){0.f, 0.f, 0.f, 0.f}; }
    const int koff = fq * 1024 + fr * 16;
    const int prow = fr >> 2, pp = fr & 3;
    const int vrow = (4 * fq + prow) * 64 + (pp & 1) * 8 + (pp >> 1) * 16;
    const int vE = vrow + 32 * (fq & 1), vO = vrow + 32 * (1 - (fq & 1));
#define ATT_TILE(s) ((s) < NTa ? (s) : (s) - NTa)
#define ATT_SRC(s) ((size_t)ATT_TILE((s) < S ? (s) : S - 1) * 64 * NIN)
#define ATT_BAR(N) do { __builtin_amdgcn_sched_barrier(0); asm volatile("s_waitcnt vmcnt(" #N ") lgkmcnt(0)" ::: "memory"); __builtin_amdgcn_s_barrier(); asm volatile("" ::: "memory"); __builtin_amdgcn_sched_barrier(0); } while (0)
#define ATT_BARL() do { asm volatile("s_waitcnt lgkmcnt(0)" ::: "memory"); __builtin_amdgcn_s_barrier(); asm volatile("" ::: "memory"); } while (0)
    T0(10);
    const float* stab = (const float*)(F.ctl + 3200 + 80 * l);
    const float lam = stab[0], negMv = stab[1];
    float sgv[4];
#pragma unroll
    for (int d0 = 0; d0 < 4; ++d0) sgv[d0] = stab[2 + 16 * d0 + fr];
    asm volatile("" ::: "memory");
    glds16(ksrc + ATT_SRC(0), kdst);
    glds16(ksrc + ATT_SRC(1), kdst + 8192); glds16(vsrc + ATT_SRC(0), vdst);
    glds16(ksrc + ATT_SRC(2), kdst + 2 * 8192); glds16(vsrc + ATT_SRC(1), vdst + 8192);
    glds16(ksrc + ATT_SRC(3), kdst + 3 * 8192); glds16(vsrc + ATT_SRC(2), vdst + 2 * 8192);
    const f32x4 negM = (f32x4){negMv, negMv, negMv, negMv};
    ATT_BAR(6);
    f32x4 sA[2][4], sB[2][4]; bf16x8 pw[2][2];
#pragma unroll
    for (int m = 0; m < 2; ++m) { pw[m][0] = (bf16x8){0, 0, 0, 0, 0, 0, 0, 0}; pw[m][1] = pw[m][0]; sB[m][0] = negM; sB[m][1] = negM; sB[m][2] = negM; sB[m][3] = negM; }
    attn_qk(sA, lds + koff, qa0, qa1, negM);
    const bool late = wid >= 4;
    T1(10); T0(11);
#define ATT_A(s, CUR, NXT) do { \
        if (!(mode & 1)) { glds16(ksrc + ATT_SRC((s) + 4), kdst + (((s) + 4) & 7) * 8192); glds16(vsrc + ATT_SRC((s) + 3), vdst + (((s) + 3) & 7) * 8192); } \
        if ((s) + 1 < S && !(mode & 8)) { const bool nb_ = ((s) + 1 >= NTa); attn_qk(NXT, lds + (((s) + 1) & 7) * 8192 + koff, nb_ ? qb0 : qa0, nb_ ? qb1 : qa1, negM); } \
        { const bool inB_ = (s) >= NTa; const int tile_ = ATT_TILE(s), NTu_ = inB_ ? NTb : NTa, q0_ = (inB_ ? qbB : qbA) * 128; \
          if (!(mode & 2)) attn_exp(CUR, pw, tile_ >= NTu_ - 2, 64 * tile_ + 4 * fq, q0_ + 16 * wid + fr); } \
    } while (0)
#define ATT_B(s) do { \
        const bool inB_ = (s) >= NTa; const int tile_ = ATT_TILE(s), NTu_ = inB_ ? NTb : NTa, q0_ = (inB_ ? qbB : qbA) * 128; \
        if (!(mode & 4)) attn_pv(pw, o, ol, lds + 65536 + ((s) & 7) * 8192, vE, vO); \
        if (tile_ == NTu_ - 1) { attn_epilogue(F, o, ol, sgv, lam, mixb + (rowbase + q0_ + 16 * wid + 4 * fq) * DM + h * 64 + fr); \
            epi_lag = 3;      \
            _Pragma("unroll") for (int m_ = 0; m_ < 2; ++m_) { ol[m_] = (f32x4){0.f, 0.f, 0.f, 0.f}; _Pragma("unroll") for (int d_ = 0; d_ < 4; ++d_) o[m_][d_] = (f32x4){0.f, 0.f, 0.f, 0.f}; } } \
    } while (0)
#ifndef ATT_STAGGER
#define ATT_STAGGER 0
#endif
#if ATT_STAGGER
#define ATT_STEP(s, CUR, NXT) do { ATT_BAR(4); ATT_A(s, CUR, NXT); ATT_BAR(4); ATT_B(s); } while (0)
    if (late) ATT_BAR(4);
#else
#define ATT_STEP(s, CUR, NXT) do { if (epi_lag > 0) { ATT_BAR(20); --epi_lag; } else ATT_BAR(4); ATT_A(s, CUR, NXT); ATT_B(s); } while (0)
#endif
    int epi_lag = 0;
#pragma unroll 1
    for (int s = 0; s < S; s += 2) { ATT_STEP(s, sA, sB); ATT_STEP(s + 1, sB, sA); }
#if ATT_STAGGER
    if (!late) ATT_BAR(4);
#endif
    (void)late;
    T1(11); T0(12);
#undef ATT_STEP
#undef ATT_A
#undef ATT_B
#undef ATT_TILE
#undef ATT_SRC
    ATT_BAR(0);
    T1(12);
#undef ATT_BAR
#undef ATT_BARL
}
__device__ __forceinline__ void attn_phase(Frame& F, int l, int mode = 0) {
    for (int pi = F.vcu; pi < 256; pi += F.G) {
        const int bh = pi >> 3, s = pi & 7;
        attn_pair(F, l, bh >> 2, bh & 3, s, mode);
    }
}
__device__ __forceinline__ unsigned bld(__amdgpu_buffer_rsrc_t r, int voff, int soff) { return __builtin_amdgcn_raw_buffer_load_b32(r, voff, soff, 0); }
__device__ __forceinline__ f32x2 bld2(__amdgpu_buffer_rsrc_t r, int voff, int soff) { typedef unsigned u2 __attribute__((ext_vector_type(2))); const u2 v = __builtin_amdgcn_raw_buffer_load_b64(r, voff, soff, 0); return __builtin_bit_cast(f32x2, v); }
template <int TPT> __device__ __forceinline__ void mixer_tile(Frame& F, int l, int b, int s0) {
    const int tid = F.tid, lane = F.lane; const int rowbase = 0;
    LAS float* cbuf = (LAS float*)F.lds;
    const int c2 = (tid & 127) * 2, tq = F.wave >> 1, sb = s0 + TPT * tq;
    bf16* projb = F.PROJ + (size_t)b * (ACT_BSTRIDE / 2); bf16* mixb = F.MIX + (size_t)b * (ACT_BSTRIDE / 2);
    const __amdgpu_buffer_rsrc_t rp = __builtin_amdgcn_make_buffer_rsrc((void*)projb, 0, (int)((size_t)SEQ * NIN * 2), 0x00020000);
    const __amdgpu_buffer_rsrc_t rm = __builtin_amdgcn_make_buffer_rsrc((void*)mixb, 0, (int)((size_t)SEQ * DM * 2), 0x00020000);
    const int vo = c2 * 2;
    unsigned hr[TPT + 30];
    {
        unsigned prr[TPT + 2], bgr[TPT], udr[TPT + 15];
#pragma unroll
        for (int j = 0; j < TPT + 2; ++j) { const int s = sb - 2 + j, sc = s < 0 ? 0 : s; prr[j] = bld(rp, vo, (rowbase + sc) * (NIN * 2) + 1536 * 2); }
#pragma unroll
        for (int j = 0; j < TPT; ++j) bgr[j] = bld(rp, vo, (rowbase + sb + j) * (NIN * 2) + 1280 * 2);
#pragma unroll
        for (int j = 0; j < TPT + 15; ++j) { const int s = sb - 15 + j, sc = s < 0 ? 0 : s; udr[j] = bld(rp, vo, (rowbase + sc) * (NIN * 2) + 2048 * 2); }
        if (TPT <= 16) {
#pragma unroll
            for (int j = 0; j < TPT + 30; ++j) { const int s = sb - 30 + j, sc = s < 0 ? 0 : s; hr[j] = bld(rp, vo, (rowbase + sc) * (NIN * 2) + 768 * 2); } }
        const __amdgpu_buffer_rsrc_t rw = __builtin_amdgcn_make_buffer_rsrc((void*)(inp(F, 16) + (size_t)l * 3 * 256), 0, 3 * 256 * 4, 0x00020000);
        f32x2 w3[3];
#pragma unroll
        for (int k = 0; k < 3; ++k) w3[k] = bld2(rw, c2 * 4, k * 1024);
        f32x2 pr[TPT + 2];
#pragma unroll
        for (int j = 0; j < TPT + 2; ++j) { const float ok = (sb - 2 + j) >= 0 ? 1.f : 0.f; pr[j] = (f32x2){bflo(prr[j]) * ok, bfhi(prr[j]) * ok}; }
#pragma unroll
        for (int i = 0; i < TPT; ++i) { const f32x2 cv = w3[0] * pr[i] + w3[1] * pr[i + 1] + w3[2] * pr[i + 2];
            __builtin_amdgcn_raw_buffer_store_b32(pk2(bflo(bgr[i]) * cv[0], bfhi(bgr[i]) * cv[1]), rm, vo, (rowbase + sb + i) * (DM * 2) + 512 * 2, 0); }
        const int grp = c2 >> 6;
        const float m1 = grp >= 1 ? 1.f : 0.f, m2 = grp >= 2 ? 1.f : 0.f, m3 = grp >= 3 ? 1.f : 0.f;
        f32x2 t[TPT + 15], ut[TPT];
#pragma unroll
        for (int j = 0; j < TPT + 15; ++j) { const float ok = (sb - 15 + j) >= 0 ? 1.f : 0.f; t[j] = (f32x2){bflo(udr[j]) * ok, bfhi(udr[j]) * ok}; }
#pragma unroll
        for (int i = 0; i < TPT; ++i) ut[i] = t[15 + i];
#pragma unroll
        for (int j = TPT + 14; j >= 1; --j) t[j] += t[j - 1];
#pragma unroll
        for (int j = TPT + 14; j >= 3; --j) t[j] += t[j - 2] * m1;
#pragma unroll
        for (int j = TPT + 14; j >= 7; --j) t[j] += t[j - 4] * m2;
#pragma unroll
        for (int j = TPT + 14; j >= 15; --j) t[j] += t[j - 8] * m3;
#pragma unroll
        for (int i = 0; i < TPT; ++i) { const int win = 2 << grp, s = sb + i; const float rc = 1.0f / (float)((s + 1 < win) ? (s + 1) : win); const f32x2 y = t[15 + i] * rc - ut[i];
            __builtin_amdgcn_raw_buffer_store_b32(pk2(y[0], y[1]), rm, vo, (rowbase + s) * (DM * 2) + 768 * 2, 0); }
    }
    if (TPT > 16) {
#pragma unroll
        for (int j = 0; j < TPT + 30; ++j) { const int s = sb - 30 + j, sc = s < 0 ? 0 : s; hr[j] = bld(rp, vo, (rowbase + sc) * (NIN * 2) + 768 * 2); } }
    {
        const __amdgpu_buffer_rsrc_t rw = __builtin_amdgcn_make_buffer_rsrc((void*)(inp(F, 12) + (size_t)l * 31 * 256), 0, 31 * 256 * 4, 0x00020000);
        f32x2 w[31];
#pragma unroll
        for (int k = 0; k < 31; ++k) w[k] = bld2(rw, c2 * 4, k * 1024);
        f32x2 acc[TPT];
        const f32x2 bias = *(const f32x2*)(inp(F, 13) + l * 256 + c2);
#pragma unroll
        for (int i = 0; i < TPT; ++i) acc[i] = bias;
#pragma unroll
        for (int j = 0; j < TPT + 30; ++j) { const float ok = (sb - 30 + j) >= 0 ? 1.f : 0.f;
            const f32x2 hv = (f32x2){bflo(hr[j]) * ok, bfhi(hr[j]) * ok};
#pragma unroll
            for (int i = 0; i < TPT; ++i) { if (j - i >= 0 && j - i <= 30) acc[i] += w[j - i] * hv; } }
#pragma unroll
        for (int i = 0; i < TPT; ++i) *(LAS f32x2*)(cbuf + (TPT * tq + i) * 256 + c2) = acc[i];
    }
    LDS_WAIT(); __syncthreads();
    {
        const f32x4 g = *(const f32x4*)(inp(F, 14) + l * 256 + 4 * lane), bb = *(const f32x4*)(inp(F, 15) + l * 256 + 4 * lane);
        constexpr int NT = TPT / 2; f32x4 v[NT]; float mu[NT], var[NT];
#pragma unroll
        for (int i = 0; i < NT; ++i) { v[i] = *(const LAS f32x4*)(cbuf + (NT * F.wave + i) * 256 + 4 * lane); mu[i] = (v[i][0] + v[i][1]) + (v[i][2] + v[i][3]); }
#pragma unroll
        for (int o = 1; o < 64; o <<= 1)
#pragma unroll
            for (int i = 0; i < NT; ++i) mu[i] += __shfl_xor(mu[i], o);
#pragma unroll
        for (int i = 0; i < NT; ++i) { v[i] = v[i] - mu[i] * (1.0f / 256.0f); var[i] = (v[i][0] * v[i][0] + v[i][1] * v[i][1]) + (v[i][2] * v[i][2] + v[i][3] * v[i][3]); }
#pragma unroll
        for (int o = 1; o < 64; o <<= 1)
#pragma unroll
            for (int i = 0; i < NT; ++i) var[i] += __shfl_xor(var[i], o);
#pragma unroll
        for (int i = 0; i < NT; ++i) { const int t = NT * F.wave + i;
            const float rs = __builtin_amdgcn_rsqf(var[i] * (1.0f / 256.0f) + EPS); f32x4 y = v[i] * rs * g + bb;
            y[0] *= sigmoidf_(y[0]); y[1] *= sigmoidf_(y[1]); y[2] *= sigmoidf_(y[2]); y[3] *= sigmoidf_(y[3]);
            v2u w; w.x = pk2(y[0], y[1]); w.y = pk2(y[2], y[3]);
            *(v2u*)(mixb + ((size_t)rowbase + s0 + t) * DM + 256 + 4 * lane) = w; }
    }
    __syncthreads();
}

__device__ __forceinline__ void wait_count(Frame& F, gu32* c, unsigned target, bool inv = true) {
    if (F.tid == 0) { unsigned sp = 0;
        while (__hip_atomic_load(c, __ATOMIC_RELAXED, __HIP_MEMORY_SCOPE_AGENT) < target) { __builtin_amdgcn_s_sleep(1); if (++sp > XB_SPIN_CAP) break; }
        if (inv) __builtin_amdgcn_fence(__ATOMIC_ACQUIRE, "agent");
        asm volatile("s_waitcnt vmcnt(0)" ::: "memory"); }
    __syncthreads();
}

struct Args { const float* in[21]; float* out; unsigned char* ws; int ph_lo, ph_hi, li, pad; };
__global__ void __launch_bounds__(NWAVES * 64, 2) trunk_fwd(Args args) {
    extern __shared__ __attribute__((aligned(16))) unsigned char lds[];
    Frame F;
    F.lds = (LAS unsigned char*)lds;
    F.MISC = (volatile LAS unsigned*)(F.lds + MISC_OFF);
    F.tid = threadIdx.x; F.lane = F.tid & 63; F.wave = __builtin_amdgcn_readfirstlane(F.tid >> 6);
    const int wave0 = F.wave;
    F.G = gridDim.x; { const int bx = blockIdx.x; F.vcu = (F.G % 8 == 0) ? (bx % 8) * (F.G / 8) + bx / 8 : bx; }
    unsigned char* ws = args.ws; F.ws = ws;
    F.ctl = (gu32*)(ws + WS_CTL);
    F.out = args.out;
    F.MOD = (float*)(ws + WS_MOD); F.BIAS1 = (float*)(ws + WS_BIAS1); F.BIAS2 = (float*)(ws + WS_BIAS2); F.SSQ1 = (float*)(ws + WS_SSQ1); F.SSQ2 = (float*)(ws + WS_SSQ2);
    F.HA = (bf16*)(ws + WS_HA); F.XB = (bf16*)(ws + WS_XB); F.PROJ = (bf16*)(ws + WS_PROJ); F.MIX = (bf16*)(ws + WS_MIX); F.HID = (bf16*)(ws + WS_HID);
    for (int u = F.tid; u < (LDS_BYTES - LDSCTL_OFF) / 4; u += NWAVES * 64) ((LAS unsigned*)(F.lds + LDSCTL_OFF))[u] = 0u;
    __syncthreads();
    if (F.tid == 0) {
#pragma unroll
        for (int k = 0; k < 21; ++k) *(LAS unsigned long long*)(F.lds + PTR_OFF + 8 * k) = (unsigned long long)args.in[k]; }
    __syncthreads();
    XcdBarrier bar; bar.bar = (unsigned*)(F.ctl + CW_BAR); bar.x = 0; bar.st = nullptr; bar.gsize = 0;
    if (!MK_PER_PHASE) bar = xcd_barrier_post((unsigned*)(F.ctl + CW_BAR), F.MISC + 8, (unsigned)F.G);
    const bool grp = !MK_PER_PHASE && F.G == 256;
    XcdBarrier gbar = bar;
    if (grp) gbar = xcd_barrier_post((unsigned*)(F.ctl + CW_BAR) + (1 + (blockIdx.x & 7)) * XCD_BAR_WORDS, F.MISC + 10, (unsigned)(F.G / 8));
    const int lo = args.ph_lo, hi = args.ph_hi;
#define IN(k) (lo <= (k) && (k) < hi)
#define SEAM(k) do { if (IN((k) + 1)) { if ((k) >= 2 && grp) xcd_barrier(gbar); else xcd_barrier(bar); } } while (0)
#define SEAMT(k, kind) do { T0((kind) + 16); SEAM(k); T1((kind) + 16); } while (0)

#ifndef PROBE_DUP
#define PROBE_DUP 0
#endif
#ifndef PROBE_N
#define PROBE_N 2
#endif
#define REPS(k) (((PROBE_DUP >> (k)) & 1) ? PROBE_N : 1)
    if (IN(0)) { T0(1); for (int rep = 0; rep < REPS(0); ++rep) { if (rep) xcd_barrier(bar);
        prep_layers(F, 0, PREP_UPFRONT ? DEPTH : 1, rep ? ((PROBE_DUP >> 8) & 15) : 3); } T1(1); SEAMT(0, 1); }
    if (IN(1)) { T0(2); for (int rep = 0; rep < REPS(1); ++rep) { if (rep) xcd_barrier(bar); p0b(F); } T1(2); SEAMT(1, 2); }
#ifndef STAGGER_FN
#define STAGGER_FN(b) (b)
#endif
#ifndef STAGGER_TICKS
#define STAGGER_TICKS 0
#endif
    if (grp && STAGGER_TICKS > 0 && IN(2)) { const unsigned long long t_end = __builtin_amdgcn_s_memrealtime() + (unsigned long long)(STAGGER_FN(blockIdx.x & 7) * STAGGER_TICKS);
        while (__builtin_amdgcn_s_memrealtime() < t_end) __builtin_amdgcn_s_sleep(8); }
    const bool ovl = grp && lo == 0 && hi == N_PHASES;
    if (ovl) {
        if (F.tid == 0 && gbar.st[0] == 0u) { unsigned nloc, nx; xcd_barrier_complete(gbar.bar, gbar.x, gbar.gsize, nloc, nx); gbar.st[0] = nloc; gbar.st[1] = nx; }
        LDS_WAIT(); __syncthreads(); }
#pragma unroll 1
    for (int l = 0; l < DEPTH; ++l) {
        const int p = 2 + 5 * l;
        { int tl; asm volatile("v_mbcnt_lo_u32_b32 %0, -1, 0\n\tv_mbcnt_hi_u32_b32 %0, -1, %0\n\tv_lshl_or_b32 %0, %1, 6, %0" : "=&v"(tl) : "s"(wave0)); F.tid = tl; F.lane = tl & 63; F.wave = __builtin_amdgcn_readfirstlane(tl >> 6); }
        int bxl = blockIdx.x; asm volatile("" : "+s"(bxl));
        const float* modl = F.MOD + (size_t)l * 8 * NMOD;
        if (IN(p)) {
            T0(3);
            for (int rep = 0; rep < REPS(2); ++rep) { if (rep) { xcd_barrier(bar); int tl; asm volatile("v_mbcnt_lo_u32_b32 %0, -1, 0\n\tv_mbcnt_hi_u32_b32 %0, -1, %0\n\tv_lshl_or_b32 %0, %1, 6, %0" : "=&v"(tl) : "s"(wave0)); F.tid = tl; F.lane = tl & 63; F.wave = __builtin_amdgcn_readfirstlane(tl >> 6); asm volatile("" : "+s"(bxl)); }
            pg8::Gemm g{F.HA, wt_ptr(F, l, WT_IN), M, NIN, DM, 0}; pg8::StaticOrder S; S.init(M, NIN, F.G, bxl);
            if (ovl) { S.sig = (unsigned*)(F.ctl + 3072 + (l * 8 + (bxl & 7)) * 2); S.sig_nx = F.MISC[11]; }
            rstd_table(F, S, F.SSQ1, F.BIAS1 + (size_t)l * 8 * NIN, NIN);
            pg8::EpiProj E{F.PROJ, F.BIAS1 + (size_t)l * 8 * NIN, (const LAS float*)(F.lds + RT_OFF), inp(F, 8) + l * 32, inp(F, 9) + l * 32, QSCALE, ACT_BSTRIDE / 2};
            pg8::gemm_phase<pg8::EpiProj, pg8::StaticOrder, true, true>(F.lds + RING_OFF, g, S, E, F.tid);
            }
            if (!PREP_UPFRONT && l + 1 < DEPTH) {
                { int tl; asm volatile("v_mbcnt_lo_u32_b32 %0, -1, 0\n\tv_mbcnt_hi_u32_b32 %0, -1, %0\n\tv_lshl_or_b32 %0, %1, 6, %0" : "=&v"(tl) : "s"(wave0)); F.tid = tl; F.lane = tl & 63; F.wave = __builtin_amdgcn_readfirstlane(tl >> 6); }
                prep_layers(F, l + 1, 1); }
            T1(3);
            if (ovl) { T0(19);
                wait_count(F, F.ctl + 3072 + (l * 8 + (bxl & 7)) * 2, 32u, F.MISC[11] > 1u); T1(19); } else SEAMT(p, 3);
        }
        if (IN(p + 1)) {
            T0(4);
            for (int rep = 0; rep < REPS(3); ++rep) { if (rep) xcd_barrier(bar); attn_phase(F, l, rep + 1 < REPS(3) ? ((PROBE_DUP >> 12) & 15) : 0); }
            T1(4); T0(5);
            if (ovl) { const int j = bxl >> 3, bq = bxl & 7;
                if (j >= 8) {
                    wait_count(F, F.ctl + 3072 + (l * 8 + bq) * 2 + 1, 8u, F.MISC[11] > 1u);
                    if (j < 24) mixer_tile<22>(F, l, bq, 88 * (j - 8)); else mixer_tile<20>(F, l, bq, 1408 + 80 * (j - 24)); }
            } else
            for (int rep = 0; rep < REPS(4); ++rep) { if (rep) xcd_barrier(bar); for (int tt = F.vcu; tt < 256; tt += F.G) mixer_tile<16>(F, l, tt >> 5, (tt & 31) * 64); }
            if (!PREP_UPFRONT && l + 1 < DEPTH) bias_layers(F, l + 1, 1);
            T1(5); SEAMT(p + 1, 5);
        }
        if (IN(p + 2)) {
            T0(6);
            { pg8::Gemm g{F.MIX, wt_ptr(F, l, WT_OUT), M, DM, DM, ACT_BSTRIDE - (size_t)SEQ * DM * 2}; pg8::StaticOrder S; S.init(M, DM, F.G, bxl);
            pg8::EpiRes E{l == 0 ? inp(F, 0) : nullptr, modl + 1024, inp(F, 4) + l * DM, nullptr, modl + 2048, modl + 4096, inp(F, 5) + l * DM, F.HA, F.SSQ2, 1, (LAS float*)(F.lds + RT_OFF)};
            pg8::gemm_phase<pg8::EpiRes, pg8::StaticOrder, true, true>(F.lds + RING_OFF, g, S, E, F.tid); }
            T1(6); SEAMT(p + 2, 6);
        }
        if (IN(p + 3)) {
            T0(7);
            for (int rep = 0; rep < REPS(6); ++rep) { if (rep) { xcd_barrier(bar); int tl; asm volatile("v_mbcnt_lo_u32_b32 %0, -1, 0\n\tv_mbcnt_hi_u32_b32 %0, -1, %0\n\tv_lshl_or_b32 %0, %1, 6, %0" : "=&v"(tl) : "s"(wave0)); F.tid = tl; F.lane = tl & 63; F.wave = __builtin_amdgcn_readfirstlane(tl >> 6); asm volatile("" : "+s"(bxl)); }
            pg8::Gemm g{F.HA, wt_ptr(F, l, WT_FF1), M, FF, DM, 0}; pg8::StaticOrder S; S.init(M, FF, F.G, bxl);
            rstd_table(F, S, F.SSQ2, F.BIAS2 + (size_t)l * 8 * FF, FF);
            pg8::EpiFF1 E{F.HID, F.BIAS2 + (size_t)l * 8 * FF, (const LAS float*)(F.lds + RT_OFF)};
            pg8::gemm_phase<pg8::EpiFF1, pg8::StaticOrder, true, true>(F.lds + RING_OFF, g, S, E, F.tid); }
            T1(7); SEAMT(p + 3, 7);
        }
        if (IN(p + 4)) {
            T0(8);
            { pg8::Gemm g{F.HID, wt_ptr(F, l, WT_FF2), M, DM, FF, 0}; pg8::StaticOrder S; S.init(M, DM, F.G, bxl);
            const int nl = l + 1 < DEPTH ? l + 1 : l;
            pg8::EpiRes E{nullptr, modl + 4096, inp(F, 5) + l * DM, l + 1 == DEPTH ? F.out : nullptr, modl + 5120, F.MOD + (size_t)nl * 8 * NMOD + 1024, inp(F, 4) + nl * DM, F.HA, F.SSQ1, l + 1 < DEPTH ? 1 : 0, (LAS float*)(F.lds + RT_OFF)};
            pg8::gemm_phase<pg8::EpiRes, pg8::StaticOrder, true, true>(F.lds + RING_OFF, g, S, E, F.tid); }
            T1(8); if (l + 1 < DEPTH) SEAMT(p + 4, 8);
        }
    }
#ifndef PROBE_B
#define PROBE_B 0
#endif
    if (PROBE_T != 0 && blockIdx.x == PROBE_B && wave0 == 0) { const unsigned long long tend = __builtin_amdgcn_s_memrealtime() + 10ull * TQ[1]; while (__builtin_amdgcn_s_memrealtime() < tend) __builtin_amdgcn_s_sleep(16); }
#undef IN
#undef SEAM
}

extern "C" void kernel_launch(void* const* d_in, const int* in_sizes, int n_in, void* d_out, int out_size, void* d_ws, size_t ws_size, hipStream_t stream) {
    static int grid = 0;
    if (grid == 0) {
        if (n_in != 21 || in_sizes[0] != M * DM || out_size != M * DM || ws_size < WS_END) { fprintf(stderr, "kernel_launch: unexpected problem shape (n_in %d, in0 %d, out %d, ws %zu, need %zu); nothing launched\n", n_in, n_in > 0 ? in_sizes[0] : -1, out_size, ws_size, (size_t)WS_END); grid = -1; return; }
        int dev = 0, cus = 0, per_cu = 0;
        if (hipGetDevice(&dev) != hipSuccess || hipDeviceGetAttribute(&cus, hipDeviceAttributeMultiprocessorCount, dev) != hipSuccess) { fprintf(stderr, "kernel_launch: device query failed\n"); grid = -1; return; }
        if (hipFuncSetAttribute((const void*)trunk_fwd, hipFuncAttributeMaxDynamicSharedMemorySize, LDS_BYTES) != hipSuccess) { fprintf(stderr, "kernel_launch: hipFuncSetAttribute failed\n"); grid = -1; return; }
        if (hipOccupancyMaxActiveBlocksPerMultiprocessor(&per_cu, (const void*)trunk_fwd, NWAVES * 64, LDS_BYTES) != hipSuccess || per_cu < 1) { fprintf(stderr, "kernel_launch: occupancy query reports %d workgroups per CU\n", per_cu); }
        (void)hipGetLastError();
        grid = cus;
    }
    if (grid < 0) return;
    if (hipMemsetAsync((char*)d_ws + WS_CTL, 0, CTL_ZERO_BYTES, stream) != hipSuccess) { fprintf(stderr, "kernel_launch: hipMemsetAsync failed\n"); return; }
    Args a{};
    for (int i = 0; i < 21; ++i) a.in[i] = (const float*)d_in[i];
    a.out = (float*)d_out; a.ws = (unsigned char*)d_ws;
#if MK_PER_PHASE
    for (int li = 0; li < N_PHASES; ++li) { a.ph_lo = li; a.ph_hi = li + 1; a.li = li;
        hipLaunchKernelGGL(trunk_fwd, dim3(grid), dim3(NWAVES * 64), LDS_BYTES, stream, a); }
#else
    a.ph_lo = 0; a.ph_hi = N_PHASES; a.li = 0;
    hipLaunchKernelGGL(trunk_fwd, dim3(grid), dim3(NWAVES * 64), LDS_BYTES, stream, a);
#endif
    const hipError_t le = hipPeekAtLastError();
    if (le != hipSuccess) fprintf(stderr, "kernel_launch: launch failed: %s\n", hipGetErrorName(le));
}
```
